# Optimizing an MI355X kernel written in HIP

```python
import math
import jax, jax.numpy as jnp
from jax import lax
import numpy as np

D_MODEL = 1024
BATCH = 8
SEQ = 4096
DEPTH = 1

MIX_WIDTH = D_MODEL
CONV_WIDTH = MIX_WIDTH // 2
CONV_GROUPS = 8
CONV_KERNEL = 31
DIFF_WIDTH = MIX_WIDTH - CONV_WIDTH
DIFF_HEADS = 4
DIFF_VDIM = DIFF_WIDTH // DIFF_HEADS
DIFF_QKDIM = DIFF_VDIM // 2
Q_BLOCK = 128
RMS_EPS = 1e-6
LN_EPS = 1e-5
COL_GLU = 2 * CONV_WIDTH
COL_CGATE = CONV_WIDTH
COL_Q = DIFF_WIDTH
COL_K = DIFF_WIDTH
COL_V = DIFF_WIDTH
COL_DGATE = DIFF_WIDTH
IN_COLS = COL_GLU + COL_CGATE + COL_Q + COL_K + COL_V + COL_DGATE

kernel_name = "hymba_conformer_diffattn_alibi_layer"


def rmsnorm(x, g, eps=RMS_EPS):
    xf = x.astype(jnp.float32)
    y = xf * lax.rsqrt(jnp.mean(xf * xf, axis=-1, keepdims=True) + eps)
    return (y * g.astype(jnp.float32)).astype(x.dtype)


def layernorm(x, g, b, eps=LN_EPS):
    xf = x.astype(jnp.float32)
    mu = jnp.mean(xf, axis=-1, keepdims=True)
    var = jnp.mean(jnp.square(xf - mu), axis=-1, keepdims=True)
    y = (xf - mu) * lax.rsqrt(var + eps)
    return (y * g.astype(jnp.float32) + b.astype(jnp.float32)).astype(x.dtype)


def lambda_init_for(layer_idx):
    return 0.8 - 0.6 * math.exp(-0.3 * layer_idx)


def alibi_slopes(n_heads):
    return jnp.exp2(-8.0 * (jnp.arange(n_heads, dtype=jnp.float32) + 1.0) / n_heads)


def conformer_conv_branch(u, dw_w, dw_b, ln_g, ln_b, pw_w, pw_b):
    a, b = jnp.split(u, 2, axis=-1)
    h = a * jax.nn.sigmoid(b)
    c = h.shape[-1]
    rhs = dw_w[:, None, :]
    h = lax.conv_general_dilated(
        h, rhs.astype(h.dtype), window_strides=(1,),
        padding=[(CONV_KERNEL - 1, 0)],
        dimension_numbers=("NWC", "WIO", "NWC"),
        feature_group_count=c) + dw_b
    h = layernorm(h, ln_g, ln_b)
    h = jax.nn.silu(h)
    return jnp.einsum("bsc,ce->bse", h, pw_w) + pw_b


def diff_attention(q, k, v, lam, slopes):
    B, S, H = q.shape[0], q.shape[1], q.shape[2]
    nblk = S // Q_BLOCK
    scale = DIFF_QKDIM ** -0.5
    qb = q.reshape(B, nblk, Q_BLOCK, H, 2, DIFF_QKDIM).transpose(1, 0, 2, 3, 4, 5)
    kpos = jnp.arange(S)

    def one_block(args):
        qi, blk = args
        qpos = blk * Q_BLOCK + jnp.arange(Q_BLOCK)
        dist = (qpos[:, None] - kpos[None, :]).astype(jnp.float32)
        bias = jnp.where(dist[None] >= 0, -slopes[:, None, None] * dist[None], -jnp.inf)
        s = jnp.einsum("bqhcd,bkhcd->bhcqk", qi, k).astype(jnp.float32) * scale
        p = jax.nn.softmax(s + bias[None, :, None], axis=-1)
        a = p[:, :, 0] - lam * p[:, :, 1]
        return jnp.einsum("bhqk,bkhe->bqhe", a.astype(v.dtype), v)

    out = lax.map(one_block, (qb, jnp.arange(nblk)))
    return out.transpose(1, 0, 2, 3, 4).reshape(B, S, H, DIFF_VDIM)


def setup_inputs(seed: int = 0) -> dict:
    key = jax.random.key(seed)
    ks = jax.random.split(key, 20)
    f32 = jnp.float32
    L = DEPTH
    nrm = lambda k, shape, s: (jax.random.normal(k, shape, f32) * s)
    return {
        "x": jax.random.normal(ks[0], (BATCH, SEQ, D_MODEL), f32),
        "pre_norm_g": 1.0 + nrm(ks[1], (L, D_MODEL), 0.02),
        "w_in": nrm(ks[2], (L, D_MODEL, IN_COLS), D_MODEL ** -0.5),
        "conv_dw_w": nrm(ks[3], (L, CONV_KERNEL, CONV_WIDTH), CONV_KERNEL ** -0.5),
        "conv_dw_b": nrm(ks[4], (L, CONV_WIDTH), 0.02),
        "conv_ln_g": 1.0 + nrm(ks[5], (L, CONV_WIDTH), 0.02),
        "conv_ln_b": nrm(ks[6], (L, CONV_WIDTH), 0.02),
        "conv_pw_w": nrm(ks[7], (L, CONV_WIDTH, CONV_WIDTH), CONV_WIDTH ** -0.5),
        "conv_pw_b": nrm(ks[8], (L, CONV_WIDTH), 0.02),
        "lambda_q1": nrm(ks[9], (L, DIFF_QKDIM), 0.1),
        "lambda_k1": nrm(ks[10], (L, DIFF_QKDIM), 0.1),
        "lambda_q2": nrm(ks[11], (L, DIFF_QKDIM), 0.1),
        "lambda_k2": nrm(ks[12], (L, DIFF_QKDIM), 0.1),
        "diff_subln_g": 1.0 + nrm(ks[13], (L, DIFF_VDIM), 0.02),
        "w_out": nrm(ks[14], (L, MIX_WIDTH, D_MODEL), MIX_WIDTH ** -0.5),
        "post_norm_g": 1.0 + nrm(ks[15], (L, D_MODEL), 0.02),
    }


def reference(x, pre_norm_g, w_in, conv_dw_w, conv_dw_b, conv_ln_g, conv_ln_b,
              conv_pw_w, conv_pw_b, lambda_q1, lambda_k1, lambda_q2, lambda_k2,
              diff_subln_g, w_out, post_norm_g):
    B, S, _ = x.shape
    slopes = alibi_slopes(DIFF_HEADS)
    split_at = np.cumsum([COL_GLU, COL_CGATE, COL_Q, COL_K, COL_V])
    h = x
    for i in range(DEPTH):
        lam_init = lambda_init_for(i)
        xn = rmsnorm(h, pre_norm_g[i])
        z = jnp.einsum("bsd,dc->bsc", xn, w_in[i])
        u_glu, g_conv, q, k, v, g_diff = jnp.split(z, split_at, axis=-1)

        y_conv = conformer_conv_branch(u_glu, conv_dw_w[i], conv_dw_b[i], conv_ln_g[i],
                                       conv_ln_b[i], conv_pw_w[i], conv_pw_b[i])
        y_conv = y_conv * jax.nn.silu(g_conv)

        qh = q.reshape(B, S, DIFF_HEADS, 2, DIFF_QKDIM)
        kh = k.reshape(B, S, DIFF_HEADS, 2, DIFF_QKDIM)
        vh = v.reshape(B, S, DIFF_HEADS, DIFF_VDIM)
        lq1 = lambda_q1[i].astype(jnp.float32); lk1 = lambda_k1[i].astype(jnp.float32)
        lq2 = lambda_q2[i].astype(jnp.float32); lk2 = lambda_k2[i].astype(jnp.float32)
        lam = jnp.exp(jnp.sum(lq1 * lk1)) - jnp.exp(jnp.sum(lq2 * lk2)) + lam_init
        o = diff_attention(qh, kh, vh, lam, slopes)
        o = rmsnorm(o, diff_subln_g[i]) * (1.0 - lam_init)
        y_diff = o.reshape(B, S, DIFF_WIDTH) * jax.nn.silu(g_diff)

        y = jnp.concatenate([y_conv, y_diff], axis=-1)
        y = jnp.einsum("bsc,cd->bsd", y, w_out[i])
        h = h + rmsnorm(y, post_norm_g[i])
    return h
```

```cpp
#include <hip/hip_runtime.h>
#include <hip/hip_cooperative_groups.h>
#include <cstdio>
#include <cstdint>
namespace cg = cooperative_groups;
__device__ __forceinline__ int lane_id_asm() { int l; asm volatile("v_mbcnt_lo_u32_b32 %0, -1, 0\n\tv_mbcnt_hi_u32_b32 %0, -1, %0" : "=v"(l)); return l; }
namespace pg8 {
#define PG8_LAS __attribute__((address_space(3)))
typedef unsigned short bf16_t;
typedef short bf16x8 __attribute__((ext_vector_type(8)));
typedef float f32x4 __attribute__((ext_vector_type(4)));
typedef unsigned u32x4 __attribute__((ext_vector_type(4)));
constexpr int BM = 256, BK = 64, HALF = 128, HTB = HALF * BK * 2  , STAGE_BYTES = 8 * HTB, NXCD = 8, WGM = 8;

__host__ __device__ __forceinline__ int lds_byte(int r, int c) { const int st = (r >> 4) * 2 + (c >> 5), rr = r & 15, cc = c & 31, ob = rr * 64 + cc * 2; return st * 1024 + (ob ^ (((ob >> 9) & 1) << 5)); }
__host__ __device__ __forceinline__ void stage_rc(int b, int& R, int& C) { const int st = b / 1024, sb = b % 1024, swz = sb ^ (((sb >> 9) & 1) << 5); R = (st >> 1) * 16 + swz / 64; C = (st & 1) * 32 + (swz % 64) / 2; }
__host__ __device__ __forceinline__ int perm32(int rho) { const int n = rho >> 4, i = rho & 15; return 8 * (i >> 2) + 4 * n + (i & 3); }

struct Unit { int pm, pn; };
struct Gemm { const bf16_t* A; const bf16_t* Bt; int M, N, K; };

struct StaticOrder {
    int nM, nN, nwg, G, c;
    __host__ __device__ void init(int M, int N, int G_, int c_) { nM = M / BM; nN = N / BM; nwg = nM * nN; G = G_; c = c_; }
    __host__ __device__ bool next(int i, Unit& u) const {
        const long L = (long)i * G + c; if (L >= nwg) return false;
        int wgid = (int)L; { const int q = nwg / NXCD, r = nwg % NXCD, xcd = wgid % NXCD, off = wgid / NXCD; wgid = (xcd < r ? xcd * (q + 1) : r * (q + 1) + (xcd - r) * q) + off; }
        const int nig = WGM * nN, gid = wgid / nig, fm = gid * WGM, gsz = (nM - fm) < WGM ? (nM - fm) : WGM;
        u.pm = fm + ((wgid % nig) % gsz); u.pn = (wgid % nig) / gsz; return true;
    }
    __device__ __forceinline__ void a_ready(const Unit&) const {}
    __device__ __forceinline__ void done(const Unit&) const {}
};

__device__ __forceinline__ unsigned cvt_pk_bf16(float lo, float hi) { unsigned r; asm volatile("v_cvt_pk_bf16_f32 %0, %1, %2" : "=v"(r) : "v"(lo), "v"(hi)); return r; }

typedef float f32x2 __attribute__((ext_vector_type(2)));
__host__ __device__ __forceinline__ float alibi_c32(int h) { return h == 0 ? 2980.9579870417283f : h == 1 ? 7.38905609893065f : h == 2 ? 1.6487212707001282f : 1.1331484530668263f; }
__host__ __device__ __forceinline__ float alibi_sl(int h) { return h == 0 ? 0.36067376022224085f : h == 1 ? 0.09016844005556021f : h == 2 ? 0.022542110013890053f : 0.005635527503472513f; }
__device__ __forceinline__ float sigmoid_f(float v) { return __builtin_amdgcn_rcpf(1.0f + __builtin_amdgcn_exp2f(-1.4426950408889634f * v)); }
__device__ __forceinline__ float silu_f(float v) { return v * sigmoid_f(v); }
__device__ __forceinline__ float bf_lo(unsigned w) { return __uint_as_float(w << 16); }
__device__ __forceinline__ float bf_hi(unsigned w) { return __uint_as_float(w & 0xffff0000u); }
__device__ __forceinline__ u32x4 pack8(const f32x4 v0, const f32x4 v1) { u32x4 w; w.x = cvt_pk_bf16(v0[0], v0[1]); w.y = cvt_pk_bf16(v0[2], v0[3]); w.z = cvt_pk_bf16(v1[0], v1[1]); w.w = cvt_pk_bf16(v1[2], v1[3]); return w; }

struct EpiIn {
    static constexpr bool PERM = true, AFTER_DRAIN = false;
    bf16_t *Hg, *CG, *Q, *K, *V, *DG; unsigned* nmax;
    __device__ __forceinline__ void operator()(const f32x4 (&acc)[2][2][4][2], const Unit& u, int wr, int wc, int fr, int fq) const {
        const int row0 = u.pm * BM + wr * 64 + fr; const int pn = u.pn;
        if (pn < 4) {
            const int col = 128 * pn + wc * 32 + 8 * fq;
#pragma unroll
            for (int ai = 0; ai < 2; ++ai)
#pragma unroll
                for (int m = 0; m < 4; ++m) {
                    f32x4 h0, h1;
#pragma unroll
                    for (int j = 0; j < 4; ++j) { h0[j] = acc[ai][0][m][0][j] * sigmoid_f(acc[ai][1][m][0][j]); h1[j] = acc[ai][0][m][1][j] * sigmoid_f(acc[ai][1][m][1][j]); }
                    *(u32x4*)(Hg + (size_t)(row0 + ai * HALF + m * 16) * 512 + col) = pack8(h0, h1);
                }
        } else {
            const int role = (pn - 4) >> 1, colt = 256 * ((pn - 4) & 1) + wc * 32 + 8 * fq;
            bf16_t* base = role == 0 ? CG : role == 1 ? Q : role == 2 ? K : role == 3 ? V : DG;
            float mx[2] = {0.f, 0.f};
#pragma unroll
            for (int ai = 0; ai < 2; ++ai)
#pragma unroll
                for (int m = 0; m < 4; ++m)
#pragma unroll
                    for (int bj = 0; bj < 2; ++bj) {
                        f32x4 v0 = acc[ai][bj][m][0], v1 = acc[ai][bj][m][1];
                        if (role == 0 || role == 4) {
#pragma unroll
                            for (int j = 0; j < 4; ++j) { v0[j] = silu_f(v0[j]); v1[j] = silu_f(v1[j]); }
                        } else if (role == 1) { v0 = v0 * 0.18033688011112042f; v1 = v1 * 0.18033688011112042f; }
                        else if (role == 3) {
                            if (m >= 2) {
                                const int h = 2 * ((pn - 4) & 1) + bj;
                                const float c = alibi_c32(h);
                                v0 = v0 * c; v1 = v1 * c;
                            }
                        }
                        *(u32x4*)(base + (size_t)(row0 + ai * HALF + m * 16) * 512 + colt + bj * HALF) = pack8(v0, v1);
                        if (role == 1 || role == 2) { float ss = (v0[0] * v0[0] + v0[1] * v0[1]) + (v0[2] * v0[2] + v0[3] * v0[3]) + (v1[0] * v1[0] + v1[1] * v1[1]) + (v1[2] * v1[2] + v1[3] * v1[3]);
                            ss += __shfl_xor(ss, 16); ss += __shfl_xor(ss, 32); mx[bj] = fmaxf(mx[bj], ss); }
                    }
            if (role == 1 || role == 2) {
#pragma unroll
                for (int bj = 0; bj < 2; ++bj) { float v = mx[bj]; v = fmaxf(v, __shfl_xor(v, 1)); v = fmaxf(v, __shfl_xor(v, 2)); v = fmaxf(v, __shfl_xor(v, 4)); v = fmaxf(v, __shfl_xor(v, 8));
                    if (fr == 0 && fq == 0) atomicMax(nmax + (role - 1) * 8 + 4 * ((pn - 4) & 1) + 2 * bj + (wc >> 1), __float_as_uint(v)); }
            }
        }
    }
};
struct EpiPw {
    static constexpr bool PERM = true, AFTER_DRAIN = false;
    const bf16_t* CG; const float* bias; bf16_t* Y;
    __device__ __forceinline__ void operator()(const f32x4 (&acc)[2][2][4][2], const Unit& u, int wr, int wc, int fr, int fq) const {
        const int row0 = u.pm * BM + wr * 64 + fr; const int col0 = u.pn * BM + wc * 32 + 8 * fq;
        f32x4 bv[2][2];
#pragma unroll
        for (int bj = 0; bj < 2; ++bj)
#pragma unroll
            for (int n = 0; n < 2; ++n) bv[bj][n] = *(const f32x4*)(bias + col0 + bj * HALF + 4 * n);
#pragma unroll
        for (int ai = 0; ai < 2; ++ai)
#pragma unroll
            for (int m = 0; m < 4; ++m) { const size_t row = (size_t)(row0 + ai * HALF + m * 16);
#pragma unroll
                for (int bj = 0; bj < 2; ++bj) {
                    const u32x4 g = *(const u32x4*)(CG + row * 512 + col0 + bj * HALF);
                    f32x4 v0 = acc[ai][bj][m][0] + bv[bj][0], v1 = acc[ai][bj][m][1] + bv[bj][1];
                    v0[0] *= bf_lo(g.x); v0[1] *= bf_hi(g.x); v0[2] *= bf_lo(g.y); v0[3] *= bf_hi(g.y);
                    v1[0] *= bf_lo(g.z); v1[1] *= bf_hi(g.z); v1[2] *= bf_lo(g.w); v1[3] *= bf_hi(g.w);
                    *(u32x4*)(Y + row * 1024 + col0 + bj * HALF) = pack8(v0, v1);
                } }
    }
};
struct EpiOut {
    static constexpr bool PERM = true, AFTER_DRAIN = false;
    bf16_t* Y2; float* rowss;
    __device__ __forceinline__ void operator()(const f32x4 (&acc)[2][2][4][2], const Unit& u, int wr, int wc, int fr, int fq) const {
        const int row0 = u.pm * BM + wr * 64 + fr; const int col0 = u.pn * BM + wc * 32 + 8 * fq;
#pragma unroll
        for (int ai = 0; ai < 2; ++ai)
#pragma unroll
            for (int m = 0; m < 4; ++m) { const size_t row = (size_t)(row0 + ai * HALF + m * 16); float ss = 0.f;
#pragma unroll
                for (int bj = 0; bj < 2; ++bj) {
                    const f32x4 v0 = acc[ai][bj][m][0], v1 = acc[ai][bj][m][1];
                    ss += (v0[0] * v0[0] + v0[1] * v0[1]) + (v0[2] * v0[2] + v0[3] * v0[3]) + (v1[0] * v1[0] + v1[1] * v1[1]) + (v1[2] * v1[2] + v1[3] * v1[3]);
                    *(u32x4*)(Y2 + row * 1024 + col0 + bj * HALF) = pack8(v0, v1);
                }
                ss += __shfl_xor(ss, 16); ss += __shfl_xor(ss, 32);
                if (fq == 0) atomicAdd(rowss + row, ss);
            }
    }
};


template <class Epi, class Sched, bool ALIGN_EPI = false, bool SP2 = false>
__device__ __forceinline__ void gemm_phase(PG8_LAS unsigned char* lds, const Gemm g, const Sched& S, const Epi& E, int wid_in) {
    const int lane = lane_id_asm();
    int wid_o = wid_in; asm volatile("" : "+s"(wid_o)); const int wid = wid_o, tid = wid * 64 + lane, wr = wid >> 2, wc = wid & 3, fr = lane & 15, fq = lane >> 4;
    const int K = g.K, nt = K / BK;
    unsigned voffA[2], voffB[2];
#pragma unroll
    for (int i = 0; i < 2; ++i) { int R, C; stage_rc(tid * 16 + i * 8192, R, C); const int Rb = Epi::PERM ? ((R & ~31) + perm32(R & 31)) : R;
        voffA[i] = (unsigned)(R * K + C) * 2u; voffB[i] = (unsigned)(Rb * K + C) * 2u; }
    const size_t kstep = (size_t)(BK * 2);
    const size_t hstep = (size_t)HALF * K * 2;
    const size_t tstep = 2 * hstep;
    const unsigned ldsw = (unsigned)wid * 1024u;
    const int aoff = lds_byte(wr * 64 + fr, fq * 8), boff = lds_byte(wc * 32 + fr, fq * 8);
#define PG8_SA(b, h) (((b) * 2 + (h)) * HTB)
#define PG8_SB(b, h) ((4 + (b) * 2 + (h)) * HTB)
#define PG8_STAGE(bufoff, gbase, voff) do { _Pragma("unroll") for (int _i = 0; _i < 2; ++_i) \
        __builtin_amdgcn_global_load_lds((const unsigned*)((const char*)(gbase) + (voff)[_i]), (PG8_LAS unsigned*)(lds + (bufoff) + ldsw + _i * 8192), 16, 0, 0); } while (0)
#define PG8_LDA(dst, b, h) do { _Pragma("unroll") for (int m = 0; m < 4; ++m) _Pragma("unroll") for (int k = 0; k < 2; ++k) dst[m][k] = *(const PG8_LAS bf16x8*)(lds + PG8_SA(b, h) + aoff + m * 2048 + k * 1024); } while (0)
#define PG8_LDB(dst, b, h) do { _Pragma("unroll") for (int n = 0; n < 2; ++n) _Pragma("unroll") for (int k = 0; k < 2; ++k) dst[n][k] = *(const PG8_LAS bf16x8*)(lds + PG8_SB(b, h) + boff + n * 2048 + k * 1024); } while (0)
#define PG8_MMA(ai, bj, At, Bt) do { __builtin_amdgcn_s_setprio(1); _Pragma("unroll") for (int m = 0; m < 4; ++m) _Pragma("unroll") for (int n = 0; n < 2; ++n) _Pragma("unroll") for (int k = 0; k < 2; ++k) \
        acc[ai][bj][m][n] = __builtin_amdgcn_mfma_f32_16x16x32_bf16(Bt[n][k], At[m][k], acc[ai][bj][m][n], 0, 0, 0); __builtin_amdgcn_s_setprio(0); } while (0)
#define PG8_WAIT_V(n) asm volatile("s_waitcnt vmcnt(" #n ")" ::: "memory")
#define PG8_WAIT_L(n) asm volatile("s_waitcnt lgkmcnt(" #n ")" ::: "memory")
#define PG8_BAR __builtin_amdgcn_s_barrier()
#define PG8_SCHED __builtin_amdgcn_sched_barrier(0)
    Unit cur, nxt; int ui = 0;
    if (!S.next(0, cur)) return;
    f32x4 acc[2][2][4][2];
#pragma unroll
    for (int a = 0; a < 2; ++a)
#pragma unroll
        for (int b = 0; b < 2; ++b)
#pragma unroll
            for (int m = 0; m < 4; ++m)
#pragma unroll
                for (int n = 0; n < 2; ++n) acc[a][b][m][n] = (f32x4){0.f, 0.f, 0.f, 0.f};
    bf16x8 At[4][2], B0[2][2], B1[2][2];
    const char* cA = (const char*)g.A + (size_t)cur.pm * tstep; const char* cB = (const char*)g.Bt + (size_t)cur.pn * tstep;
    S.a_ready(cur);
    if constexpr (SP2) {
        PG8_STAGE(PG8_SB(0, 0), cB, voffB); PG8_STAGE(PG8_SB(0, 1), cB + hstep, voffB); PG8_STAGE(PG8_SA(0, 0), cA, voffA); PG8_STAGE(PG8_SA(0, 1), cA + hstep, voffA);
        if (wr == 1) PG8_BAR;
        PG8_WAIT_V(2); PG8_BAR;
        PG8_STAGE(PG8_SB(1, 0), cB + kstep, voffB); PG8_STAGE(PG8_SA(1, 0), cA + kstep, voffA); PG8_STAGE(PG8_SB(1, 1), cB + hstep + kstep, voffB);
        PG8_WAIT_V(6); PG8_BAR;
    } else {
        PG8_STAGE(PG8_SB(0, 0), cB, voffB); PG8_STAGE(PG8_SA(0, 0), cA, voffA); PG8_STAGE(PG8_SB(0, 1), cB + hstep, voffB); PG8_STAGE(PG8_SA(0, 1), cA + hstep, voffA);
        if (wr == 1) PG8_BAR;
        PG8_WAIT_V(4); PG8_BAR;
        PG8_STAGE(PG8_SB(1, 0), cB + kstep, voffB); PG8_STAGE(PG8_SA(1, 0), cA + kstep, voffA); PG8_STAGE(PG8_SB(1, 1), cB + hstep + kstep, voffB);
        PG8_WAIT_V(6); PG8_BAR;
    }
    for (;;) {
        const bool has_next = S.next(ui + 1, nxt);
        const char* nA = has_next ? (const char*)g.A + (size_t)nxt.pm * tstep : cA; const char* nB = has_next ? (const char*)g.Bt + (size_t)nxt.pn * tstep : cB;
        for (int t = 0; t < nt; t += 2) {
            const bool last = (t == nt - 2);
            const char* a1 = cA + (size_t)(t + 1) * kstep;
            const char* a2 = last ? nA : cA + (size_t)(t + 2) * kstep; const char* b2 = last ? nB : cB + (size_t)(t + 2) * kstep;
            const char* a3 = a2 + kstep; const char* b3 = b2 + kstep;
            if (last && has_next) S.a_ready(nxt);
            if constexpr (SP2) {
            PG8_LDB(B0, 0, 0); PG8_LDB(B1, 0, 1); PG8_SCHED; PG8_LDA(At, 0, 0); PG8_STAGE(PG8_SA(1, 1), a1 + hstep, voffA);
            PG8_WAIT_V(8); PG8_WAIT_L(0); PG8_BAR; PG8_MMA(0, 0, At, B0); PG8_MMA(0, 1, At, B1); PG8_BAR; PG8_SCHED;
            PG8_LDA(At, 0, 1); PG8_STAGE(PG8_SB(0, 0), b2, voffB); PG8_STAGE(PG8_SB(0, 1), b2 + hstep, voffB); PG8_STAGE(PG8_SA(0, 0), a2, voffA);
            PG8_WAIT_V(8); PG8_WAIT_L(0); PG8_BAR; PG8_MMA(1, 0, At, B0); PG8_MMA(1, 1, At, B1); PG8_BAR; PG8_SCHED;
            PG8_LDB(B0, 1, 0); PG8_LDB(B1, 1, 1); PG8_SCHED; PG8_LDA(At, 1, 0); PG8_STAGE(PG8_SA(0, 1), a2 + hstep, voffA);
            PG8_WAIT_V(8); PG8_WAIT_L(0); PG8_BAR; PG8_MMA(0, 0, At, B0); PG8_MMA(0, 1, At, B1); PG8_BAR; PG8_SCHED;
            PG8_LDA(At, 1, 1); PG8_STAGE(PG8_SB(1, 0), b3, voffB); PG8_STAGE(PG8_SB(1, 1), b3 + hstep, voffB); PG8_STAGE(PG8_SA(1, 0), a3, voffA);
            PG8_WAIT_V(8); PG8_WAIT_L(0); PG8_BAR; PG8_MMA(1, 0, At, B0); PG8_MMA(1, 1, At, B1); PG8_BAR; PG8_SCHED;
            } else {
            PG8_LDB(B0, 0, 0); PG8_SCHED; PG8_LDA(At, 0, 0); PG8_STAGE(PG8_SA(1, 1), a1 + hstep, voffA);
            PG8_WAIT_L(8); PG8_BAR; PG8_WAIT_L(0); PG8_MMA(0, 0, At, B0); PG8_BAR; PG8_SCHED;
            PG8_LDB(B1, 0, 1); PG8_STAGE(PG8_SB(0, 0), b2, voffB);
            PG8_BAR; PG8_WAIT_L(0); PG8_MMA(0, 1, At, B1); PG8_BAR;
            PG8_LDA(At, 0, 1); PG8_STAGE(PG8_SA(0, 0), a2, voffA);
            PG8_BAR; PG8_WAIT_L(0); PG8_MMA(1, 0, At, B0); PG8_BAR; PG8_SCHED;
            PG8_STAGE(PG8_SB(0, 1), b2 + hstep, voffB);
            PG8_WAIT_V(6); PG8_BAR; PG8_MMA(1, 1, At, B1); PG8_BAR;
            PG8_LDB(B0, 1, 0); PG8_SCHED; PG8_LDA(At, 1, 0); PG8_STAGE(PG8_SA(0, 1), a2 + hstep, voffA);
            PG8_WAIT_L(8); PG8_BAR; PG8_WAIT_L(0); PG8_MMA(0, 0, At, B0); PG8_BAR; PG8_SCHED;
            PG8_LDB(B1, 1, 1); PG8_STAGE(PG8_SB(1, 0), b3, voffB);
            PG8_BAR; PG8_WAIT_L(0); PG8_MMA(0, 1, At, B1); PG8_BAR;
            PG8_LDA(At, 1, 1); PG8_STAGE(PG8_SA(1, 0), a3, voffA);
            PG8_BAR; PG8_WAIT_L(0); PG8_MMA(1, 0, At, B0); PG8_BAR; PG8_SCHED;
            PG8_STAGE(PG8_SB(1, 1), b3 + hstep, voffB);
            PG8_WAIT_V(6); PG8_BAR; PG8_MMA(1, 1, At, B1); PG8_BAR;
            }
        }
        if constexpr (ALIGN_EPI) { if (wr == 0) PG8_BAR; }
        if constexpr (!Epi::AFTER_DRAIN) { E(acc, cur, wr, wc, fr, fq); S.done(cur); }
        if (!has_next) break;
#pragma unroll
        for (int a = 0; a < 2; ++a)
#pragma unroll
            for (int b = 0; b < 2; ++b)
#pragma unroll
                for (int m = 0; m < 4; ++m)
#pragma unroll
                    for (int n = 0; n < 2; ++n) acc[a][b][m][n] = (f32x4){0.f, 0.f, 0.f, 0.f};
        cur = nxt; cA = nA; cB = nB; ++ui;
        if constexpr (ALIGN_EPI) { if (wr == 1) PG8_BAR; }
    }
    PG8_WAIT_V(0);
    if constexpr (!ALIGN_EPI) { if (wr == 0) PG8_BAR; }
    PG8_BAR;
    if constexpr (Epi::AFTER_DRAIN) { E.fused(acc, cur, wr, wc, fr, fq, lds, wid, lane); S.done(cur); }
#undef PG8_SA
#undef PG8_SB
#undef PG8_STAGE
#undef PG8_LDA
#undef PG8_LDB
#undef PG8_MMA
#undef PG8_WAIT_V
#undef PG8_WAIT_L
#undef PG8_BAR
#undef PG8_SCHED
}
}

#ifndef PG8_SP2
#define PG8_SP2 true
#endif
#ifndef PG8_ALIGN
#define PG8_ALIGN true
#endif
#include <hip/hip_bf16.h>
#include <cmath>
namespace attn_body {
using bf16=__hip_bfloat16;
using bf16x8=__attribute__((ext_vector_type(8)))short;
using s16x4=__attribute__((ext_vector_type(4)))short;
using f32x16=__attribute__((ext_vector_type(16)))float;
using u32x4=__attribute__((ext_vector_type(4)))unsigned;
constexpr int BATCH=8,SEQ=4096,D=64;
constexpr int QP=512,KP=512,VP=512,OP=1024;
constexpr int NW=8,QBLK=32,QB=QBLK*NW,KVBLK=64,NQB=SEQ/QB;
constexpr int ATTN_UNIT_ROWS=QB;
__device__ __forceinline__ int crow(int r,int hi){return (r&3)+8*(r>>2)+4*hi;}
#define SBAR() __builtin_amdgcn_sched_barrier(0)
__device__ __forceinline__ void cmask(f32x16&p0,f32x16&p1,int jb,int qrel,int hi){
  const float NEG=-INFINITY; int kb=64*jb+4*hi;
  #pragma unroll
  for(int r=0;r<16;++r){int kv=kb+(r&3)+8*(r>>2); if(kv>qrel)p0[r]=NEG; if(kv+32>qrel)p1[r]=NEG;}
}

constexpr int NSLOT=3, SLOTB=8192;
constexpr int LDS_K=0, LDS_V=NSLOT*SLOTB, LDS_WS=2*NSLOT*SLOTB, LDS_OST=LDS_WS+NW*64*4, LDS_BYTES=LDS_OST+NW*4096;
constexpr float C2=0.125f*1.4426950408889634f;
__device__ __forceinline__ void glds16(const void*sbase,unsigned voff,unsigned lds_dst){unsigned keep;
  asm volatile("s_mov_b32 %0, m0\n\ts_mov_b32 m0, %2\n\ts_nop 0\n\tglobal_load_lds_dwordx4 %1, %3\n\ts_mov_b32 m0, %0":"=&s"(keep):"v"(voff),"s"(lds_dst),"s"(sbase):"memory");}
__device__ __forceinline__ float max3f(float a,float b,float c){float r;asm("v_max3_f32 %0, %1, %2, %3":"=v"(r):"v"(a),"v"(b),"v"(c));return r;}
__device__ __forceinline__ float max2f(float a,float b){float r;asm("v_max_f32_e32 %0, %1, %2":"=v"(r):"v"(a),"v"(b));return r;}
__device__ __forceinline__ float fadd_s(float a,float b){float r;asm("v_add_f32_e32 %0, %1, %2":"=v"(r):"v"(a),"v"(b));return r;}
__device__ __forceinline__ float fsub_s(float a,float b){float r;asm("v_sub_f32_e32 %0, %1, %2":"=v"(r):"v"(a),"v"(b));return r;}
typedef float f32x2_t __attribute__((ext_vector_type(2))); typedef __bf16 bf16x2_t __attribute__((ext_vector_type(2)));
__device__ __forceinline__ unsigned cvtpk_s(float lo,float hi){f32x2_t v={lo,hi};bf16x2_t b=__builtin_convertvector(v,bf16x2_t);return __builtin_bit_cast(unsigned,b);}
#define WAIT_BAR(N) asm volatile("s_waitcnt vmcnt(" #N ") lgkmcnt(0)\n\ts_barrier":::"memory")

__device__ __forceinline__ void qkt(f32x16&p0,f32x16&p1,const char*Kslot,const bf16x8*qr,const f32x16&negm,int r32,int hi){
  const char*kb=Kslot+hi*1024+r32*16;
  #pragma unroll
  for(int d0=0;d0<4;++d0){
    const bf16x8 b0=*reinterpret_cast<const bf16x8*>(kb+d0*2048);
    const bf16x8 b1=*reinterpret_cast<const bf16x8*>(kb+d0*2048+512);
    if(d0==0){p0=__builtin_amdgcn_mfma_f32_32x32x16_bf16(b0,qr[0],negm,0,0,0);p1=__builtin_amdgcn_mfma_f32_32x32x16_bf16(b1,qr[0],negm,0,0,0);}
    else{p0=__builtin_amdgcn_mfma_f32_32x32x16_bf16(b0,qr[d0],p0,0,0,0);p1=__builtin_amdgcn_mfma_f32_32x32x16_bf16(b1,qr[d0],p1,0,0,0);}}
}
typedef __attribute__((address_space(3))) const char* lds_cptr;
typedef short v4i16_t __attribute__((ext_vector_type(4)));
__device__ __forceinline__ void kload8(bf16x8*kf,lds_cptr kp){
  kf[0]=*(const __attribute__((address_space(3))) bf16x8*)(kp);      kf[1]=*(const __attribute__((address_space(3))) bf16x8*)(kp+512);
  kf[2]=*(const __attribute__((address_space(3))) bf16x8*)(kp+2048); kf[3]=*(const __attribute__((address_space(3))) bf16x8*)(kp+2560);
  kf[4]=*(const __attribute__((address_space(3))) bf16x8*)(kp+4096); kf[5]=*(const __attribute__((address_space(3))) bf16x8*)(kp+4608);
  kf[6]=*(const __attribute__((address_space(3))) bf16x8*)(kp+6144); kf[7]=*(const __attribute__((address_space(3))) bf16x8*)(kp+6656);
}
__device__ __forceinline__ void kload2(bf16x8*kf,lds_cptr kp,int j){ kf[2*j]=*(const __attribute__((address_space(3))) bf16x8*)(kp+j*2048); kf[2*j+1]=*(const __attribute__((address_space(3))) bf16x8*)(kp+j*2048+512); }
__device__ __forceinline__ s16x4 vtr(lds_cptr p){ return __builtin_bit_cast(s16x4,__builtin_amdgcn_ds_read_tr16_b64_v4i16((__attribute__((address_space(3))) v4i16_t*)p)); }
__device__ __forceinline__ float rowmax(const f32x16&p0,const f32x16&p1){
  float a=max3f(p0[0],p0[1],p1[0]),b=max3f(p0[2],p0[3],p1[1]);a=max3f(a,p1[2],p1[3]);
  #pragma unroll
  for(int r=4;r<16;r+=4){a=max3f(a,p0[r],p0[r+1]);b=max3f(b,p0[r+2],p0[r+3]);a=max3f(a,p1[r],p1[r+1]);b=max3f(b,p1[r+2],p1[r+3]);}
  const float m=max2f(a,b);
  auto rr=__builtin_amdgcn_permlane32_swap(__float_as_uint(m),__float_as_uint(m),false,false);
  return max2f(__uint_as_float(rr[0]),__uint_as_float(rr[1]));
}
__device__ __forceinline__ void pv(f32x16*o,int vb,bf16x8 pa0,bf16x8 pa1,bf16x8 pa2,bf16x8 pa3){
  #pragma unroll
  for(int d0=0;d0<2;++d0){s16x4 lo[4],hi[4];
    #pragma unroll
    for(int ks=0;ks<4;++ks){
      asm volatile("ds_read_b64_tr_b16 %0,%1 offset:%c2":"=&v"(lo[ks]):"v"(vb),"i"(d0*4096+ks*1024):"memory");
      asm volatile("ds_read_b64_tr_b16 %0,%1 offset:%c2":"=&v"(hi[ks]):"v"(vb),"i"(d0*4096+ks*1024+512):"memory");}
    asm volatile("s_waitcnt lgkmcnt(0)":::"memory");SBAR();
    #define PK(k) (bf16x8){lo[k][0],lo[k][1],lo[k][2],lo[k][3],hi[k][0],hi[k][1],hi[k][2],hi[k][3]}
    o[d0]=__builtin_amdgcn_mfma_f32_32x32x16_bf16(pa0,PK(0),o[d0],0,0,0);
    o[d0]=__builtin_amdgcn_mfma_f32_32x32x16_bf16(pa1,PK(1),o[d0],0,0,0);
    o[d0]=__builtin_amdgcn_mfma_f32_32x32x16_bf16(pa2,PK(2),o[d0],0,0,0);
    o[d0]=__builtin_amdgcn_mfma_f32_32x32x16_bf16(pa3,PK(3),o[d0],0,0,0);
    #undef PK
  }
}

#ifndef ATTN_STORE16
#define ATTN_STORE16(p,v) (*(u32x4*)(p)=(v))
#endif
template<int THRL> __device__ __forceinline__ void attn_unit(int b,int qb,const bf16*Qh,const bf16*__restrict__ Kh0,const bf16*__restrict__ Vh0,bf16*Oh,float sl,float c32,char*shm,int wid_in,int T0,unsigned*qctr,unsigned qslot){
  const int lane=lane_id_asm(),r32=lane&31,hi=lane>>5; int wid=wid_in; asm volatile("":"+s"(wid));
  const long rowbase=(long)b*SEQ; const int q0=qb*QB;
  const bf16*Qw=Qh+(rowbase+q0+wid*QBLK)*QP;
  const bf16*Kh=Kh0+(rowbase+(long)T0*KVBLK)*KP,*Vh=Vh0+(rowbase+(long)T0*KVBLK)*VP;
  const unsigned lds0=(unsigned)(uintptr_t)shm;
  float*wsf=(float*)(shm+LDS_WS)+wid*64;
  const unsigned koff=(unsigned)(lane*KP+wid*8)*2u;
  const unsigned voff=(unsigned)((16*(wid&3)+(lane>>2))*VP+(wid>>2)*32+(lane&3)*8)*2u;
  const unsigned kdst=lds0+LDS_K+wid*1024, vdst=lds0+LDS_V+wid*1024;
  #define DMA_K(t,slot) glds16(Kh+(long)(t)*KVBLK*KP,koff,(unsigned)__builtin_amdgcn_readfirstlane(kdst+(slot)))
  #define DMA_V(t,slot) glds16(Vh+(long)(t)*KVBLK*VP,voff,(unsigned)__builtin_amdgcn_readfirstlane(vdst+(slot)))
  const char*Kbase=shm+LDS_K; bf16x8 kf[8];
  const lds_cptr shm3=(lds_cptr)shm; const lds_cptr kp0=shm3+LDS_K+hi*1024+r32*16; const lds_cptr vp0=shm3+LDS_V+((lane>>4)&1)*32+(lane&3)*8+(4*hi+((lane&15)>>2))*64;
  const int NT=(q0+QB)/KVBLK-T0;
  DMA_K(0,0);DMA_V(0,0);DMA_K(1,SLOTB);
  bf16x8 qr[4];
  #pragma unroll
  for(int d0=0;d0<4;++d0)qr[d0]=*reinterpret_cast<const bf16x8*>(&Qw[(long)r32*QP+d0*16+hi*8]);
  float l_reg=0.f;f32x16 o[2];o[0]=f32x16{};o[1]=f32x16{};f32x16 negm;
  { float hb_=sl*(float)(4*hi); asm volatile("":"+v"(hb_));
    _Pragma("unroll") for(int r=0;r<16;++r)negm[r]=hb_+sl*(float)((r&3)+8*(r>>2)); }
  asm volatile("":"+v"(negm)); const float sl64=64.f*sl;
  const int qrel=wid*QBLK+r32;
  #define CMASK(P0,P1,t) do{int jb_=(t)-(NT-4); if(jb_>=0)cmask(P0,P1,jb_,qrel,hi);}while(0)
  bool resc=false;
  #define START(P0,P1) do{ const float rm=rowmax(P0,P1); resc=false; \
    { const float dl=rm; \
      _Pragma("unroll") for(int r=0;r<16;++r){P0[r]=fsub_s(P0[r],dl);P1[r]=fsub_s(P1[r],dl);} \
      _Pragma("unroll") for(int r=0;r<16;++r)negm[r]-=dl; asm volatile("":"+v"(negm)); } \
    _Pragma("unroll") for(int r=0;r<16;++r)P0[r]=__builtin_amdgcn_exp2f(P0[r]); }while(0)
  #define RESC() do{ if(resc){ asm volatile("s_waitcnt lgkmcnt(0)":::"memory"); \
      _Pragma("unroll") for(int d_=0;d_<2;++d_) _Pragma("unroll") for(int r=0;r<16;++r)o[d_][r]*=wsf[crow(r,hi)]; } }while(0)
  f32x16 pA0,pA1,pB0,pB1;
  int sl_prev=0,sl_cur=0,sl_next=SLOTB;
  #define ROT() do{sl_prev=sl_cur;sl_cur=sl_next;sl_next=(sl_next==(NSLOT-1)*SLOTB)?0:sl_next+SLOTB;}while(0)
  DMA_K(2,2*SLOTB);
  unsigned nxt_=0u; if(wid==0&&lane==0)nxt_=__hip_atomic_fetch_add(qctr,1u,__ATOMIC_RELAXED,__HIP_MEMORY_SCOPE_AGENT);
  WAIT_BAR(3);
  qkt(pA0,pA1,Kbase,qr,negm,r32,hi);asm volatile("s_nop 15\n\ts_nop 7":"+v"(pA0),"+v"(pA1));CMASK(pA0,pA1,0);
  START(pA0,pA1);
  _Pragma("unroll") for(int r=0;r<16;++r)pA1[r]=__builtin_amdgcn_exp2f(pA1[r]);
  WAIT_BAR(0);
  if(wid==0&&lane==0)*(volatile __attribute__((address_space(3))) unsigned*)(shm3+qslot)=nxt_;
  DMA_K(3,0);DMA_V(1,SLOTB);
  ROT();
  kload8(kf,kp0+sl_cur);
  WAIT_BAR(2);
  s16x4 vlo[8],vhi[8]; u32x4 pw0,pw1,pw2,pw3;
  #define PKW(P,B) cvtpk_s(P[B],P[B+1])
  #define PAF(k) __builtin_bit_cast(bf16x8,pw##k)
  #define VFR(i) (bf16x8){vlo[i][0],vlo[i][1],vlo[i][2],vlo[i][3],vhi[i][0],vhi[i][1],vhi[i][2],vhi[i][3]}
  #define PIN(x) asm volatile("":"+v"(x))
  #define MX3(a,b,c) __builtin_fmaxf(__builtin_fmaxf((a),(b)),(c))
  #define GAPA(MF,SA,A0,A1,A2,A3,W0,W1,PW) do{ MF; SA+=A0; SA+=A1; SA+=A2; SA+=A3; PIN(SA); W0; W1; PIN(PW); SBAR(); }while(0)
  #define GAPA2(MF,A0,A1,B0_,B1_,W0,W1,PW) do{ MF; sacc+=A0; sacc+=A1; saccb=B0_+B1_; PIN(sacc); PIN(saccb); W0; W1; PIN(PW); SBAR(); }while(0)
  #define EX(v) __builtin_amdgcn_exp2f(v)
  #define GAPB(MF,X,B) do{ MF; X[B]=EX(X[B]); X[B+1]=EX(X[B+1]); X[B+2]=EX(X[B+2]); X[B+3]=EX(X[B+3]); PIN(X); SBAR(); }while(0)
  #define VRD(i) do{ vlo[i]=vtr(vp_+(((i)>>2)*4096+((i)&3)*1024)); vhi[i]=vtr(vp_+(((i)>>2)*4096+((i)&3)*1024+512)); }while(0)
  #define KRD(G,j) do{ if(G){ kload2(kf,kp0+sl_next,j); SBAR(); } }while(0)
  #define STEP(C0,C1,P0,P1,t,GK,GV,GL) do{ SBAR(); \
    _Pragma("unroll") for(int r=0;r<16;++r)negm[r]+=sl64; asm volatile("":"+v"(negm)); SBAR(); \
    const lds_cptr vp_=vp0+sl_prev; \
    VRD(0); SBAR(); float sacc=(P0[0]+P0[1]); float saccb; \
    GAPA(C0=__builtin_amdgcn_mfma_f32_32x32x16_bf16(kf[0],qr[0],negm,0,0,0), sacc, P0[2],P0[3],P0[4],P0[5],     pw0[0]=PKW(P0,0), pw0[1]=PKW(P0,2), pw0); \
    VRD(4); SBAR(); GAPA(C1=__builtin_amdgcn_mfma_f32_32x32x16_bf16(kf[1],qr[0],negm,0,0,0), sacc, P0[6],P0[7],P0[8],P0[9],     pw0[2]=PKW(P0,4), pw0[3]=PKW(P0,6), pw0); \
    VRD(1); SBAR(); GAPA(C0=__builtin_amdgcn_mfma_f32_32x32x16_bf16(kf[2],qr[1],C0,0,0,0),   sacc, P0[10],P0[11],P0[12],P0[13], pw1[0]=PKW(P0,8), pw1[1]=PKW(P0,10), pw1); \
    VRD(5); SBAR(); GAPA2(C1=__builtin_amdgcn_mfma_f32_32x32x16_bf16(kf[3],qr[1],C1,0,0,0),   P0[14],P0[15],P1[0],P1[1],   pw1[2]=PKW(P0,12),pw1[3]=PKW(P0,14), pw1); \
    VRD(2); SBAR(); GAPA(C0=__builtin_amdgcn_mfma_f32_32x32x16_bf16(kf[4],qr[2],C0,0,0,0),   saccb, P1[2],P1[3],P1[4],P1[5],     pw2[0]=PKW(P1,0), pw2[1]=PKW(P1,2), pw2); \
    VRD(6); SBAR(); GAPA(C1=__builtin_amdgcn_mfma_f32_32x32x16_bf16(kf[5],qr[2],C1,0,0,0),   saccb, P1[6],P1[7],P1[8],P1[9],     pw2[2]=PKW(P1,4), pw2[3]=PKW(P1,6), pw2); \
    VRD(3); SBAR(); GAPA(C0=__builtin_amdgcn_mfma_f32_32x32x16_bf16(kf[6],qr[3],C0,0,0,0),   saccb, P1[10],P1[11],P1[12],P1[13], pw3[0]=PKW(P1,8), pw3[1]=PKW(P1,10), pw3); \
    VRD(7); SBAR(); GAPA(C1=__builtin_amdgcn_mfma_f32_32x32x16_bf16(kf[7],qr[3],C1,0,0,0),   saccb, P1[14],P1[15],0.f,0.f,       pw3[2]=PKW(P1,12),pw3[3]=PKW(P1,14), pw3); \
    l_reg+=sacc+c32*saccb; \
    if(GK){DMA_K((t)+3,sl_cur);} if(GV){DMA_V((t)+1,sl_next);} \
    CMASK(C0,C1,t); \
    { float a=MX3(C0[0],C0[1],C1[0]),b=MX3(C0[2],C0[3],C1[1]); a=MX3(a,C1[2],C1[3]); \
      _Pragma("unroll") for(int r=4;r<16;r+=4){a=MX3(a,C0[r],C0[r+1]);b=MX3(b,C0[r+2],C0[r+3]);a=MX3(a,C1[r],C1[r+1]);b=MX3(b,C1[r+2],C1[r+3]);} \
      float rm=__builtin_fmaxf(a,b); { auto rr=__builtin_amdgcn_permlane32_swap(__float_as_uint(rm),__float_as_uint(rm),false,false); rm=__builtin_fmaxf(__uint_as_float(rr[0]),__uint_as_float(rr[1])); } \
      resc=false; \
      if(__builtin_expect(__any(rm>(float)THRL),0)){ const float dl=__builtin_fmaxf(rm,0.f); \
        _Pragma("unroll") for(int r=0;r<16;++r){C0[r]-=dl;C1[r]-=dl;} \
        _Pragma("unroll") for(int r=0;r<16;++r)negm[r]-=dl; asm volatile("":"+v"(negm)); \
        const float f=__builtin_amdgcn_exp2f(-dl); l_reg*=f; if(hi==0)wsf[r32]=f; resc=true; } } \
    SBAR(); \
    GAPB(o[0]=__builtin_amdgcn_mfma_f32_32x32x16_bf16(PAF(0),VFR(0),o[0],0,0,0), C0,0); \
    GAPB(o[1]=__builtin_amdgcn_mfma_f32_32x32x16_bf16(PAF(0),VFR(4),o[1],0,0,0), C0,4); \
    KRD(GL,0); GAPB(o[0]=__builtin_amdgcn_mfma_f32_32x32x16_bf16(PAF(1),VFR(1),o[0],0,0,0), C0,8); \
    KRD(GL,1); GAPB(o[1]=__builtin_amdgcn_mfma_f32_32x32x16_bf16(PAF(1),VFR(5),o[1],0,0,0), C0,12); \
    KRD(GL,2); GAPB(o[0]=__builtin_amdgcn_mfma_f32_32x32x16_bf16(PAF(2),VFR(2),o[0],0,0,0), C1,0); \
    KRD(GL,3); GAPB(o[1]=__builtin_amdgcn_mfma_f32_32x32x16_bf16(PAF(2),VFR(6),o[1],0,0,0), C1,4); \
    GAPB(o[0]=__builtin_amdgcn_mfma_f32_32x32x16_bf16(PAF(3),VFR(3),o[0],0,0,0), C1,8); \
    GAPB(o[1]=__builtin_amdgcn_mfma_f32_32x32x16_bf16(PAF(3),VFR(7),o[1],0,0,0), C1,12); \
    }while(0)
  int t=1;
  #undef CMASK
  #define CMASK(P0,P1,t) do{}while(0)
  for(;t+5<NT;t+=2){
    STEP(pB0,pB1,pA0,pA1,t,true,true,true);     WAIT_BAR(2); RESC(); ROT();
    STEP(pA0,pA1,pB0,pB1,t+1,true,true,true);   WAIT_BAR(2); RESC(); ROT();
  }
  #undef CMASK
  #define CMASK(P0,P1,t) do{int jb_=(t)-(NT-4); if(jb_>=0)cmask(P0,P1,jb_,qrel,hi);}while(0)
  #define ENDW(tt) do{ if((tt)+3<NT){WAIT_BAR(2);} else if((tt)+2<NT){WAIT_BAR(1);} else {WAIT_BAR(0);} }while(0)
  for(;t+1<NT;t+=2){
    STEP(pB0,pB1,pA0,pA1,t,(t+3<NT),(t+1<NT),(t+1<NT));       ENDW(t);   RESC(); ROT();
    STEP(pA0,pA1,pB0,pB1,t+1,(t+4<NT),(t+2<NT),(t+2<NT));     ENDW(t+1); RESC(); ROT();
  }
  STEP(pB0,pB1,pA0,pA1,NT-1,false,false,false); RESC();
  { float sacc=pB0[0]+pB0[1]; _Pragma("unroll") for(int r=2;r<16;++r)sacc+=pB0[r]; float saccb=pB1[0]+pB1[1]; _Pragma("unroll") for(int r=2;r<16;++r)saccb+=pB1[r]; l_reg+=sacc+c32*saccb;
    pw0=(u32x4){PKW(pB0,0),PKW(pB0,2),PKW(pB0,4),PKW(pB0,6)};pw1=(u32x4){PKW(pB0,8),PKW(pB0,10),PKW(pB0,12),PKW(pB0,14)};pw2=(u32x4){PKW(pB1,0),PKW(pB1,2),PKW(pB1,4),PKW(pB1,6)};pw3=(u32x4){PKW(pB1,8),PKW(pB1,10),PKW(pB1,12),PKW(pB1,14)};
    SBAR(); pv(o,(int)(unsigned)(unsigned long)(vp0+sl_cur),PAF(0),PAF(1),PAF(2),PAF(3)); }
  #undef PKW
  #undef PAF
  #undef VFR
  #undef PIN
  #undef MX3
  #undef GAPA
  #undef GAPA2
  #undef GAPB
  #undef EX
  #undef VRD
  #undef KRD
  #undef STEP
  #undef ENDW
  {auto rr=__builtin_amdgcn_permlane32_swap(__float_as_uint(l_reg),__float_as_uint(l_reg),false,false);l_reg=__uint_as_float(rr[0])+__uint_as_float(rr[1]);}
  if(hi==0)wsf[32+r32]=l_reg;asm volatile("s_waitcnt lgkmcnt(0)":::"memory");
  float rli[16];
  #pragma unroll
  for(int r=0;r<16;++r)rli[r]=__builtin_amdgcn_rcpf(wsf[32+crow(r,hi)]);
  bf16*Ow=Oh+(rowbase+q0+wid*QBLK)*OP;
  { bf16*stg=(bf16*)(shm+LDS_OST)+wid*2048;
    #pragma unroll
    for(int r=0;r<16;++r){const int orow=crow(r,hi);
      #pragma unroll
      for(int d0=0;d0<2;++d0)stg[orow*64+d0*32+r32]=__float2bfloat16(o[d0][r]*rli[r]);}
    asm volatile("s_waitcnt lgkmcnt(0)":::"memory");
    #pragma unroll
    for(int i=0;i<4;++i){const int row=i*8+(lane>>3),ch=lane&7; const u32x4 v=*(const u32x4*)(stg+row*64+ch*8); ATTN_STORE16(Ow+(long)row*OP+ch*8,v);} }
  asm volatile("s_waitcnt lgkmcnt(0)\n\ts_barrier":::"memory");
  #undef DMA_K
  #undef DMA_V
  #undef CMASK
  #undef START
  #undef RESC
  #undef ROT
}
constexpr int ATTN_LDS_BYTES=LDS_BYTES;
constexpr int A2_K=0, A2_V=4*8192, A2_WS=A2_V+3*16384, A2_BYTES=A2_WS+NW*256;
__device__ __forceinline__ void attn_unit2(int b,int qb,const bf16*Qh,const bf16*__restrict__ Kh0,const bf16*__restrict__ Vh0,bf16*Oh,float sl,float c32,char*shm,int wid_in,int T0,unsigned*qctr,unsigned qslot){
  const int lane=lane_id_asm(),r32=lane&31,hi=lane>>5; int wid=wid_in; asm volatile("":"+s"(wid));
  const long rowbase=(long)b*SEQ; const int q0=qb*QB;
  const bf16*Qw=Qh+(rowbase+q0+wid*QBLK)*QP;
  const bf16*Kh=Kh0+(rowbase+(long)T0*KVBLK)*KP,*Vh=Vh0+(rowbase+(long)T0*KVBLK)*VP;
  const unsigned lds0=(unsigned)(uintptr_t)shm;
  float*wsf=(float*)(shm+A2_WS)+wid*64;
  const unsigned koff=(unsigned)(lane*KP+wid*8)*2u;
  const unsigned voff=(unsigned)((16*(wid&3)+(lane>>2))*VP+(wid>>2)*32+(lane&3)*8)*2u;
  const unsigned kdst=lds0+A2_K+wid*1024, vdst=lds0+A2_V+wid*1024;
  #define DMA_K(t,slot) glds16(Kh+(long)(t)*KVBLK*KP,koff,(unsigned)__builtin_amdgcn_readfirstlane(kdst+(slot)))
  #define DMA_V(t,slot) do{ glds16(Vh+(long)(t)*KVBLK*VP,voff,(unsigned)__builtin_amdgcn_readfirstlane(vdst+2*(slot))); glds16(Vh+(long)(t)*KVBLK*VP+64,voff,(unsigned)__builtin_amdgcn_readfirstlane(vdst+2*(slot)+8192)); }while(0)
  const char*Kbase=shm+A2_K; bf16x8 kf[8];
  const lds_cptr shm3=(lds_cptr)shm; const lds_cptr kp0=shm3+A2_K+hi*1024+r32*16; const lds_cptr vp0=shm3+A2_V+((lane>>4)&1)*32+(lane&3)*8+(4*hi+((lane&15)>>2))*64;
  const int NT=(q0+QB)/KVBLK-T0;
  DMA_K(0,0);DMA_V(0,0);DMA_K(1,8192);
  bf16x8 qr[4];
  #pragma unroll
  for(int d0=0;d0<4;++d0)qr[d0]=*reinterpret_cast<const bf16x8*>(&Qw[(long)r32*QP+d0*16+hi*8]);
  float l_reg=0.f;f32x16 o[4];o[0]=f32x16{};o[1]=f32x16{};o[2]=f32x16{};o[3]=f32x16{};f32x16 negm;
  { float hb_=sl*(float)(64*T0-q0-QBLK*wid-r32+4*hi); asm volatile("":"+v"(hb_));
    _Pragma("unroll") for(int r=0;r<16;++r)negm[r]=hb_+sl*(float)((r&3)+8*(r>>2)); }
  asm volatile("":"+v"(negm)); const float sl64=64.f*sl;
  const int qrel=wid*QBLK+r32;
  #define CMASK(P0,P1,t) do{int jb_=(t)-(NT-4); if(jb_>=0)cmask(P0,P1,jb_,qrel,hi);}while(0)
  int sl_prev=0,sl_cur=0,sl_next=8192;
  #define ROT() do{sl_prev=sl_cur;sl_cur=sl_next;sl_next=(sl_next==2*8192)?0:sl_next+8192;}while(0)
  DMA_K(2,2*8192);
  #define KSL(t) (((t)&3)*8192)
  unsigned nxt_=0u; if(wid==0&&lane==0)nxt_=__hip_atomic_fetch_add(qctr,1u,__ATOMIC_RELAXED,__HIP_MEMORY_SCOPE_AGENT);
  WAIT_BAR(3);
  u32x4 pwA0,pwA1,pwA2,pwA3,pwB0,pwB1,pwB2,pwB3;
  #define PKW(P,B) cvtpk_s(P[B],P[B+1])
  #define EX(v) __builtin_amdgcn_exp2f(v)
  #define PIN(x) asm volatile("":"+v"(x))
  { f32x16 c0,c1; qkt(c0,c1,Kbase,qr,negm,r32,hi); CMASK(c0,c1,0);
    float sa=0.f,sb=0.f;
    _Pragma("unroll") for(int r=0;r<16;++r){c0[r]=EX(c0[r]);c1[r]=EX(c1[r]);sa+=c0[r];sb+=c1[r];}
    l_reg+=sa+c32*sb;
    pwA0=(u32x4){PKW(c0,0),PKW(c0,2),PKW(c0,4),PKW(c0,6)};pwA1=(u32x4){PKW(c0,8),PKW(c0,10),PKW(c0,12),PKW(c0,14)};pwA2=(u32x4){PKW(c1,0),PKW(c1,2),PKW(c1,4),PKW(c1,6)};pwA3=(u32x4){PKW(c1,8),PKW(c1,10),PKW(c1,12),PKW(c1,14)}; }
  WAIT_BAR(0);
  if(wid==0&&lane==0)*(volatile __attribute__((address_space(3))) unsigned*)(shm3+qslot)=nxt_;
  DMA_K(3,3*8192);DMA_V(1,8192);
  ROT();
  kload2(kf,kp0+KSL(1),0); kload2(kf,kp0+KSL(1),1);
  _Pragma("unroll") for(int r=0;r<16;++r)negm[r]+=sl64;
  s16x4 vlo[8],vhi[8];
  #define PAFI(PI,k) __builtin_bit_cast(bf16x8,PI##k)
  #define VFR(i) (bf16x8){vlo[i][0],vlo[i][1],vlo[i][2],vlo[i][3],vhi[i][0],vhi[i][1],vhi[i][2],vhi[i][3]}
  #define VRD(ks,d) do{ vlo[((ks)&1)*4+(d)]=vtr(vp_+((d)*4096+(ks)*1024)); vhi[((ks)&1)*4+(d)]=vtr(vp_+((d)*4096+(ks)*1024+512)); }while(0)
  #define GAPQ(MF) do{ MF; SBAR(); }while(0)
  #define GAPN(MF,B) do{ MF; negm[B]+=sl64; negm[B+1]+=sl64; negm[B+2]+=sl64; negm[B+3]+=sl64; PIN(negm); SBAR(); }while(0)
  #define GAPB(MF,RD,X,SA,B,PO,W) do{ MF; RD; X[B]=EX(X[B]); X[B+1]=EX(X[B+1]); SA+=X[B]; SA+=X[B+1]; PO[W]=PKW(X,B); PIN(X); PIN(SA); PIN(PO); SBAR(); }while(0)
  #define STEP2(PI,PO,t,GK,GV,GL) do{ SBAR(); \
    const lds_cptr vp_=vp0+2*sl_prev; const lds_cptr kq_=kp0+KSL(t); f32x16 C0,C1; float sa=0.f,sb=0.f; \
    kload2(kf,kq_,2); VRD(0,0); SBAR(); kload2(kf,kq_,3); VRD(0,1); SBAR(); \
    GAPQ(C0=__builtin_amdgcn_mfma_f32_32x32x16_bf16(kf[0],qr[0],negm,0,0,0)); \
    VRD(0,2); SBAR(); GAPQ(C1=__builtin_amdgcn_mfma_f32_32x32x16_bf16(kf[1],qr[0],negm,0,0,0)); \
    VRD(0,3); SBAR(); GAPN(C0=__builtin_amdgcn_mfma_f32_32x32x16_bf16(kf[2],qr[1],C0,0,0,0),0); \
    VRD(1,0); SBAR(); GAPN(C1=__builtin_amdgcn_mfma_f32_32x32x16_bf16(kf[3],qr[1],C1,0,0,0),4); \
    VRD(1,1); SBAR(); GAPN(C0=__builtin_amdgcn_mfma_f32_32x32x16_bf16(kf[4],qr[2],C0,0,0,0),8); \
    VRD(1,2); SBAR(); GAPN(C1=__builtin_amdgcn_mfma_f32_32x32x16_bf16(kf[5],qr[2],C1,0,0,0),12); \
    VRD(1,3); SBAR(); GAPQ(C0=__builtin_amdgcn_mfma_f32_32x32x16_bf16(kf[6],qr[3],C0,0,0,0)); \
    GAPQ(C1=__builtin_amdgcn_mfma_f32_32x32x16_bf16(kf[7],qr[3],C1,0,0,0)); \
    if(GK){DMA_K((t)+3,KSL((t)+3));} if(GV){DMA_V((t)+1,sl_next);} \
    CMASK(C0,C1,t); SBAR(); \
    GAPB(o[0]=__builtin_amdgcn_mfma_f32_32x32x16_bf16(PAFI(PI,0),VFR(0),o[0],0,0,0), VRD(2,0), C0,sa,0, PO##0,0); \
    GAPB(o[1]=__builtin_amdgcn_mfma_f32_32x32x16_bf16(PAFI(PI,0),VFR(1),o[1],0,0,0), VRD(2,1), C0,sa,2, PO##0,1); \
    GAPB(o[2]=__builtin_amdgcn_mfma_f32_32x32x16_bf16(PAFI(PI,0),VFR(2),o[2],0,0,0), VRD(2,2), C0,sa,4, PO##0,2); \
    GAPB(o[3]=__builtin_amdgcn_mfma_f32_32x32x16_bf16(PAFI(PI,0),VFR(3),o[3],0,0,0), VRD(2,3), C0,sa,6, PO##0,3); \
    GAPB(o[0]=__builtin_amdgcn_mfma_f32_32x32x16_bf16(PAFI(PI,1),VFR(4),o[0],0,0,0), VRD(3,0), C0,sa,8, PO##1,0); \
    GAPB(o[1]=__builtin_amdgcn_mfma_f32_32x32x16_bf16(PAFI(PI,1),VFR(5),o[1],0,0,0), VRD(3,1), C0,sa,10, PO##1,1); \
    GAPB(o[2]=__builtin_amdgcn_mfma_f32_32x32x16_bf16(PAFI(PI,1),VFR(6),o[2],0,0,0), VRD(3,2), C0,sa,12, PO##1,2); \
    GAPB(o[3]=__builtin_amdgcn_mfma_f32_32x32x16_bf16(PAFI(PI,1),VFR(7),o[3],0,0,0), VRD(3,3), C0,sa,14, PO##1,3); \
    GAPB(o[0]=__builtin_amdgcn_mfma_f32_32x32x16_bf16(PAFI(PI,2),VFR(0),o[0],0,0,0), (void)0, C1,sb,0, PO##2,0); \
    GAPB(o[1]=__builtin_amdgcn_mfma_f32_32x32x16_bf16(PAFI(PI,2),VFR(1),o[1],0,0,0), if(GL){kload2(kf,kp0+KSL((t)+1),0);}, C1,sb,2, PO##2,1); \
    GAPB(o[2]=__builtin_amdgcn_mfma_f32_32x32x16_bf16(PAFI(PI,2),VFR(2),o[2],0,0,0), (void)0, C1,sb,4, PO##2,2); \
    GAPB(o[3]=__builtin_amdgcn_mfma_f32_32x32x16_bf16(PAFI(PI,2),VFR(3),o[3],0,0,0), if(GL){kload2(kf,kp0+KSL((t)+1),1);}, C1,sb,6, PO##2,3); \
    GAPB(o[0]=__builtin_amdgcn_mfma_f32_32x32x16_bf16(PAFI(PI,3),VFR(4),o[0],0,0,0), (void)0, C1,sb,8, PO##3,0); \
    GAPB(o[1]=__builtin_amdgcn_mfma_f32_32x32x16_bf16(PAFI(PI,3),VFR(5),o[1],0,0,0), (void)0, C1,sb,10, PO##3,1); \
    GAPB(o[2]=__builtin_amdgcn_mfma_f32_32x32x16_bf16(PAFI(PI,3),VFR(6),o[2],0,0,0), (void)0, C1,sb,12, PO##3,2); \
    GAPB(o[3]=__builtin_amdgcn_mfma_f32_32x32x16_bf16(PAFI(PI,3),VFR(7),o[3],0,0,0), (void)0, C1,sb,14, PO##3,3); \
    l_reg+=sa+c32*sb; \
    }while(0)
  int t=1;
  #undef CMASK
  #define CMASK(P0,P1,t) do{}while(0)
  for(;t+5<NT;t+=2){
    STEP2(pwA,pwB,t,true,true,true);     WAIT_BAR(3); ROT();
    STEP2(pwB,pwA,t+1,true,true,true);   WAIT_BAR(3); ROT();
  }
  #undef CMASK
  #define CMASK(P0,P1,t) do{int jb_=(t)-(NT-4); if(jb_>=0)cmask(P0,P1,jb_,qrel,hi);}while(0)
  #define ENDW(tt) do{ if((tt)+3<NT){WAIT_BAR(3);} else if((tt)+2<NT){WAIT_BAR(2);} else {WAIT_BAR(0);} }while(0)
  for(;t+1<NT;t+=2){
    STEP2(pwA,pwB,t,(t+3<NT),(t+1<NT),(t+1<NT));       ENDW(t);   ROT();
    STEP2(pwB,pwA,t+1,(t+4<NT),(t+2<NT),(t+2<NT));     ENDW(t+1); ROT();
  }
  STEP2(pwA,pwB,NT-1,false,false,false);
  { const int vb=(int)(unsigned)(unsigned long)(vp0+2*sl_cur);
    #pragma unroll
    for(int d0=0;d0<4;++d0){s16x4 lo[4],hh[4];
      #pragma unroll
      for(int ks=0;ks<4;++ks){
        asm volatile("ds_read_b64_tr_b16 %0,%1 offset:%c2":"=&v"(lo[ks]):"v"(vb),"i"(d0*4096+ks*1024):"memory");
        asm volatile("ds_read_b64_tr_b16 %0,%1 offset:%c2":"=&v"(hh[ks]):"v"(vb),"i"(d0*4096+ks*1024+512):"memory");}
      asm volatile("s_waitcnt lgkmcnt(0)":::"memory");SBAR();
      #define PK(k) (bf16x8){lo[k][0],lo[k][1],lo[k][2],lo[k][3],hh[k][0],hh[k][1],hh[k][2],hh[k][3]}
      o[d0]=__builtin_amdgcn_mfma_f32_32x32x16_bf16(PAFI(pwB,0),PK(0),o[d0],0,0,0);
      o[d0]=__builtin_amdgcn_mfma_f32_32x32x16_bf16(PAFI(pwB,1),PK(1),o[d0],0,0,0);
      o[d0]=__builtin_amdgcn_mfma_f32_32x32x16_bf16(PAFI(pwB,2),PK(2),o[d0],0,0,0);
      o[d0]=__builtin_amdgcn_mfma_f32_32x32x16_bf16(PAFI(pwB,3),PK(3),o[d0],0,0,0);
      #undef PK
    } }
  {auto rr=__builtin_amdgcn_permlane32_swap(__float_as_uint(l_reg),__float_as_uint(l_reg),false,false);l_reg=__uint_as_float(rr[0])+__uint_as_float(rr[1]);}
  if(hi==0)wsf[32+r32]=l_reg;
  asm volatile("s_waitcnt lgkmcnt(0)\n\ts_barrier":::"memory");
  float rli[16];
  #pragma unroll
  for(int r=0;r<16;++r)rli[r]=__builtin_amdgcn_rcpf(wsf[32+crow(r,hi)]);
  bf16*Ow=Oh+(rowbase+q0+wid*QBLK)*OP;
  { bf16*stg=(bf16*)(shm)+wid*4096;
    #pragma unroll
    for(int r=0;r<16;++r){const int orow=crow(r,hi);
      #pragma unroll
      for(int d0=0;d0<4;++d0)stg[orow*128+d0*32+r32]=__float2bfloat16(o[d0][r]*rli[r]);}
    asm volatile("s_waitcnt lgkmcnt(0)":::"memory");
    #pragma unroll
    for(int i=0;i<8;++i){const int row=i*4+(lane>>4),ch=lane&15; const u32x4 v=*(const u32x4*)(stg+row*128+ch*8); ATTN_STORE16(Ow+(long)row*OP+ch*8,v);} }
  asm volatile("s_waitcnt lgkmcnt(0)\n\ts_barrier":::"memory");
  #undef DMA_K
  #undef DMA_V
  #undef CMASK
  #undef ROT
  #undef PKW
  #undef EX
  #undef PIN
  #undef PAFI
  #undef VFR
  #undef VRD
  #undef KSL
  #undef GAPQ
  #undef GAPN
  #undef GAPB
  #undef STEP2
  #undef ENDW
}
#undef SBAR
#undef WAIT_BAR
}

constexpr int NWAVES = 8;
constexpr int M = 32768, DMODEL = 1024, NIN = 3584, SEQL = 4096;
constexpr size_t MiB = 1u << 20;
constexpr size_t WS_ROWSS = 0;
constexpr size_t WS_WIN = 2 * MiB, WS_WO = 10 * MiB, WS_PW = 12 * MiB;
constexpr size_t WS_XN = 16 * MiB, WS_O = WS_XN;
constexpr size_t WS_HG = 80 * MiB, WS_CG = 112 * MiB, WS_Q = 144 * MiB, WS_K = 176 * MiB, WS_V = 208 * MiB, WS_DG = 240 * MiB, WS_U = 272 * MiB;
constexpr size_t WS_Y = 304 * MiB, WS_Y2 = 368 * MiB, WS_END = 432 * MiB;
constexpr int RING_BYTES = 131072, LDS_BYTES = 147456, LDSCTL_OFF = RING_BYTES;
constexpr size_t WS_BAR = 512 * 1024, WS_BAR_BYTES = 16384;
constexpr int NMAX_WORD = 3600, QCTR_WORD = 3712;
#define GAS __attribute__((address_space(1)))
#define LAS __attribute__((address_space(3)))
typedef unsigned short bf16;
typedef unsigned v4u __attribute__((ext_vector_type(4)));
typedef unsigned v2u __attribute__((ext_vector_type(2)));
typedef float f32x4 __attribute__((ext_vector_type(4)));
typedef float f32x2 __attribute__((ext_vector_type(2)));
#define LDS_WAIT() asm volatile("s_waitcnt lgkmcnt(0)" ::: "memory")
__device__ __forceinline__ unsigned pk2(float lo, float hi) { return pg8::cvt_pk_bf16(lo, hi); }
__device__ __forceinline__ float wave_sum(float v) {
#pragma unroll
    for (int o = 1; o < 64; o <<= 1) v += __shfl_xor(v, o);
    return v;
}
__device__ __forceinline__ void p0_transpose_item(const float* W, int K, int N, bf16* WT, int k0, int n0, int dst_row0, LAS float* scr, int lane) {
#pragma unroll
    for (int i = 0; i < 32; ++i) { const int kk = 2 * i + (lane >> 5); scr[kk * 33 + (lane & 31)] = W[(size_t)(k0 + kk) * N + n0 + (lane & 31)]; }
    LDS_WAIT(); asm volatile("" ::: "memory");
    const int c = lane & 7;
#pragma unroll
    for (int j = 0; j < 4; ++j) { const int n = (lane >> 3) + 8 * j; const LAS float* p = scr + (8 * c) * 33 + n;
        v4u o; o.x = pk2(p[0 * 33], p[1 * 33]); o.y = pk2(p[2 * 33], p[3 * 33]); o.z = pk2(p[4 * 33], p[5 * 33]); o.w = pk2(p[6 * 33], p[7 * 33]);
        *(v4u*)(WT + (size_t)(dst_row0 + n) * K + k0 + 8 * c) = o; }
    LDS_WAIT(); asm volatile("" ::: "memory");
}
__device__ __forceinline__ int win_dst_row(int n0) {
    if (n0 >= 1024) return n0;
    if (n0 < 512) return 256 * (n0 >> 7) + (n0 & 127);
    const int n1 = n0 - 512; return 256 * (n1 >> 7) + 128 + (n1 & 127);
}

#define RLX_AGENT __ATOMIC_RELAXED, __HIP_MEMORY_SCOPE_AGENT
#define XB_TMO      128
#define XB_XCNT(j)  (256  + 64 * (j))
#define XB_XSUB(j)  (1280 + 64 * (j))
#define XB_XGEN(j)  (2304 + 64 * (j))
#define XB_TOP      3328
#define XB_TOPGEN   3392
#define XCD_BAR_WORDS 3456
#define XB_SPIN_CAP (1u << 18)

__device__ __forceinline__ unsigned xb_ld(unsigned* p)              { return __hip_atomic_load(p, __ATOMIC_RELAXED, __HIP_MEMORY_SCOPE_AGENT); }
__device__ __forceinline__ unsigned xb_add(unsigned* p, unsigned v) { return __hip_atomic_fetch_add(p, v, __ATOMIC_RELAXED, __HIP_MEMORY_SCOPE_AGENT); }
__device__ __forceinline__ unsigned xb_xcc_id() { return (unsigned)__builtin_amdgcn_s_getreg((3 << 11) | 20) & 0xFu; }
#define XB_SPIN(cond, bar) do { unsigned _sp = 0; while (cond) { __builtin_amdgcn_s_sleep(1); \
    if ((++_sp & 255u) == 0u) { if (xb_ld(&(bar)[XB_TMO])) break; if (_sp > XB_SPIN_CAP) { atomicAdd(&(bar)[XB_TMO], 1u); break; } } } } while (0)

struct XcdBarrier {
    unsigned* bar; unsigned x;
    volatile LAS unsigned* st;
};

__device__ __forceinline__ XcdBarrier xcd_barrier_post(unsigned* bar, volatile LAS unsigned* st) {
    XcdBarrier b; b.bar = bar; b.x = xb_xcc_id(); b.st = st;
    if (threadIdx.x == 0) (void)xb_add(&bar[XB_XCNT(b.x)], 1u);
    return b;
}
__device__ __forceinline__ void xcd_barrier_complete(unsigned* bar, unsigned x, unsigned& nloc, unsigned& nx) {
    const unsigned G = gridDim.x * gridDim.y * gridDim.z;
    unsigned sum, cnt, mine, sp = 0u;
    for (;;) {
        sum = 0u; cnt = 0u; mine = 0u;
#pragma unroll
        for (unsigned j = 0; j < 16; ++j) { const unsigned c = xb_ld(&bar[XB_XCNT(j)]); sum += c; cnt += (c > 0u) ? 1u : 0u; mine = (j == x) ? c : mine; }
        if (sum == G) break;
        __builtin_amdgcn_s_sleep(1);
        if ((++sp & 255u) == 0u) { if (xb_ld(&bar[XB_TMO])) break; if (sp > XB_SPIN_CAP) { atomicAdd(&bar[XB_TMO], 1u); break; } }
    }
    nloc = mine > 0u ? mine : 1u; nx = cnt > 0u ? cnt : 1u;
}

__device__ __forceinline__ void xcd_barrier(const XcdBarrier& b) {
    asm volatile("s_waitcnt vmcnt(0)" ::: "memory");
    __syncthreads();
    if (threadIdx.x == 0) {
        unsigned* bar = b.bar;
        __builtin_amdgcn_s_waitcnt(0);
        unsigned nloc = b.st[0], nx = b.st[1];
        if (nloc == 0u) { xcd_barrier_complete(bar, b.x, nloc, nx); b.st[0] = nloc; b.st[1] = nx; }
        const unsigned old = xb_add(&bar[XB_XSUB(b.x)], 1u);
        const unsigned gen = old / nloc;
        if (old + 1u == (gen + 1u) * nloc) {
            __builtin_amdgcn_fence(__ATOMIC_RELEASE, "agent");
            asm volatile("s_waitcnt vmcnt(0)" ::: "memory");
            const unsigned og = xb_add(&bar[XB_TOP], 1u);
            const unsigned tg = og / nx;
            if (og + 1u == (tg + 1u) * nx) xb_add(&bar[XB_TOPGEN], 1u);
            else XB_SPIN(xb_ld(&bar[XB_TOPGEN]) == tg, bar);
            __builtin_amdgcn_fence(__ATOMIC_ACQUIRE, "agent");
            xb_add(&bar[XB_XGEN(b.x)], 1u);
            asm volatile("s_waitcnt vmcnt(0)" ::: "memory");
        } else {
            XB_SPIN(xb_ld(&bar[XB_XGEN(b.x)]) == gen, bar);
            __builtin_amdgcn_fence(__ATOMIC_ACQUIRE, "agent");
            asm volatile("s_waitcnt vmcnt(0)" ::: "memory");
        }
    }
    __syncthreads();
}

constexpr int CONV_IN_BYTES = 62 * 1024;
__device__ __forceinline__ void conv_phase(LAS unsigned char* lds, int u0, int ustride, int nunits, const bf16* Hg, const float* dw_w, const float* dw_b, const float* ln_g, const float* ln_b, bf16* U, int tid, int lane, int wave) {
    const int cp = tid & 255, tg = tid >> 8;
    f32x2 w[31];
#pragma unroll
    for (int j = 0; j < 31; ++j) w[j] = *(const f32x2*)(dw_w + j * 512 + 2 * cp);
    const f32x2 bias = *(const f32x2*)(dw_b + 2 * cp);
    f32x4 gg[2], bb[2];
#pragma unroll
    for (int j = 0; j < 2; ++j) { gg[j] = *((const f32x4*)ln_g + lane + 64 * j); bb[j] = *((const f32x4*)ln_b + lane + 64 * j); }
    v4u pre[8];
#define CONV_PREFETCH(unit) do { const int row0_ = (unit) * 32, t0_ = row0_ & (SEQL - 1); _Pragma("unroll") for (int k = 0; k < 8; ++k) { const int i = tid + 512 * k, r = i >> 6, ch = i & 63; pre[k] = (v4u){0u, 0u, 0u, 0u}; \
        if (i < 62 * 64 && t0_ - 30 + r >= 0) pre[k] = *(const v4u*)(Hg + (size_t)(row0_ - 30 + r) * 512 + ch * 8); } } while (0)
    if (u0 < nunits) CONV_PREFETCH(u0);
    for (int unit = u0; unit < nunits; unit += ustride) {
        const int row0 = unit * 32;
#pragma unroll
        for (int k = 0; k < 8; ++k) { const int i = tid + 512 * k, r = i >> 6, ch = i & 63; if (i < 62 * 64) *(LAS v4u*)(lds + r * 1024 + ch * 16) = pre[k]; }
        __syncthreads();
        if (unit + ustride < nunits) CONV_PREFETCH(unit + ustride);
#pragma unroll 1
        for (int g = 0; g < 2; ++g) {
            const int tl0 = tg * 16 + g * 8;
            f32x2 acc[8];
#pragma unroll
            for (int o = 0; o < 8; ++o) acc[o] = bias;
#pragma unroll
            for (int i = 0; i < 38; ++i) { const unsigned wv = *(const LAS unsigned*)(lds + (tl0 + i) * 1024 + cp * 4); const f32x2 x = {pg8::bf_lo(wv), pg8::bf_hi(wv)};
#pragma unroll
                for (int o = 0; o < 8; ++o) { const int j = i - o; if (j >= 0 && j <= 30) acc[o] += w[j] * x; } }
#pragma unroll
            for (int o = 0; o < 8; ++o) *(LAS f32x2*)(lds + CONV_IN_BYTES + (tl0 + o) * 2048 + cp * 8) = acc[o];
        }
        __syncthreads();
        f32x4 v[4][2]; float s1[4], s2[4];
#pragma unroll
        for (int k = 0; k < 4; ++k) { const int tl = wave * 4 + k; s1[k] = 0.f;
#pragma unroll
            for (int j = 0; j < 2; ++j) { v[k][j] = *(const LAS f32x4*)(lds + CONV_IN_BYTES + tl * 2048 + (lane + 64 * j) * 16); s1[k] += (v[k][j].x + v[k][j].y) + (v[k][j].z + v[k][j].w); } }
#pragma unroll
        for (int o = 1; o < 64; o <<= 1) {
#pragma unroll
            for (int k = 0; k < 4; ++k) s1[k] += __shfl_xor(s1[k], o); }
#pragma unroll
        for (int k = 0; k < 4; ++k) { const float mean = s1[k] * (1.f / 512.f); s2[k] = 0.f;
#pragma unroll
            for (int j = 0; j < 2; ++j) { v[k][j] = v[k][j] - mean; s2[k] += (v[k][j].x * v[k][j].x + v[k][j].y * v[k][j].y) + (v[k][j].z * v[k][j].z + v[k][j].w * v[k][j].w); } }
#pragma unroll
        for (int o = 1; o < 64; o <<= 1) {
#pragma unroll
            for (int k = 0; k < 4; ++k) s2[k] += __shfl_xor(s2[k], o); }
#pragma unroll
        for (int k = 0; k < 4; ++k) { const int tl = wave * 4 + k; const float rstd = 1.f / sqrtf(s2[k] * (1.f / 512.f) + 1e-5f);
#pragma unroll
            for (int j = 0; j < 2; ++j) { f32x4 y = v[k][j] * rstd * gg[j] + bb[j];
                y.x = pg8::silu_f(y.x); y.y = pg8::silu_f(y.y); y.z = pg8::silu_f(y.z); y.w = pg8::silu_f(y.w);
                v2u o; o.x = pk2(y.x, y.y); o.y = pk2(y.z, y.w); *(v2u*)(U + (size_t)(row0 + tl) * 512 + (lane + 64 * j) * 4) = o; } }
        __syncthreads();
    }
#undef CONV_PREFETCH
}

__device__ __forceinline__ void conv_phase_dyn(LAS unsigned char* lds, int cur, unsigned* qctr, int qbase  , int nunits, const bf16* Hg, const float* dw_w, const float* dw_b, const float* ln_g, const float* ln_b, bf16* U, int tid, int lane, int wave) {
    const int cp = tid & 255, tg = tid >> 8;
    f32x2 w[31];
#pragma unroll
    for (int j = 0; j < 31; ++j) w[j] = *(const f32x2*)(dw_w + j * 512 + 2 * cp);
    const f32x2 bias = *(const f32x2*)(dw_b + 2 * cp);
    f32x4 gg[2], bb[2];
#pragma unroll
    for (int j = 0; j < 2; ++j) { gg[j] = *((const f32x4*)ln_g + lane + 64 * j); bb[j] = *((const f32x4*)ln_b + lane + 64 * j); }
    v4u pre[8];
#define CONV_PREFETCH(unit) do { const int row0_ = (unit) * 32, t0_ = row0_ & (SEQL - 1); _Pragma("unroll") for (int k = 0; k < 8; ++k) { const int i = tid + 512 * k, r = i >> 6, ch = i & 63; pre[k] = (v4u){0u, 0u, 0u, 0u}; \
        if (i < 62 * 64 && t0_ - 30 + r >= 0) pre[k] = *(const v4u*)(Hg + (size_t)(row0_ - 30 + r) * 512 + ch * 8); } } while (0)
    const bool popper = (wave == 0 && lane == 0); volatile LAS unsigned* slot = (volatile LAS unsigned*)(lds + LDSCTL_OFF + 224);
    if (popper) slot[0] = __hip_atomic_fetch_add(qctr, 1u, __ATOMIC_RELAXED, __HIP_MEMORY_SCOPE_AGENT);
    __syncthreads();
    int nxt = qbase + (int)__builtin_amdgcn_readfirstlane(slot[0]);
    if (cur < nunits) CONV_PREFETCH(cur);
    while (cur < nunits) {
        const int unit = cur; const int row0 = unit * 32;
#pragma unroll
        for (int k = 0; k < 8; ++k) { const int i = tid + 512 * k, r = i >> 6, ch = i & 63; if (i < 62 * 64) *(LAS v4u*)(lds + r * 1024 + ch * 16) = pre[k]; }
        asm volatile("s_waitcnt lgkmcnt(0)\n\ts_barrier" ::: "memory");
        unsigned pv = 0u; if (popper) pv = __hip_atomic_fetch_add(qctr, 1u, __ATOMIC_RELAXED, __HIP_MEMORY_SCOPE_AGENT);
        if (nxt < nunits) CONV_PREFETCH(nxt);
#pragma unroll 1
        for (int g = 0; g < 2; ++g) {
            const int tl0 = tg * 16 + g * 8;
            f32x2 acc[8];
#pragma unroll
            for (int o = 0; o < 8; ++o) acc[o] = bias;
#pragma unroll
            for (int i = 0; i < 38; ++i) { const unsigned wv = *(const LAS unsigned*)(lds + (tl0 + i) * 1024 + cp * 4); const f32x2 x = {pg8::bf_lo(wv), pg8::bf_hi(wv)};
#pragma unroll
                for (int o = 0; o < 8; ++o) { const int j = i - o; if (j >= 0 && j <= 30) acc[o] += w[j] * x; } }
#pragma unroll
            for (int o = 0; o < 8; ++o) *(LAS f32x2*)(lds + CONV_IN_BYTES + (tl0 + o) * 2048 + cp * 8) = acc[o];
        }
        asm volatile("s_waitcnt lgkmcnt(0)\n\ts_barrier" ::: "memory");
        f32x4 v[4][2]; float s1[4], s2[4];
#pragma unroll
        for (int k = 0; k < 4; ++k) { const int tl = wave * 4 + k; s1[k] = 0.f;
#pragma unroll
            for (int j = 0; j < 2; ++j) { v[k][j] = *(const LAS f32x4*)(lds + CONV_IN_BYTES + tl * 2048 + (lane + 64 * j) * 16); s1[k] += (v[k][j].x + v[k][j].y) + (v[k][j].z + v[k][j].w); } }
#pragma unroll
        for (int o = 1; o < 64; o <<= 1) {
#pragma unroll
            for (int k = 0; k < 4; ++k) s1[k] += __shfl_xor(s1[k], o); }
#pragma unroll
        for (int k = 0; k < 4; ++k) { const float mean = s1[k] * (1.f / 512.f); s2[k] = 0.f;
#pragma unroll
            for (int j = 0; j < 2; ++j) { v[k][j] = v[k][j] - mean; s2[k] += (v[k][j].x * v[k][j].x + v[k][j].y * v[k][j].y) + (v[k][j].z * v[k][j].z + v[k][j].w * v[k][j].w); } }
#pragma unroll
        for (int o = 1; o < 64; o <<= 1) {
#pragma unroll
            for (int k = 0; k < 4; ++k) s2[k] += __shfl_xor(s2[k], o); }
#pragma unroll
        for (int k = 0; k < 4; ++k) { const int tl = wave * 4 + k; const float rstd = 1.f / sqrtf(s2[k] * (1.f / 512.f) + 1e-5f);
#pragma unroll
            for (int j = 0; j < 2; ++j) { f32x4 y = v[k][j] * rstd * gg[j] + bb[j];
                y.x = pg8::silu_f(y.x); y.y = pg8::silu_f(y.y); y.z = pg8::silu_f(y.z); y.w = pg8::silu_f(y.w);
                v2u o; o.x = pk2(y.x, y.y); o.y = pk2(y.z, y.w); *(v2u*)(U + (size_t)(row0 + tl) * 512 + (lane + 64 * j) * 4) = o; } }
        if (popper) slot[0] = pv;
        __syncthreads();
        cur = nxt; nxt = qbase + (int)__builtin_amdgcn_readfirstlane(slot[0]);
        __syncthreads();
    }
#undef CONV_PREFETCH
}

struct Args { const float* in[16]; float* out; unsigned char* ws; };
__global__ void __launch_bounds__(NWAVES * 64, 2) fwd_megakernel(Args args) {
    extern __shared__ __attribute__((aligned(16))) unsigned char lds[];
    cg::grid_group grid = cg::this_grid();
    LAS unsigned char* L = (LAS unsigned char*)lds;
    const int wave = __builtin_amdgcn_readfirstlane(threadIdx.x >> 6);
#define FRESH_TID() const int lane = lane_id_asm(); const int tid = wave * 64 + lane; (void)tid
    const int G = gridDim.x; const int bx = blockIdx.x; const int vcu = (G % 8 == 0) ? (bx % 8) * (G / 8) + bx / 8 : bx;
    const int gw = vcu * NWAVES + wave, NGW = G * NWAVES;
#define CA4 __attribute__((address_space(4)))
#define PHASE_PTRS() \
    const CA4 Args* A_; { auto kp_ = __builtin_amdgcn_kernarg_segment_ptr(); asm volatile("" : "+s"(kp_)); A_ = (const CA4 Args*)kp_; } \
    unsigned char* ws = A_->ws; (void)ws; \
    const float* x = A_->in[0]; const float* pre_g = A_->in[1]; const float* w_in = A_->in[2]; const float* dw_w = A_->in[3]; const float* dw_b = A_->in[4]; \
    const float* cln_g = A_->in[5]; const float* cln_b = A_->in[6]; const float* pw_w = A_->in[7]; const float* pw_b = A_->in[8]; \
    const float* lq1 = A_->in[9]; const float* lk1 = A_->in[10]; const float* lq2 = A_->in[11]; const float* lk2 = A_->in[12]; \
    const float* sub_g = A_->in[13]; const float* w_out = A_->in[14]; const float* post_g = A_->in[15]; float* out = A_->out; \
    float* rowss = (float*)(ws + WS_ROWSS); \
    bf16 *WinT = (bf16*)(ws + WS_WIN), *WoT = (bf16*)(ws + WS_WO), *PwT = (bf16*)(ws + WS_PW), *XN = (bf16*)(ws + WS_XN), *OB = (bf16*)(ws + WS_O); \
    bf16 *HG = (bf16*)(ws + WS_HG), *CGB = (bf16*)(ws + WS_CG), *QB_ = (bf16*)(ws + WS_Q), *KB = (bf16*)(ws + WS_K), *VB = (bf16*)(ws + WS_V), *DGB = (bf16*)(ws + WS_DG), *UB = (bf16*)(ws + WS_U); \
    bf16 *YB = (bf16*)(ws + WS_Y), *Y2 = (bf16*)(ws + WS_Y2); \
    (void)x; (void)pre_g; (void)w_in; (void)dw_w; (void)dw_b; (void)cln_g; (void)cln_b; (void)pw_w; (void)pw_b; (void)lq1; (void)lk1; (void)lq2; (void)lk2; (void)sub_g; (void)w_out; (void)post_g; (void)out; \
    (void)rowss; (void)WinT; (void)WoT; (void)PwT; (void)XN; (void)OB; (void)HG; (void)CGB; (void)QB_; (void)KB; (void)VB; (void)DGB; (void)UB; (void)YB; (void)Y2
    if (threadIdx.x < 128) ((LAS unsigned*)(L + LDSCTL_OFF))[threadIdx.x] = 0u;
    __syncthreads();
    XcdBarrier bar = xcd_barrier_post((unsigned*)(args.ws + WS_BAR), (volatile LAS unsigned*)(L + LDSCTL_OFF));
    if (args.ws == nullptr) grid.sync();

    {
        PHASE_PTRS(); FRESH_TID();
        LAS float* scr = (LAS float*)(L + wave * 16384);
        constexpr int I_IN = (DMODEL / 64) * (NIN / 32), I_O = (1024 / 64) * (1024 / 32), I_PW = (512 / 64) * (512 / 32);
        for (int it = gw; it < I_IN + I_O + I_PW; it += NGW) {
            int r = it;
            if (r < I_IN) { const int nblk = NIN / 32, kb = r / nblk, nb = r % nblk; p0_transpose_item(w_in, DMODEL, NIN, WinT, 64 * kb, 32 * nb, win_dst_row(32 * nb), scr, lane); continue; } r -= I_IN;
            if (r < I_O) { const int nblk = 1024 / 32, kb = r / nblk, nb = r % nblk; p0_transpose_item(w_out, 1024, 1024, WoT, 64 * kb, 32 * nb, 32 * nb, scr, lane); continue; } r -= I_O;
            { const int nblk = 512 / 32, kb = r / nblk, nb = r % nblk; p0_transpose_item(pw_w, 512, 512, PwT, 64 * kb, 32 * nb, 32 * nb, scr, lane); }
        }
        for (int i = bx * 512 + tid; i < M; i += G * 512) rowss[i] = 0.f;
        f32x4 gv[4];
#pragma unroll
        for (int j = 0; j < 4; ++j) gv[j] = *((const f32x4*)pre_g + lane + 64 * j);
        for (int m0 = gw; m0 < M; m0 += 4 * NGW) {
            f32x4 v[4][4]; float ss[4];
#pragma unroll
            for (int k = 0; k < 4; ++k) { const int m = m0 + k * NGW; const f32x4* xr = (const f32x4*)(x + (size_t)(m < M ? m : m0) * DMODEL) + lane;
#pragma unroll
                for (int j = 0; j < 4; ++j) v[k][j] = __builtin_nontemporal_load(xr + 64 * j); }
#pragma unroll
            for (int k = 0; k < 4; ++k) { ss[k] = 0.f;
#pragma unroll
                for (int j = 0; j < 4; ++j) ss[k] += (v[k][j].x * v[k][j].x + v[k][j].y * v[k][j].y) + (v[k][j].z * v[k][j].z + v[k][j].w * v[k][j].w); }
#pragma unroll
            for (int o = 1; o < 64; o <<= 1) {
#pragma unroll
                for (int k = 0; k < 4; ++k) ss[k] += __shfl_xor(ss[k], o); }
#pragma unroll
            for (int k = 0; k < 4; ++k) { const int m = m0 + k * NGW; if (m < M) { const float rstd = 1.f / sqrtf(ss[k] * (1.f / DMODEL) + 1e-6f);
                v2u* o8 = (v2u*)(XN + (size_t)m * DMODEL) + lane;
#pragma unroll
                for (int j = 0; j < 4; ++j) { const f32x4 y = v[k][j] * rstd * gv[j]; v2u o; o.x = pk2(y.x, y.y); o.y = pk2(y.z, y.w); o8[64 * j] = o; } } }
        }
    }
    xcd_barrier(bar);

    {
        PHASE_PTRS();
        pg8::Gemm g{XN, WinT, M, NIN, DMODEL}; pg8::StaticOrder S; S.init(M, NIN, G, bx);
        pg8::EpiIn E{HG, CGB, QB_, KB, VB, DGB, (unsigned*)(ws + WS_BAR) + NMAX_WORD};
        pg8::gemm_phase<pg8::EpiIn, pg8::StaticOrder, PG8_ALIGN, PG8_SP2>(L, g, S, E, wave);
    }
    xcd_barrier(bar);

    {
        PHASE_PTRS(); FRESH_TID();
        unsigned* ctlw = (unsigned*)(ws + WS_BAR);
        int Wt[8];
#pragma unroll
        for (int i = 0; i < 8; ++i) { const float qm = __uint_as_float(__hip_atomic_load(ctlw + NMAX_WORD + i, RLX_AGENT)), km = __uint_as_float(__hip_atomic_load(ctlw + NMAX_WORD + 8 + i, RLX_AGENT));
            const float Sb = 2.02f * sqrtf(qm * km);
            const float w = (2.f * Sb + 42.f) / (64.f * pg8::alibi_sl(i >> 1)); Wt[i] = w < 64.f ? (int)w + 1 : 64; }
        const unsigned qslot = LDSCTL_OFF + 64;
        float sbmax = 0.f;
#pragma unroll
        for (int i = 0; i < 8; ++i) { const float qm = __uint_as_float(__hip_atomic_load(ctlw + NMAX_WORD + i, RLX_AGENT)), km = __uint_as_float(__hip_atomic_load(ctlw + NMAX_WORD + 8 + i, RLX_AGENT)); sbmax = fmaxf(sbmax, 2.02f * sqrtf(qm * km)); }
        if (sbmax <= 60.f) {
            int u = vcu;
            while (u < 1024) {
                int qb, b, h, c;
                if (u < 512) { qb = 15 - (u >> 5); const int r = u & 31; b = r >> 2; h = 2 + ((r >> 1) & 1); c = r & 1; }
                else { const int v = (u - 512) & 255; h = (u < 768) ? 1 : 0; qb = 15 - (v >> 4); const int r = v & 15; b = r >> 1; c = r & 1; }
                const int hc = 2 * h + c; int W = Wt[0];
#pragma unroll
                for (int i = 1; i < 8; ++i) W = (hc == i) ? Wt[i] : W;
                int T0 = 4 * qb - W; T0 = T0 > 0 ? (T0 & ~1) : 0;
                attn_body::attn_unit2(b, qb, (const attn_body::bf16*)(QB_ + h * 128 + c * 64), (const attn_body::bf16*)(KB + h * 128 + c * 64), (const attn_body::bf16*)(VB + h * 128),
                                      (attn_body::bf16*)(OB + h * 256 + c * 128), pg8::alibi_sl(h), pg8::alibi_c32(h), (char*)lds, wave, T0, ctlw + QCTR_WORD, qslot);
                u = G + (int)__builtin_amdgcn_readfirstlane(*(volatile LAS unsigned*)(L + qslot));
            }
            { const int ucur_ = u - 1024; PHASE_PTRS(); FRESH_TID();
              conv_phase_dyn(L, ucur_, (unsigned*)(ws + WS_BAR) + QCTR_WORD, G - 1024, M / 32, HG, dw_w, dw_b, cln_g, cln_b, UB, tid, lane, wave); }
        } else {
        conv_phase(L, vcu, G, M / 32, HG, dw_w, dw_b, cln_g, cln_b, UB, tid, lane, wave);
        int u = vcu;
        while (u < 2048) {
            const int qb = 15 - (u >> 7), r = u & 127, b = r >> 4, h = (r >> 2) & 3, c = (r >> 1) & 1, vh = r & 1;
            const int hc = 2 * h + c; int W = Wt[0];
#pragma unroll
            for (int i = 1; i < 8; ++i) W = (hc == i) ? Wt[i] : W;
            int T0 = 4 * qb - W; T0 = T0 > 0 ? (T0 & ~1) : 0;
            attn_body::attn_unit<8>(b, qb, (const attn_body::bf16*)(QB_ + h * 128 + c * 64), (const attn_body::bf16*)(KB + h * 128 + c * 64), (const attn_body::bf16*)(VB + h * 128 + vh * 64),
                                    (attn_body::bf16*)(OB + h * 256 + c * 128 + vh * 64), pg8::alibi_sl(h), pg8::alibi_c32(h), (char*)lds, wave, T0, ctlw + QCTR_WORD, qslot);
            u = G + (int)__builtin_amdgcn_readfirstlane(*(volatile LAS unsigned*)(L + qslot));
        }
        }
    }
    xcd_barrier(bar);

    {
        PHASE_PTRS();
        {
            pg8::Gemm g{UB, PwT, M, 512, 512}; pg8::StaticOrder S; S.init(M, 512, G, bx);
            pg8::EpiPw E{CGB, pw_b, YB};
            pg8::gemm_phase<pg8::EpiPw, pg8::StaticOrder, PG8_ALIGN, PG8_SP2>(L, g, S, E, wave);
        }
        FRESH_TID();
        const float lam = expf(wave_sum(lq1[lane] * lk1[lane])) - expf(wave_sum(lq2[lane] * lk2[lane])) + 0.2f;
        const int h = lane >> 4, ec = (lane & 15) * 8;
        float gs[8];
#pragma unroll
        for (int j = 0; j < 8; ++j) gs[j] = sub_g[ec + j] * 0.8f;
        for (int m0 = gw; m0 < M; m0 += 4 * NGW) {
            v4u a[4], bq[4], gt[4];
#pragma unroll
            for (int k = 0; k < 4; ++k) { const int mm = m0 + k * NGW; const size_t m = (size_t)(mm < M ? mm : m0);
                a[k] = *(const v4u*)(OB + m * 1024 + h * 256 + ec); bq[k] = *(const v4u*)(OB + m * 1024 + h * 256 + 128 + ec); gt[k] = *(const v4u*)(DGB + m * 512 + h * 128 + ec); }
#pragma unroll
            for (int k = 0; k < 4; ++k) { const int mm = m0 + k * NGW; if (mm >= M) continue;
                const unsigned aw[4] = {a[k].x, a[k].y, a[k].z, a[k].w}, bw[4] = {bq[k].x, bq[k].y, bq[k].z, bq[k].w}, gw4[4] = {gt[k].x, gt[k].y, gt[k].z, gt[k].w};
                float o[8]; float ss = 0.f;
#pragma unroll
                for (int j = 0; j < 4; ++j) { o[2 * j] = pg8::bf_lo(aw[j]) - lam * pg8::bf_lo(bw[j]); o[2 * j + 1] = pg8::bf_hi(aw[j]) - lam * pg8::bf_hi(bw[j]); ss += o[2 * j] * o[2 * j] + o[2 * j + 1] * o[2 * j + 1]; }
                ss += __shfl_xor(ss, 1); ss += __shfl_xor(ss, 2); ss += __shfl_xor(ss, 4); ss += __shfl_xor(ss, 8);
                const float rstd = 1.f / sqrtf(ss * (1.f / 128.f) + 1e-6f);
                unsigned wv[4];
#pragma unroll
                for (int j = 0; j < 4; ++j) wv[j] = pk2(o[2 * j] * rstd * gs[2 * j] * pg8::bf_lo(gw4[j]), o[2 * j + 1] * rstd * gs[2 * j + 1] * pg8::bf_hi(gw4[j]));
                v4u w; w.x = wv[0]; w.y = wv[1]; w.z = wv[2]; w.w = wv[3];
                *(v4u*)(YB + (size_t)mm * 1024 + 512 + h * 128 + ec) = w; }
        }
    }
    xcd_barrier(bar);

    {
        PHASE_PTRS();
        pg8::Gemm g{YB, WoT, M, 1024, 1024}; pg8::StaticOrder S; S.init(M, 1024, G, bx);
        pg8::EpiOut E{Y2, rowss};
        pg8::gemm_phase<pg8::EpiOut, pg8::StaticOrder, PG8_ALIGN, PG8_SP2>(L, g, S, E, wave);
    }
    xcd_barrier(bar);

    {
        PHASE_PTRS(); FRESH_TID();
        f32x4 gv[4];
#pragma unroll
        for (int j = 0; j < 4; ++j) gv[j] = *((const f32x4*)post_g + lane + 64 * j);
        for (int m0 = gw; m0 < M; m0 += 4 * NGW) {
            f32x4 xv[4][4]; v2u yv[4][4]; float rs[4];
#pragma unroll
            for (int k = 0; k < 4; ++k) { const int mm = m0 + k * NGW; const size_t m = (size_t)(mm < M ? mm : m0); rs[k] = rowss[m];
                const f32x4* xr = (const f32x4*)(x + m * DMODEL) + lane; const v2u* yr = (const v2u*)(Y2 + m * 1024) + lane;
#pragma unroll
                for (int j = 0; j < 4; ++j) { xv[k][j] = __builtin_nontemporal_load(xr + 64 * j); yv[k][j] = yr[64 * j]; } }
#pragma unroll
            for (int k = 0; k < 4; ++k) { const int mm = m0 + k * NGW; if (mm >= M) continue;
                const float rstd = 1.f / sqrtf(rs[k] * (1.f / 1024.f) + 1e-6f); f32x4* orow = (f32x4*)(out + (size_t)mm * DMODEL) + lane;
#pragma unroll
                for (int j = 0; j < 4; ++j) { f32x4 o;
                    o.x = xv[k][j].x + pg8::bf_lo(yv[k][j].x) * rstd * gv[j].x; o.y = xv[k][j].y + pg8::bf_hi(yv[k][j].x) * rstd * gv[j].y; o.z = xv[k][j].z + pg8::bf_lo(yv[k][j].y) * rstd * gv[j].z; o.w = xv[k][j].w + pg8::bf_hi(yv[k][j].y) * rstd * gv[j].w;
                    __builtin_nontemporal_store(o, orow + 64 * j); } }
        }
    }
}

extern "C" void kernel_launch(void* const* d_in, const int* in_sizes, int n_in, void* d_out, int out_size, void* d_ws, size_t ws_size, hipStream_t stream) {
    static int grid = 0;
    if (grid == 0) {
        if (n_in != 16 || out_size != M * DMODEL || ws_size < WS_END) { fprintf(stderr, "kernel_launch: unexpected problem shape (n_in %d, out %d, ws %zu)\n", n_in, out_size, ws_size); grid = -1; return; }
        int dev = 0, cus = 0, per_cu = 0;
        hipGetDevice(&dev); hipDeviceGetAttribute(&cus, hipDeviceAttributeMultiprocessorCount, dev);
        hipFuncSetAttribute((const void*)fwd_megakernel, hipFuncAttributeMaxDynamicSharedMemorySize, LDS_BYTES);
        hipOccupancyMaxActiveBlocksPerMultiprocessor(&per_cu, (const void*)fwd_megakernel, NWAVES * 64, LDS_BYTES);
        if (per_cu < 1) { fprintf(stderr, "kernel_launch: occupancy query reports %d blocks per CU\n", per_cu); per_cu = 1; }
        (void)hipGetLastError();
        grid = cus;
    }
    if (grid < 0) return;
    (void)hipMemsetAsync((char*)d_ws + WS_BAR, 0, WS_BAR_BYTES, stream);
    Args a{};
    for (int i = 0; i < 16; ++i) a.in[i] = (const float*)d_in[i];
    a.out = (float*)d_out; a.ws = (unsigned char*)d_ws;
    void* kargs[] = {&a};
    hipError_t e = hipLaunchCooperativeKernel((const void*)fwd_megakernel, dim3(grid), dim3(NWAVES * 64), kargs, LDS_BYTES, stream);
    if (e != hipSuccess) fprintf(stderr, "cooperative launch failed: %s (grid %d)\n", hipGetErrorString(e), grid);
}
```

```cpp
#include <hip/hip_runtime.h>
#include <hip/hip_cooperative_groups.h>
#include <cstdio>
#include <cstdint>
namespace cg = cooperative_groups;
__device__ __forceinline__ int lane_id_asm() { int l; asm volatile("v_mbcnt_lo_u32_b32 %0, -1, 0\n\tv_mbcnt_hi_u32_b32 %0, -1, %0" : "=v"(l)); return l; }
namespace pg8 {
#define PG8_LAS __attribute__((address_space(3)))
typedef unsigned short bf16_t;
typedef short bf16x8 __attribute__((ext_vector_type(8)));
typedef float f32x4 __attribute__((ext_vector_type(4)));
typedef unsigned u32x4 __attribute__((ext_vector_type(4)));
constexpr int BM = 256, BK = 64, HALF = 128, HTB = HALF * BK * 2  , STAGE_BYTES = 8 * HTB, NXCD = 8, WGM = 8;

__host__ __device__ __forceinline__ int lds_byte(int r, int c) { const int st = (r >> 4) * 2 + (c >> 5), rr = r & 15, cc = c & 31, ob = rr * 64 + cc * 2; return st * 1024 + (ob ^ (((ob >> 9) & 1) << 5)); }
__host__ __device__ __forceinline__ void stage_rc(int b, int& R, int& C) { const int st = b / 1024, sb = b % 1024, swz = sb ^ (((sb >> 9) & 1) << 5); R = (st >> 1) * 16 + swz / 64; C = (st & 1) * 32 + (swz % 64) / 2; }
__host__ __device__ __forceinline__ int perm32(int rho) { const int n = rho >> 4, i = rho & 15; return 8 * (i >> 2) + 4 * n + (i & 3); }

struct Unit { int pm, pn; };
struct Gemm { const bf16_t* A; const bf16_t* Bt; int M, N, K; };

struct StaticOrder {
    int nM, nN, nwg, G, c;
    __host__ __device__ void init(int M, int N, int G_, int c_) { nM = M / BM; nN = N / BM; nwg = nM * nN; G = G_; c = c_; }
    __host__ __device__ bool next(int i, Unit& u) const {
        const long L = (long)i * G + c; if (L >= nwg) return false;
        int wgid = (int)L; { const int q = nwg / NXCD, r = nwg % NXCD, xcd = wgid % NXCD, off = wgid / NXCD; wgid = (xcd < r ? xcd * (q + 1) : r * (q + 1) + (xcd - r) * q) + off; }
        const int nig = WGM * nN, gid = wgid / nig, fm = gid * WGM, gsz = (nM - fm) < WGM ? (nM - fm) : WGM;
        u.pm = fm + ((wgid % nig) % gsz); u.pn = (wgid % nig) / gsz; return true;
    }
    __device__ __forceinline__ void a_ready(const Unit&) const {}
    __device__ __forceinline__ void done(const Unit&) const {}
};

__device__ __forceinline__ unsigned cvt_pk_bf16(float lo, float hi) { unsigned r; asm volatile("v_cvt_pk_bf16_f32 %0, %1, %2" : "=v"(r) : "v"(lo), "v"(hi)); return r; }

typedef float f32x2 __attribute__((ext_vector_type(2)));
__host__ __device__ __forceinline__ float alibi_c32(int h) { return h == 0 ? 2980.9579870417283f : h == 1 ? 7.38905609893065f : h == 2 ? 1.6487212707001282f : 1.1331484530668263f; }
__host__ __device__ __forceinline__ float alibi_sl(int h) { return h == 0 ? 0.36067376022224085f : h == 1 ? 0.09016844005556021f : h == 2 ? 0.022542110013890053f : 0.005635527503472513f; }
__device__ __forceinline__ float sigmoid_f(float v) { return __builtin_amdgcn_rcpf(1.0f + __builtin_amdgcn_exp2f(-1.4426950408889634f * v)); }
__device__ __forceinline__ float silu_f(float v) { return v * sigmoid_f(v); }
__device__ __forceinline__ float bf_lo(unsigned w) { return __uint_as_float(w << 16); }
__device__ __forceinline__ float bf_hi(unsigned w) { return __uint_as_float(w & 0xffff0000u); }
__device__ __forceinline__ u32x4 pack8(const f32x4 v0, const f32x4 v1) { u32x4 w; w.x = cvt_pk_bf16(v0[0], v0[1]); w.y = cvt_pk_bf16(v0[2], v0[3]); w.z = cvt_pk_bf16(v1[0], v1[1]); w.w = cvt_pk_bf16(v1[2], v1[3]); return w; }

struct EpiIn {
    static constexpr bool PERM = true, AFTER_DRAIN = false;
    bf16_t *Hg, *CG, *Q, *K, *V, *DG; unsigned* nmax;
    __device__ __forceinline__ void operator()(const f32x4 (&acc)[2][2][4][2], const Unit& u, int wr, int wc, int fr, int fq) const {
        const int row0 = u.pm * BM + wr * 64 + fr; const int pn = u.pn;
        if (pn < 4) {
            const int col = 128 * pn + wc * 32 + 8 * fq;
#pragma unroll
            for (int ai = 0; ai < 2; ++ai)
#pragma unroll
                for (int m = 0; m < 4; ++m) {
                    f32x4 h0, h1;
#pragma unroll
                    for (int j = 0; j < 4; ++j) { h0[j] = acc[ai][0][m][0][j] * sigmoid_f(acc[ai][1][m][0][j]); h1[j] = acc[ai][0][m][1][j] * sigmoid_f(acc[ai][1][m][1][j]); }
                    *(u32x4*)(Hg + (size_t)(row0 + ai * HALF + m * 16) * 512 + col) = pack8(h0, h1);
                }
        } else {
            const int role = (pn - 4) >> 1, colt = 256 * ((pn - 4) & 1) + wc * 32 + 8 * fq;
            bf16_t* base = role == 0 ? CG : role == 1 ? Q : role == 2 ? K : role == 3 ? V : DG;
            float mx[2] = {0.f, 0.f};
#pragma unroll
            for (int ai = 0; ai < 2; ++ai)
#pragma unroll
                for (int m = 0; m < 4; ++m)
#pragma unroll
                    for (int bj = 0; bj < 2; ++bj) {
                        f32x4 v0 = acc[ai][bj][m][0], v1 = acc[ai][bj][m][1];
                        if (role == 0 || role == 4) {
#pragma unroll
                            for (int j = 0; j < 4; ++j) { v0[j] = silu_f(v0[j]); v1[j] = silu_f(v1[j]); }
                        } else if (role == 1) { v0 = v0 * 0.18033688011112042f; v1 = v1 * 0.18033688011112042f; }
                        else if (role == 3) {
                            if (m >= 2) {
                                const int h = 2 * ((pn - 4) & 1) + bj;
                                const float c = alibi_c32(h);
                                v0 = v0 * c; v1 = v1 * c;
                            }
                        }
                        *(u32x4*)(base + (size_t)(row0 + ai * HALF + m * 16) * 512 + colt + bj * HALF) = pack8(v0, v1);
                        if (role == 1 || role == 2) { float ss = (v0[0] * v0[0] + v0[1] * v0[1]) + (v0[2] * v0[2] + v0[3] * v0[3]) + (v1[0] * v1[0] + v1[1] * v1[1]) + (v1[2] * v1[2] + v1[3] * v1[3]);
                            ss += __shfl_xor(ss, 16); ss += __shfl_xor(ss, 32); mx[bj] = fmaxf(mx[bj], ss); }
                    }
            if (role == 1 || role == 2) {
#pragma unroll
                for (int bj = 0; bj < 2; ++bj) { float v = mx[bj]; v = fmaxf(v, __shfl_xor(v, 1)); v = fmaxf(v, __shfl_xor(v, 2)); v = fmaxf(v, __shfl_xor(v, 4)); v = fmaxf(v, __shfl_xor(v, 8));
                    if (fr == 0 && fq == 0) atomicMax(nmax + (role - 1) * 8 + 4 * ((pn - 4) & 1) + 2 * bj + (wc >> 1), __float_as_uint(v)); }
            }
        }
    }
};
struct EpiPw {
    static constexpr bool PERM = true, AFTER_DRAIN = false;
    const bf16_t* CG; const float* bias; bf16_t* Y;
    __device__ __forceinline__ void operator()(const f32x4 (&acc)[2][2][4][2], const Unit& u, int wr, int wc, int fr, int fq) const {
        const int row0 = u.pm * BM + wr * 64 + fr; const int col0 = u.pn * BM + wc * 32 + 8 * fq;
        f32x4 bv[2][2];
#pragma unroll
        for (int bj = 0; bj < 2; ++bj)
#pragma unroll
            for (int n = 0; n < 2; ++n) bv[bj][n] = *(const f32x4*)(bias + col0 + bj * HALF + 4 * n);
#pragma unroll
        for (int ai = 0; ai < 2; ++ai)
#pragma unroll
            for (int m = 0; m < 4; ++m) { const size_t row = (size_t)(row0 + ai * HALF + m * 16);
#pragma unroll
                for (int bj = 0; bj < 2; ++bj) {
                    const u32x4 g = *(const u32x4*)(CG + row * 512 + col0 + bj * HALF);
                    f32x4 v0 = acc[ai][bj][m][0] + bv[bj][0], v1 = acc[ai][bj][m][1] + bv[bj][1];
                    v0[0] *= bf_lo(g.x); v0[1] *= bf_hi(g.x); v0[2] *= bf_lo(g.y); v0[3] *= bf_hi(g.y);
                    v1[0] *= bf_lo(g.z); v1[1] *= bf_hi(g.z); v1[2] *= bf_lo(g.w); v1[3] *= bf_hi(g.w);
                    *(u32x4*)(Y + row * 1024 + col0 + bj * HALF) = pack8(v0, v1);
                } }
    }
};
struct EpiOut {
    static constexpr bool PERM = true, AFTER_DRAIN = false;
    bf16_t* Y2; float* rowss;
    __device__ __forceinline__ void operator()(const f32x4 (&acc)[2][2][4][2], const Unit& u, int wr, int wc, int fr, int fq) const {
        const int row0 = u.pm * BM + wr * 64 + fr; const int col0 = u.pn * BM + wc * 32 + 8 * fq;
#pragma unroll
        for (int ai = 0; ai < 2; ++ai)
#pragma unroll
            for (int m = 0; m < 4; ++m) { const size_t row = (size_t)(row0 + ai * HALF + m * 16); float ss = 0.f;
#pragma unroll
                for (int bj = 0; bj < 2; ++bj) {
                    const f32x4 v0 = acc[ai][bj][m][0], v1 = acc[ai][bj][m][1];
                    ss += (v0[0] * v0[0] + v0[1] * v0[1]) + (v0[2] * v0[2] + v0[3] * v0[3]) + (v1[0] * v1[0] + v1[1] * v1[1]) + (v1[2] * v1[2] + v1[3] * v1[3]);
                    *(u32x4*)(Y2 + row * 1024 + col0 + bj * HALF) = pack8(v0, v1);
                }
                ss += __shfl_xor(ss, 16); ss += __shfl_xor(ss, 32);
                if (fq == 0) atomicAdd(rowss + row, ss);
            }
    }
};


template <class Epi, class Sched, bool ALIGN_EPI = false, bool SP2 = false>
__device__ __forceinline__ void gemm_phase(PG8_LAS unsigned char* lds, const Gemm g, const Sched& S, const Epi& E, int wid_in) {
    const int lane = lane_id_asm();
    int wid_o = wid_in; asm volatile("" : "+s"(wid_o)); const int wid = wid_o, tid = wid * 64 + lane, wr = wid >> 2, wc = wid & 3, fr = lane & 15, fq = lane >> 4;
    const int K = g.K, nt = K / BK;
    unsigned voffA[2], voffB[2];
#pragma unroll
    for (int i = 0; i < 2; ++i) { int R, C; stage_rc(tid * 16 + i * 8192, R, C); const int Rb = Epi::PERM ? ((R & ~31) + perm32(R & 31)) : R;
        voffA[i] = (unsigned)(R * K + C) * 2u; voffB[i] = (unsigned)(Rb * K + C) * 2u; }
    const size_t kstep = (size_t)(BK * 2);
    const size_t hstep = (size_t)HALF * K * 2;
    const size_t tstep = 2 * hstep;
    const unsigned ldsw = (unsigned)wid * 1024u;
    const int aoff = lds_byte(wr * 64 + fr, fq * 8), boff = lds_byte(wc * 32 + fr, fq * 8);
#define PG8_SA(b, h) (((b) * 2 + (h)) * HTB)
#define PG8_SB(b, h) ((4 + (b) * 2 + (h)) * HTB)
#define PG8_STAGE(bufoff, gbase, voff) do { _Pragma("unroll") for (int _i = 0; _i < 2; ++_i) \
        __builtin_amdgcn_global_load_lds((const unsigned*)((const char*)(gbase) + (voff)[_i]), (PG8_LAS unsigned*)(lds + (bufoff) + ldsw + _i * 8192), 16, 0, 0); } while (0)
#define PG8_LDA(dst, b, h) do { _Pragma("unroll") for (int m = 0; m < 4; ++m) _Pragma("unroll") for (int k = 0; k < 2; ++k) dst[m][k] = *(const PG8_LAS bf16x8*)(lds + PG8_SA(b, h) + aoff + m * 2048 + k * 1024); } while (0)
#define PG8_LDB(dst, b, h) do { _Pragma("unroll") for (int n = 0; n < 2; ++n) _Pragma("unroll") for (int k = 0; k < 2; ++k) dst[n][k] = *(const PG8_LAS bf16x8*)(lds + PG8_SB(b, h) + boff + n * 2048 + k * 1024); } while (0)
#define PG8_MMA(ai, bj, At, Bt) do { __builtin_amdgcn_s_setprio(1); _Pragma("unroll") for (int m = 0; m < 4; ++m) _Pragma("unroll") for (int n = 0; n < 2; ++n) _Pragma("unroll") for (int k = 0; k < 2; ++k) \
        acc[ai][bj][m][n] = __builtin_amdgcn_mfma_f32_16x16x32_bf16(Bt[n][k], At[m][k], acc[ai][bj][m][n], 0, 0, 0); __builtin_amdgcn_s_setprio(0); } while (0)
#define PG8_WAIT_V(n) asm volatile("s_waitcnt vmcnt(" #n ")" ::: "memory")
#define PG8_WAIT_L(n) asm volatile("s_waitcnt lgkmcnt(" #n ")" ::: "memory")
#define PG8_BAR __builtin_amdgcn_s_barrier()
#define PG8_SCHED __builtin_amdgcn_sched_barrier(0)
    Unit cur, nxt; int ui = 0;
    if (!S.next(0, cur)) return;
    f32x4 acc[2][2][4][2];
#pragma unroll
    for (int a = 0; a < 2; ++a)
#pragma unroll
        for (int b = 0; b < 2; ++b)
#pragma unroll
            for (int m = 0; m < 4; ++m)
#pragma unroll
                for (int n = 0; n < 2; ++n) acc[a][b][m][n] = (f32x4){0.f, 0.f, 0.f, 0.f};
    bf16x8 At[4][2], B0[2][2], B1[2][2];
    const char* cA = (const char*)g.A + (size_t)cur.pm * tstep; const char* cB = (const char*)g.Bt + (size_t)cur.pn * tstep;
    S.a_ready(cur);
    if constexpr (SP2) {
        PG8_STAGE(PG8_SB(0, 0), cB, voffB); PG8_STAGE(PG8_SB(0, 1), cB + hstep, voffB); PG8_STAGE(PG8_SA(0, 0), cA, voffA); PG8_STAGE(PG8_SA(0, 1), cA + hstep, voffA);
        if (wr == 1) PG8_BAR;
        PG8_WAIT_V(2); PG8_BAR;
        PG8_STAGE(PG8_SB(1, 0), cB + kstep, voffB); PG8_STAGE(PG8_SA(1, 0), cA + kstep, voffA); PG8_STAGE(PG8_SB(1, 1), cB + hstep + kstep, voffB);
        PG8_WAIT_V(6); PG8_BAR;
    } else {
        PG8_STAGE(PG8_SB(0, 0), cB, voffB); PG8_STAGE(PG8_SA(0, 0), cA, voffA); PG8_STAGE(PG8_SB(0, 1), cB + hstep, voffB); PG8_STAGE(PG8_SA(0, 1), cA + hstep, voffA);
        if (wr == 1) PG8_BAR;
        PG8_WAIT_V(4); PG8_BAR;
        PG8_STAGE(PG8_SB(1, 0), cB + kstep, voffB); PG8_STAGE(PG8_SA(1, 0), cA + kstep, voffA); PG8_STAGE(PG8_SB(1, 1), cB + hstep + kstep, voffB);
        PG8_WAIT_V(6); PG8_BAR;
    }
    for (;;) {
        const bool has_next = S.next(ui + 1, nxt);
        const char* nA = has_next ? (const char*)g.A + (size_t)nxt.pm * tstep : cA; const char* nB = has_next ? (const char*)g.Bt + (size_t)nxt.pn * tstep : cB;
        for (int t = 0; t < nt; t += 2) {
            const bool last = (t == nt - 2);
            const char* a1 = cA + (size_t)(t + 1) * kstep;
            const char* a2 = last ? nA : cA + (size_t)(t + 2) * kstep; const char* b2 = last ? nB : cB + (size_t)(t + 2) * kstep;
            const char* a3 = a2 + kstep; const char* b3 = b2 + kstep;
            if (last && has_next) S.a_ready(nxt);
            if constexpr (SP2) {
            PG8_LDB(B0, 0, 0); PG8_LDB(B1, 0, 1); PG8_SCHED; PG8_LDA(At, 0, 0); PG8_STAGE(PG8_SA(1, 1), a1 + hstep, voffA);
            PG8_WAIT_V(8); PG8_WAIT_L(0); PG8_BAR; PG8_MMA(0, 0, At, B0); PG8_MMA(0, 1, At, B1); PG8_BAR; PG8_SCHED;
            PG8_LDA(At, 0, 1); PG8_STAGE(PG8_SB(0, 0), b2, voffB); PG8_STAGE(PG8_SB(0, 1), b2 + hstep, voffB); PG8_STAGE(PG8_SA(0, 0), a2, voffA);
            PG8_WAIT_V(8); PG8_WAIT_L(0); PG8_BAR; PG8_MMA(1, 0, At, B0); PG8_MMA(1, 1, At, B1); PG8_BAR; PG8_SCHED;
            PG8_LDB(B0, 1, 0); PG8_LDB(B1, 1, 1); PG8_SCHED; PG8_LDA(At, 1, 0); PG8_STAGE(PG8_SA(0, 1), a2 + hstep, voffA);
            PG8_WAIT_V(8); PG8_WAIT_L(0); PG8_BAR; PG8_MMA(0, 0, At, B0); PG8_MMA(0, 1, At, B1); PG8_BAR; PG8_SCHED;
            PG8_LDA(At, 1, 1); PG8_STAGE(PG8_SB(1, 0), b3, voffB); PG8_STAGE(PG8_SB(1, 1), b3 + hstep, voffB); PG8_STAGE(PG8_SA(1, 0), a3, voffA);
            PG8_WAIT_V(8); PG8_WAIT_L(0); PG8_BAR; PG8_MMA(1, 0, At, B0); PG8_MMA(1, 1, At, B1); PG8_BAR; PG8_SCHED;
            } else {
            PG8_LDB(B0, 0, 0); PG8_SCHED; PG8_LDA(At, 0, 0); PG8_STAGE(PG8_SA(1, 1), a1 + hstep, voffA);
            PG8_WAIT_L(8); PG8_BAR; PG8_WAIT_L(0); PG8_MMA(0, 0, At, B0); PG8_BAR; PG8_SCHED;
            PG8_LDB(B1, 0, 1); PG8_STAGE(PG8_SB(0, 0), b2, voffB);
            PG8_BAR; PG8_WAIT_L(0); PG8_MMA(0, 1, At, B1); PG8_BAR;
            PG8_LDA(At, 0, 1); PG8_STAGE(PG8_SA(0, 0), a2, voffA);
            PG8_BAR; PG8_WAIT_L(0); PG8_MMA(1, 0, At, B0); PG8_BAR; PG8_SCHED;
            PG8_STAGE(PG8_SB(0, 1), b2 + hstep, voffB);
            PG8_WAIT_V(6); PG8_BAR; PG8_MMA(1, 1, At, B1); PG8_BAR;
            PG8_LDB(B0, 1, 0); PG8_SCHED; PG8_LDA(At, 1, 0); PG8_STAGE(PG8_SA(0, 1), a2 + hstep, voffA);
            PG8_WAIT_L(8); PG8_BAR; PG8_WAIT_L(0); PG8_MMA(0, 0, At, B0); PG8_BAR; PG8_SCHED;
            PG8_LDB(B1, 1, 1); PG8_STAGE(PG8_SB(1, 0), b3, voffB);
            PG8_BAR; PG8_WAIT_L(0); PG8_MMA(0, 1, At, B1); PG8_BAR;
            PG8_LDA(At, 1, 1); PG8_STAGE(PG8_SA(1, 0), a3, voffA);
            PG8_BAR; PG8_WAIT_L(0); PG8_MMA(1, 0, At, B0); PG8_BAR; PG8_SCHED;
            PG8_STAGE(PG8_SB(1, 1), b3 + hstep, voffB);
            PG8_WAIT_V(6); PG8_BAR; PG8_MMA(1, 1, At, B1); PG8_BAR;
            }
        }
        if constexpr (ALIGN_EPI) { if (wr == 0) PG8_BAR; }
        if constexpr (!Epi::AFTER_DRAIN) { E(acc, cur, wr, wc, fr, fq); S.done(cur); }
        if (!has_next) break;
#pragma unroll
        for (int a = 0; a < 2; ++a)
#pragma unroll
            for (int b = 0; b < 2; ++b)
#pragma unroll
                for (int m = 0; m < 4; ++m)
#pragma unroll
                    for (int n = 0; n < 2; ++n) acc[a][b][m][n] = (f32x4){0.f, 0.f, 0.f, 0.f};
        cur = nxt; cA = nA; cB = nB; ++ui;
        if constexpr (ALIGN_EPI) { if (wr == 1) PG8_BAR; }
    }
    PG8_WAIT_V(0);
    if constexpr (!ALIGN_EPI) { if (wr == 0) PG8_BAR; }
    PG8_BAR;
    if constexpr (Epi::AFTER_DRAIN) { E.fused(acc, cur, wr, wc, fr, fq, lds, wid, lane); S.done(cur); }
#undef PG8_SA
#undef PG8_SB
#undef PG8_STAGE
#undef PG8_LDA
#undef PG8_LDB
#undef PG8_MMA
#undef PG8_WAIT_V
#undef PG8_WAIT_L
#undef PG8_BAR
#undef PG8_SCHED
}
}

#ifndef PG8_SP2
#define PG8_SP2 true
#endif
#ifndef PG8_ALIGN
#define PG8_ALIGN true
#endif
#include <hip/hip_bf16.h>
#include <cmath>
namespace attn_body {
using bf16=__hip_bfloat16;
using bf16x8=__attribute__((ext_vector_type(8)))short;
using s16x4=__attribute__((ext_vector_type(4)))short;
using f32x16=__attribute__((ext_vector_type(16)))float;
using u32x4=__attribute__((ext_vector_type(4)))unsigned;
constexpr int BATCH=8,SEQ=4096,D=64;
constexpr int QP=512,KP=512,VP=512,OP=1024;
constexpr int NW=8,QBLK=32,QB=QBLK*NW,KVBLK=64,NQB=SEQ/QB;
constexpr int ATTN_UNIT_ROWS=QB;
__device__ __forceinline__ int crow(int r,int hi){return (r&3)+8*(r>>2)+4*hi;}
#define SBAR() __builtin_amdgcn_sched_barrier(0)
__device__ __forceinline__ void cmask(f32x16&p0,f32x16&p1,int jb,int qrel,int hi){
  const float NEG=-INFINITY; int kb=64*jb+4*hi;
  #pragma unroll
  for(int r=0;r<16;++r){int kv=kb+(r&3)+8*(r>>2); if(kv>qrel)p0[r]=NEG; if(kv+32>qrel)p1[r]=NEG;}
}

constexpr int NSLOT=3, SLOTB=8192;
constexpr int LDS_K=0, LDS_V=NSLOT*SLOTB, LDS_WS=2*NSLOT*SLOTB, LDS_OST=LDS_WS+NW*64*4, LDS_BYTES=LDS_OST+NW*4096;
constexpr float C2=0.125f*1.4426950408889634f;
__device__ __forceinline__ void glds16(const void*sbase,unsigned voff,unsigned lds_dst){unsigned keep;
  asm volatile("s_mov_b32 %0, m0\n\ts_mov_b32 m0, %2\n\ts_nop 0\n\tglobal_load_lds_dwordx4 %1, %3\n\ts_mov_b32 m0, %0":"=&s"(keep):"v"(voff),"s"(lds_dst),"s"(sbase):"memory");}
__device__ __forceinline__ float max3f(float a,float b,float c){float r;asm("v_max3_f32 %0, %1, %2, %3":"=v"(r):"v"(a),"v"(b),"v"(c));return r;}
__device__ __forceinline__ float max2f(float a,float b){float r;asm("v_max_f32_e32 %0, %1, %2":"=v"(r):"v"(a),"v"(b));return r;}
__device__ __forceinline__ float fadd_s(float a,float b){float r;asm("v_add_f32_e32 %0, %1, %2":"=v"(r):"v"(a),"v"(b));return r;}
__device__ __forceinline__ float fsub_s(float a,float b){float r;asm("v_sub_f32_e32 %0, %1, %2":"=v"(r):"v"(a),"v"(b));return r;}
typedef float f32x2_t __attribute__((ext_vector_type(2))); typedef __bf16 bf16x2_t __attribute__((ext_vector_type(2)));
__device__ __forceinline__ unsigned cvtpk_s(float lo,float hi){f32x2_t v={lo,hi};bf16x2_t b=__builtin_convertvector(v,bf16x2_t);return __builtin_bit_cast(unsigned,b);}
#define WAIT_BAR(N) asm volatile("s_waitcnt vmcnt(" #N ") lgkmcnt(0)\n\ts_barrier":::"memory")

__device__ __forceinline__ void qkt(f32x16&p0,f32x16&p1,const char*Kslot,const bf16x8*qr,const f32x16&negm,int r32,int hi){
  const char*kb=Kslot+hi*1024+r32*16;
  #pragma unroll
  for(int d0=0;d0<4;++d0){
    const bf16x8 b0=*reinterpret_cast<const bf16x8*>(kb+d0*2048);
    const bf16x8 b1=*reinterpret_cast<const bf16x8*>(kb+d0*2048+512);
    if(d0==0){p0=__builtin_amdgcn_mfma_f32_32x32x16_bf16(b0,qr[0],negm,0,0,0);p1=__builtin_amdgcn_mfma_f32_32x32x16_bf16(b1,qr[0],negm,0,0,0);}
    else{p0=__builtin_amdgcn_mfma_f32_32x32x16_bf16(b0,qr[d0],p0,0,0,0);p1=__builtin_amdgcn_mfma_f32_32x32x16_bf16(b1,qr[d0],p1,0,0,0);}}
}
typedef __attribute__((address_space(3))) const char* lds_cptr;
typedef short v4i16_t __attribute__((ext_vector_type(4)));
__device__ __forceinline__ void kload8(bf16x8*kf,lds_cptr kp){
  kf[0]=*(const __attribute__((address_space(3))) bf16x8*)(kp);      kf[1]=*(const __attribute__((address_space(3))) bf16x8*)(kp+512);
  kf[2]=*(const __attribute__((address_space(3))) bf16x8*)(kp+2048); kf[3]=*(const __attribute__((address_space(3))) bf16x8*)(kp+2560);
  kf[4]=*(const __attribute__((address_space(3))) bf16x8*)(kp+4096); kf[5]=*(const __attribute__((address_space(3))) bf16x8*)(kp+4608);
  kf[6]=*(const __attribute__((address_space(3))) bf16x8*)(kp+6144); kf[7]=*(const __attribute__((address_space(3))) bf16x8*)(kp+6656);
}
__device__ __forceinline__ void kload2(bf16x8*kf,lds_cptr kp,int j){ kf[2*j]=*(const __attribute__((address_space(3))) bf16x8*)(kp+j*2048); kf[2*j+1]=*(const __attribute__((address_space(3))) bf16x8*)(kp+j*2048+512); }
__device__ __forceinline__ s16x4 vtr(lds_cptr p){ return __builtin_bit_cast(s16x4,__builtin_amdgcn_ds_read_tr16_b64_v4i16((__attribute__((address_space(3))) v4i16_t*)p)); }
__device__ __forceinline__ float rowmax(const f32x16&p0,const f32x16&p1){
  float a=max3f(p0[0],p0[1],p1[0]),b=max3f(p0[2],p0[3],p1[1]);a=max3f(a,p1[2],p1[3]);
  #pragma unroll
  for(int r=4;r<16;r+=4){a=max3f(a,p0[r],p0[r+1]);b=max3f(b,p0[r+2],p0[r+3]);a=max3f(a,p1[r],p1[r+1]);b=max3f(b,p1[r+2],p1[r+3]);}
  const float m=max2f(a,b);
  auto rr=__builtin_amdgcn_permlane32_swap(__float_as_uint(m),__float_as_uint(m),false,false);
  return max2f(__uint_as_float(rr[0]),__uint_as_float(rr[1]));
}
__device__ __forceinline__ void pv(f32x16*o,int vb,bf16x8 pa0,bf16x8 pa1,bf16x8 pa2,bf16x8 pa3){
  #pragma unroll
  for(int d0=0;d0<2;++d0){s16x4 lo[4],hi[4];
    #pragma unroll
    for(int ks=0;ks<4;++ks){
      asm volatile("ds_read_b64_tr_b16 %0,%1 offset:%c2":"=&v"(lo[ks]):"v"(vb),"i"(d0*4096+ks*1024):"memory");
      asm volatile("ds_read_b64_tr_b16 %0,%1 offset:%c2":"=&v"(hi[ks]):"v"(vb),"i"(d0*4096+ks*1024+512):"memory");}
    asm volatile("s_waitcnt lgkmcnt(0)":::"memory");SBAR();
    #define PK(k) (bf16x8){lo[k][0],lo[k][1],lo[k][2],lo[k][3],hi[k][0],hi[k][1],hi[k][2],hi[k][3]}
    o[d0]=__builtin_amdgcn_mfma_f32_32x32x16_bf16(pa0,PK(0),o[d0],0,0,0);
    o[d0]=__builtin_amdgcn_mfma_f32_32x32x16_bf16(pa1,PK(1),o[d0],0,0,0);
    o[d0]=__builtin_amdgcn_mfma_f32_32x32x16_bf16(pa2,PK(2),o[d0],0,0,0);
    o[d0]=__builtin_amdgcn_mfma_f32_32x32x16_bf16(pa3,PK(3),o[d0],0,0,0);
    #undef PK
  }
}

#ifndef ATTN_STORE16
#define ATTN_STORE16(p,v) (*(u32x4*)(p)=(v))
#endif
template<int THRL> __device__ __forceinline__ void attn_unit(int b,int qb,const bf16*Qh,const bf16*__restrict__ Kh0,const bf16*__restrict__ Vh0,bf16*Oh,float sl,float c32,char*shm,int wid_in,int T0,unsigned*qctr,unsigned qslot){
  const int lane=lane_id_asm(),r32=lane&31,hi=lane>>5; int wid=wid_in; asm volatile("":"+s"(wid));
  const long rowbase=(long)b*SEQ; const int q0=qb*QB;
  const bf16*Qw=Qh+(rowbase+q0+wid*QBLK)*QP;
  const bf16*Kh=Kh0+(rowbase+(long)T0*KVBLK)*KP,*Vh=Vh0+(rowbase+(long)T0*KVBLK)*VP;
  const unsigned lds0=(unsigned)(uintptr_t)shm;
  float*wsf=(float*)(shm+LDS_WS)+wid*64;
  const unsigned koff=(unsigned)(lane*KP+wid*8)*2u;
  const unsigned voff=(unsigned)((16*(wid&3)+(lane>>2))*VP+(wid>>2)*32+(lane&3)*8)*2u;
  const unsigned kdst=lds0+LDS_K+wid*1024, vdst=lds0+LDS_V+wid*1024;
  #define DMA_K(t,slot) glds16(Kh+(long)(t)*KVBLK*KP,koff,(unsigned)__builtin_amdgcn_readfirstlane(kdst+(slot)))
  #define DMA_V(t,slot) glds16(Vh+(long)(t)*KVBLK*VP,voff,(unsigned)__builtin_amdgcn_readfirstlane(vdst+(slot)))
  const char*Kbase=shm+LDS_K; bf16x8 kf[8];
  const lds_cptr shm3=(lds_cptr)shm; const lds_cptr kp0=shm3+LDS_K+hi*1024+r32*16; const lds_cptr vp0=shm3+LDS_V+((lane>>4)&1)*32+(lane&3)*8+(4*hi+((lane&15)>>2))*64;
  const int NT=(q0+QB)/KVBLK-T0;
  DMA_K(0,0);DMA_V(0,0);DMA_K(1,SLOTB);
  bf16x8 qr[4];
  #pragma unroll
  for(int d0=0;d0<4;++d0)qr[d0]=*reinterpret_cast<const bf16x8*>(&Qw[(long)r32*QP+d0*16+hi*8]);
  float l_reg=0.f;f32x16 o[2];o[0]=f32x16{};o[1]=f32x16{};f32x16 negm;
  { float hb_=sl*(float)(4*hi); asm volatile("":"+v"(hb_));
    _Pragma("unroll") for(int r=0;r<16;++r)negm[r]=hb_+sl*(float)((r&3)+8*(r>>2)); }
  asm volatile("":"+v"(negm)); const float sl64=64.f*sl;
  const int qrel=wid*QBLK+r32;
  #define CMASK(P0,P1,t) do{int jb_=(t)-(NT-4); if(jb_>=0)cmask(P0,P1,jb_,qrel,hi);}while(0)
  bool resc=false;
  #define START(P0,P1) do{ const float rm=rowmax(P0,P1); resc=false; \
    { const float dl=rm; \
      _Pragma("unroll") for(int r=0;r<16;++r){P0[r]=fsub_s(P0[r],dl);P1[r]=fsub_s(P1[r],dl);} \
      _Pragma("unroll") for(int r=0;r<16;++r)negm[r]-=dl; asm volatile("":"+v"(negm)); } \
    _Pragma("unroll") for(int r=0;r<16;++r)P0[r]=__builtin_amdgcn_exp2f(P0[r]); }while(0)
  #define RESC() do{ if(resc){ asm volatile("s_waitcnt lgkmcnt(0)":::"memory"); \
      _Pragma("unroll") for(int d_=0;d_<2;++d_) _Pragma("unroll") for(int r=0;r<16;++r)o[d_][r]*=wsf[crow(r,hi)]; } }while(0)
  f32x16 pA0,pA1,pB0,pB1;
  int sl_prev=0,sl_cur=0,sl_next=SLOTB;
  #define ROT() do{sl_prev=sl_cur;sl_cur=sl_next;sl_next=(sl_next==(NSLOT-1)*SLOTB)?0:sl_next+SLOTB;}while(0)
  DMA_K(2,2*SLOTB);
  unsigned nxt_=0u; if(wid==0&&lane==0)nxt_=__hip_atomic_fetch_add(qctr,1u,__ATOMIC_RELAXED,__HIP_MEMORY_SCOPE_AGENT);
  WAIT_BAR(3);
  qkt(pA0,pA1,Kbase,qr,negm,r32,hi);asm volatile("s_nop 15\n\ts_nop 7":"+v"(pA0),"+v"(pA1));CMASK(pA0,pA1,0);
  START(pA0,pA1);
  _Pragma("unroll") for(int r=0;r<16;++r)pA1[r]=__builtin_amdgcn_exp2f(pA1[r]);
  WAIT_BAR(0);
  if(wid==0&&lane==0)*(volatile __attribute__((address_space(3))) unsigned*)(shm3+qslot)=nxt_;
  DMA_K(3,0);DMA_V(1,SLOTB);
  ROT();
  kload8(kf,kp0+sl_cur);
  WAIT_BAR(2);
  s16x4 vlo[8],vhi[8]; u32x4 pw0,pw1,pw2,pw3;
  #define PKW(P,B) cvtpk_s(P[B],P[B+1])
  #define PAF(k) __builtin_bit_cast(bf16x8,pw##k)
  #define VFR(i) (bf16x8){vlo[i][0],vlo[i][1],vlo[i][2],vlo[i][3],vhi[i][0],vhi[i][1],vhi[i][2],vhi[i][3]}
  #define PIN(x) asm volatile("":"+v"(x))
  #define MX3(a,b,c) __builtin_fmaxf(__builtin_fmaxf((a),(b)),(c))
  #define GAPA(MF,SA,A0,A1,A2,A3,W0,W1,PW) do{ MF; SA+=A0; SA+=A1; SA+=A2; SA+=A3; PIN(SA); W0; W1; PIN(PW); SBAR(); }while(0)
  #define GAPA2(MF,A0,A1,B0_,B1_,W0,W1,PW) do{ MF; sacc+=A0; sacc+=A1; saccb=B0_+B1_; PIN(sacc); PIN(saccb); W0; W1; PIN(PW); SBAR(); }while(0)
  #define EX(v) __builtin_amdgcn_exp2f(v)
  #define GAPB(MF,X,B) do{ MF; X[B]=EX(X[B]); X[B+1]=EX(X[B+1]); X[B+2]=EX(X[B+2]); X[B+3]=EX(X[B+3]); PIN(X); SBAR(); }while(0)
  #define VRD(i) do{ vlo[i]=vtr(vp_+(((i)>>2)*4096+((i)&3)*1024)); vhi[i]=vtr(vp_+(((i)>>2)*4096+((i)&3)*1024+512)); }while(0)
  #define KRD(G,j) do{ if(G){ kload2(kf,kp0+sl_next,j); SBAR(); } }while(0)
  #define STEP(C0,C1,P0,P1,t,GK,GV,GL) do{ SBAR(); \
    _Pragma("unroll") for(int r=0;r<16;++r)negm[r]+=sl64; asm volatile("":"+v"(negm)); SBAR(); \
    const lds_cptr vp_=vp0+sl_prev; \
    VRD(0); SBAR(); float sacc=(P0[0]+P0[1]); float saccb; \
    GAPA(C0=__builtin_amdgcn_mfma_f32_32x32x16_bf16(kf[0],qr[0],negm,0,0,0), sacc, P0[2],P0[3],P0[4],P0[5],     pw0[0]=PKW(P0,0), pw0[1]=PKW(P0,2), pw0); \
    VRD(4); SBAR(); GAPA(C1=__builtin_amdgcn_mfma_f32_32x32x16_bf16(kf[1],qr[0],negm,0,0,0), sacc, P0[6],P0[7],P0[8],P0[9],     pw0[2]=PKW(P0,4), pw0[3]=PKW(P0,6), pw0); \
    VRD(1); SBAR(); GAPA(C0=__builtin_amdgcn_mfma_f32_32x32x16_bf16(kf[2],qr[1],C0,0,0,0),   sacc, P0[10],P0[11],P0[12],P0[13], pw1[0]=PKW(P0,8), pw1[1]=PKW(P0,10), pw1); \
    VRD(5); SBAR(); GAPA2(C1=__builtin_amdgcn_mfma_f32_32x32x16_bf16(kf[3],qr[1],C1,0,0,0),   P0[14],P0[15],P1[0],P1[1],   pw1[2]=PKW(P0,12),pw1[3]=PKW(P0,14), pw1); \
    VRD(2); SBAR(); GAPA(C0=__builtin_amdgcn_mfma_f32_32x32x16_bf16(kf[4],qr[2],C0,0,0,0),   saccb, P1[2],P1[3],P1[4],P1[5],     pw2[0]=PKW(P1,0), pw2[1]=PKW(P1,2), pw2); \
    VRD(6); SBAR(); GAPA(C1=__builtin_amdgcn_mfma_f32_32x32x16_bf16(kf[5],qr[2],C1,0,0,0),   saccb, P1[6],P1[7],P1[8],P1[9],     pw2[2]=PKW(P1,4), pw2[3]=PKW(P1,6), pw2); \
    VRD(3); SBAR(); GAPA(C0=__builtin_amdgcn_mfma_f32_32x32x16_bf16(kf[6],qr[3],C0,0,0,0),   saccb, P1[10],P1[11],P1[12],P1[13], pw3[0]=PKW(P1,8), pw3[1]=PKW(P1,10), pw3); \
    VRD(7); SBAR(); GAPA(C1=__builtin_amdgcn_mfma_f32_32x32x16_bf16(kf[7],qr[3],C1,0,0,0),   saccb, P1[14],P1[15],0.f,0.f,       pw3[2]=PKW(P1,12),pw3[3]=PKW(P1,14), pw3); \
    l_reg+=sacc+c32*saccb; \
    if(GK){DMA_K((t)+3,sl_cur);} if(GV){DMA_V((t)+1,sl_next);} \
    CMASK(C0,C1,t); \
    { float a=MX3(C0[0],C0[1],C1[0]),b=MX3(C0[2],C0[3],C1[1]); a=MX3(a,C1[2],C1[3]); \
      _Pragma("unroll") for(int r=4;r<16;r+=4){a=MX3(a,C0[r],C0[r+1]);b=MX3(b,C0[r+2],C0[r+3]);a=MX3(a,C1[r],C1[r+1]);b=MX3(b,C1[r+2],C1[r+3]);} \
      float rm=__builtin_fmaxf(a,b); { auto rr=__builtin_amdgcn_permlane32_swap(__float_as_uint(rm),__float_as_uint(rm),false,false); rm=__builtin_fmaxf(__uint_as_float(rr[0]),__uint_as_float(rr[1])); } \
      resc=false; \
      if(__builtin_expect(__any(rm>(float)THRL),0)){ const float dl=__builtin_fmaxf(rm,0.f); \
        _Pragma("unroll") for(int r=0;r<16;++r){C0[r]-=dl;C1[r]-=dl;} \
        _Pragma("unroll") for(int r=0;r<16;++r)negm[r]-=dl; asm volatile("":"+v"(negm)); \
        const float f=__builtin_amdgcn_exp2f(-dl); l_reg*=f; if(hi==0)wsf[r32]=f; resc=true; } } \
    SBAR(); \
    GAPB(o[0]=__builtin_amdgcn_mfma_f32_32x32x16_bf16(PAF(0),VFR(0),o[0],0,0,0), C0,0); \
    GAPB(o[1]=__builtin_amdgcn_mfma_f32_32x32x16_bf16(PAF(0),VFR(4),o[1],0,0,0), C0,4); \
    KRD(GL,0); GAPB(o[0]=__builtin_amdgcn_mfma_f32_32x32x16_bf16(PAF(1),VFR(1),o[0],0,0,0), C0,8); \
    KRD(GL,1); GAPB(o[1]=__builtin_amdgcn_mfma_f32_32x32x16_bf16(PAF(1),VFR(5),o[1],0,0,0), C0,12); \
    KRD(GL,2); GAPB(o[0]=__builtin_amdgcn_mfma_f32_32x32x16_bf16(PAF(2),VFR(2),o[0],0,0,0), C1,0); \
    KRD(GL,3); GAPB(o[1]=__builtin_amdgcn_mfma_f32_32x32x16_bf16(PAF(2),VFR(6),o[1],0,0,0), C1,4); \
    GAPB(o[0]=__builtin_amdgcn_mfma_f32_32x32x16_bf16(PAF(3),VFR(3),o[0],0,0,0), C1,8); \
    GAPB(o[1]=__builtin_amdgcn_mfma_f32_32x32x16_bf16(PAF(3),VFR(7),o[1],0,0,0), C1,12); \
    }while(0)
  int t=1;
  #undef CMASK
  #define CMASK(P0,P1,t) do{}while(0)
  for(;t+5<NT;t+=2){
    STEP(pB0,pB1,pA0,pA1,t,true,true,true);     WAIT_BAR(2); RESC(); ROT();
    STEP(pA0,pA1,pB0,pB1,t+1,true,true,true);   WAIT_BAR(2); RESC(); ROT();
  }
  #undef CMASK
  #define CMASK(P0,P1,t) do{int jb_=(t)-(NT-4); if(jb_>=0)cmask(P0,P1,jb_,qrel,hi);}while(0)
  #define ENDW(tt) do{ if((tt)+3<NT){WAIT_BAR(2);} else if((tt)+2<NT){WAIT_BAR(1);} else {WAIT_BAR(0);} }while(0)
  for(;t+1<NT;t+=2){
    STEP(pB0,pB1,pA0,pA1,t,(t+3<NT),(t+1<NT),(t+1<NT));       ENDW(t);   RESC(); ROT();
    STEP(pA0,pA1,pB0,pB1,t+1,(t+4<NT),(t+2<NT),(t+2<NT));     ENDW(t+1); RESC(); ROT();
  }
  STEP(pB0,pB1,pA0,pA1,NT-1,false,false,false); RESC();
  { float sacc=pB0[0]+pB0[1]; _Pragma("unroll") for(int r=2;r<16;++r)sacc+=pB0[r]; float saccb=pB1[0]+pB1[1]; _Pragma("unroll") for(int r=2;r<16;++r)saccb+=pB1[r]; l_reg+=sacc+c32*saccb;
    pw0=(u32x4){PKW(pB0,0),PKW(pB0,2),PKW(pB0,4),PKW(pB0,6)};pw1=(u32x4){PKW(pB0,8),PKW(pB0,10),PKW(pB0,12),PKW(pB0,14)};pw2=(u32x4){PKW(pB1,0),PKW(pB1,2),PKW(pB1,4),PKW(pB1,6)};pw3=(u32x4){PKW(pB1,8),PKW(pB1,10),PKW(pB1,12),PKW(pB1,14)};
    SBAR(); pv(o,(int)(unsigned)(unsigned long)(vp0+sl_cur),PAF(0),PAF(1),PAF(2),PAF(3)); }
  #undef PKW
  #undef PAF
  #undef VFR
  #undef PIN
  #undef MX3
  #undef GAPA
  #undef GAPA2
  #undef GAPB
  #undef EX
  #undef VRD
  #undef KRD
  #undef STEP
  #undef ENDW
  {auto rr=__builtin_amdgcn_permlane32_swap(__float_as_uint(l_reg),__float_as_uint(l_reg),false,false);l_reg=__uint_as_float(rr[0])+__uint_as_float(rr[1]);}
  if(hi==0)wsf[32+r32]=l_reg;asm volatile("s_waitcnt lgkmcnt(0)":::"memory");
  float rli[16];
  #pragma unroll
  for(int r=0;r<16;++r)rli[r]=__builtin_amdgcn_rcpf(wsf[32+crow(r,hi)]);
  bf16*Ow=Oh+(rowbase+q0+wid*QBLK)*OP;
  { bf16*stg=(bf16*)(shm+LDS_OST)+wid*2048;
    #pragma unroll
    for(int r=0;r<16;++r){const int orow=crow(r,hi);
      #pragma unroll
      for(int d0=0;d0<2;++d0)stg[orow*64+d0*32+r32]=__float2bfloat16(o[d0][r]*rli[r]);}
    asm volatile("s_waitcnt lgkmcnt(0)":::"memory");
    #pragma unroll
    for(int i=0;i<4;++i){const int row=i*8+(lane>>3),ch=lane&7; const u32x4 v=*(const u32x4*)(stg+row*64+ch*8); ATTN_STORE16(Ow+(long)row*OP+ch*8,v);} }
  asm volatile("s_waitcnt lgkmcnt(0)\n\ts_barrier":::"memory");
  #undef DMA_K
  #undef DMA_V
  #undef CMASK
  #undef START
  #undef RESC
  #undef ROT
}
constexpr int ATTN_LDS_BYTES=LDS_BYTES;
constexpr int A2_K=0, A2_V=4*8192, A2_WS=A2_V+3*16384, A2_BYTES=A2_WS+NW*256;
__device__ __forceinline__ void attn_unit2(int b,int qb,const bf16*Qh,const bf16*__restrict__ Kh0,const bf16*__restrict__ Vh0,bf16*Oh,float sl,float c32,char*shm,int wid_in,int T0,unsigned*qctr,unsigned qslot){
  const int lane=lane_id_asm(),r32=lane&31,hi=lane>>5; int wid=wid_in; asm volatile("":"+s"(wid));
  const long rowbase=(long)b*SEQ; const int q0=qb*QB;
  const bf16*Qw=Qh+(rowbase+q0+wid*QBLK)*QP;
  const bf16*Kh=Kh0+(rowbase+(long)T0*KVBLK)*KP,*Vh=Vh0+(rowbase+(long)T0*KVBLK)*VP;
  const unsigned lds0=(unsigned)(uintptr_t)shm;
  float*wsf=(float*)(shm+A2_WS)+wid*64;
  const unsigned koff=(unsigned)(lane*KP+wid*8)*2u;
  const unsigned voff=(unsigned)((16*(wid&3)+(lane>>2))*VP+(wid>>2)*32+(lane&3)*8)*2u;
  const unsigned kdst=lds0+A2_K+wid*1024, vdst=lds0+A2_V+wid*1024;
  #define DMA_K(t,slot) glds16(Kh+(long)(t)*KVBLK*KP,koff,(unsigned)__builtin_amdgcn_readfirstlane(kdst+(slot)))
  #define DMA_V0(t,slot) glds16(Vh+(long)(t)*KVBLK*VP,voff,(unsigned)__builtin_amdgcn_readfirstlane(vdst+2*(slot)))
  #define DMA_V1(t,slot) glds16(Vh+(long)(t)*KVBLK*VP+64,voff,(unsigned)__builtin_amdgcn_readfirstlane(vdst+2*(slot)+8192))
  #define DMA_V(t,slot) do{ DMA_V0(t,slot); DMA_V1(t,slot); }while(0)
  const char*Kbase=shm+A2_K; bf16x8 kf[8];
  const lds_cptr shm3=(lds_cptr)shm; const lds_cptr kp0=shm3+A2_K+hi*1024+r32*16; const lds_cptr vp0=shm3+A2_V+((lane>>4)&1)*32+(lane&3)*8+(4*hi+((lane&15)>>2))*64;
  const int NT=(q0+QB)/KVBLK-T0;
  DMA_K(0,0);DMA_V(0,0);DMA_K(1,8192);
  bf16x8 qr[4];
  #pragma unroll
  for(int d0=0;d0<4;++d0)qr[d0]=*reinterpret_cast<const bf16x8*>(&Qw[(long)r32*QP+d0*16+hi*8]);
  float l_reg=0.f;f32x16 o[4];o[0]=f32x16{};o[1]=f32x16{};o[2]=f32x16{};o[3]=f32x16{};f32x16 negm;
  { float hb_=sl*(float)(64*T0-q0-QBLK*wid-r32+4*hi); asm volatile("":"+v"(hb_));
    _Pragma("unroll") for(int r=0;r<16;++r)negm[r]=hb_+sl*(float)((r&3)+8*(r>>2)); }
  asm volatile("":"+v"(negm)); const float sl64=64.f*sl;
  const int qrel=wid*QBLK+r32;
  #define CMASK(P0,P1,t) do{int jb_=(t)-(NT-4); if(jb_>=0)cmask(P0,P1,jb_,qrel,hi);}while(0)
  int sl_prev=0,sl_cur=0,sl_next=8192;
  #define ROT() do{sl_prev=sl_cur;sl_cur=sl_next;sl_next=(sl_next==2*8192)?0:sl_next+8192;}while(0)
  DMA_K(2,2*8192);
  #define KSL(t) (((t)&3)*8192)
  unsigned nxt_=0u; if(wid==0&&lane==0)nxt_=__hip_atomic_fetch_add(qctr,1u,__ATOMIC_RELAXED,__HIP_MEMORY_SCOPE_AGENT);
  WAIT_BAR(3);
  u32x4 pwA0,pwA1,pwA2,pwA3,pwB0,pwB1,pwB2,pwB3;
  #define PKW(P,B) cvtpk_s(P[B],P[B+1])
  #define EX(v) __builtin_amdgcn_exp2f(v)
  #define PIN(x) asm volatile("":"+v"(x))
  { f32x16 c0,c1; qkt(c0,c1,Kbase,qr,negm,r32,hi); CMASK(c0,c1,0);
    float sa=0.f,sb=0.f;
    _Pragma("unroll") for(int r=0;r<16;++r){c0[r]=EX(c0[r]);c1[r]=EX(c1[r]);sa+=c0[r];sb+=c1[r];}
    l_reg+=sa+c32*sb;
    pwA0=(u32x4){PKW(c0,0),PKW(c0,2),PKW(c0,4),PKW(c0,6)};pwA1=(u32x4){PKW(c0,8),PKW(c0,10),PKW(c0,12),PKW(c0,14)};pwA2=(u32x4){PKW(c1,0),PKW(c1,2),PKW(c1,4),PKW(c1,6)};pwA3=(u32x4){PKW(c1,8),PKW(c1,10),PKW(c1,12),PKW(c1,14)}; }
  WAIT_BAR(0);
  if(wid==0&&lane==0)*(volatile __attribute__((address_space(3))) unsigned*)(shm3+qslot)=nxt_;
  DMA_K(3,3*8192);DMA_V(1,8192);
  ROT();
  kload2(kf,kp0+KSL(1),0); kload2(kf,kp0+KSL(1),1);
  _Pragma("unroll") for(int r=0;r<16;++r)negm[r]+=sl64;
  s16x4 vlo[8],vhi[8];
  #define PAFI(PI,k) __builtin_bit_cast(bf16x8,PI##k)
  #define VFR(i) (bf16x8){vlo[i][0],vlo[i][1],vlo[i][2],vlo[i][3],vhi[i][0],vhi[i][1],vhi[i][2],vhi[i][3]}
  #define VRD(ks,d) do{ vlo[((ks)&1)*4+(d)]=vtr(vp_+((d)*4096+(ks)*1024)); vhi[((ks)&1)*4+(d)]=vtr(vp_+((d)*4096+(ks)*1024+512)); }while(0)
  #define GAPQ(MF) do{ MF; SBAR(); }while(0)
  #define GAPN(MF,B) do{ MF; negm[B]+=sl64; negm[B+1]+=sl64; negm[B+2]+=sl64; negm[B+3]+=sl64; PIN(negm); SBAR(); }while(0)
  #define GAPB(MF,RD,X,SA,B,PO,W) do{ MF; RD; X[B]=EX(X[B]); X[B+1]=EX(X[B+1]); SA+=X[B]; SA+=X[B+1]; PO[W]=PKW(X,B); PIN(X); PIN(SA); PIN(PO); SBAR(); }while(0)
  #define STEP2(PI,PO,t,GK,GV,GL) do{ SBAR(); \
    const lds_cptr vp_=vp0+2*sl_prev; const lds_cptr kq_=kp0+KSL(t); f32x16 C0,C1; float sa=0.f,sb=0.f; \
    kload2(kf,kq_,2); VRD(0,0); SBAR(); kload2(kf,kq_,3); VRD(0,1); SBAR(); \
    GAPQ(C0=__builtin_amdgcn_mfma_f32_32x32x16_bf16(kf[0],qr[0],negm,0,0,0)); \
    VRD(0,2); SBAR(); GAPQ(C1=__builtin_amdgcn_mfma_f32_32x32x16_bf16(kf[1],qr[0],negm,0,0,0)); \
    VRD(0,3); SBAR(); GAPN(C0=__builtin_amdgcn_mfma_f32_32x32x16_bf16(kf[2],qr[1],C0,0,0,0),0); \
    VRD(1,0); SBAR(); GAPN(C1=__builtin_amdgcn_mfma_f32_32x32x16_bf16(kf[3],qr[1],C1,0,0,0),4); \
    VRD(1,1); SBAR(); GAPN(C0=__builtin_amdgcn_mfma_f32_32x32x16_bf16(kf[4],qr[2],C0,0,0,0),8); \
    VRD(1,2); SBAR(); GAPN(C1=__builtin_amdgcn_mfma_f32_32x32x16_bf16(kf[5],qr[2],C1,0,0,0),12); \
    VRD(1,3); SBAR(); GAPQ(C0=__builtin_amdgcn_mfma_f32_32x32x16_bf16(kf[6],qr[3],C0,0,0,0)); \
    GAPQ(C1=__builtin_amdgcn_mfma_f32_32x32x16_bf16(kf[7],qr[3],C1,0,0,0)); \
    CMASK(C0,C1,t); SBAR(); \
    GAPB(o[0]=__builtin_amdgcn_mfma_f32_32x32x16_bf16(PAFI(PI,0),VFR(0),o[0],0,0,0), VRD(2,0), C0,sa,0, PO##0,0); \
    GAPB(o[1]=__builtin_amdgcn_mfma_f32_32x32x16_bf16(PAFI(PI,0),VFR(1),o[1],0,0,0), VRD(2,1), C0,sa,2, PO##0,1); \
    GAPB(o[2]=__builtin_amdgcn_mfma_f32_32x32x16_bf16(PAFI(PI,0),VFR(2),o[2],0,0,0), VRD(2,2), C0,sa,4, PO##0,2); \
    GAPB(o[3]=__builtin_amdgcn_mfma_f32_32x32x16_bf16(PAFI(PI,0),VFR(3),o[3],0,0,0), VRD(2,3), C0,sa,6, PO##0,3); \
    GAPB(o[0]=__builtin_amdgcn_mfma_f32_32x32x16_bf16(PAFI(PI,1),VFR(4),o[0],0,0,0), VRD(3,0), C0,sa,8, PO##1,0); \
    GAPB(o[1]=__builtin_amdgcn_mfma_f32_32x32x16_bf16(PAFI(PI,1),VFR(5),o[1],0,0,0), VRD(3,1), C0,sa,10, PO##1,1); \
    GAPB(o[2]=__builtin_amdgcn_mfma_f32_32x32x16_bf16(PAFI(PI,1),VFR(6),o[2],0,0,0), VRD(3,2), C0,sa,12, PO##1,2); \
    GAPB(o[3]=__builtin_amdgcn_mfma_f32_32x32x16_bf16(PAFI(PI,1),VFR(7),o[3],0,0,0), VRD(3,3), C0,sa,14, PO##1,3); \
    GAPB(o[0]=__builtin_amdgcn_mfma_f32_32x32x16_bf16(PAFI(PI,2),VFR(0),o[0],0,0,0), if(GK){DMA_K((t)+3,KSL((t)+3));}, C1,sb,0, PO##2,0); \
    GAPB(o[1]=__builtin_amdgcn_mfma_f32_32x32x16_bf16(PAFI(PI,2),VFR(1),o[1],0,0,0), if(GL){kload2(kf,kp0+KSL((t)+1),0);}, C1,sb,2, PO##2,1); \
    GAPB(o[2]=__builtin_amdgcn_mfma_f32_32x32x16_bf16(PAFI(PI,2),VFR(2),o[2],0,0,0), if(GV){DMA_V0((t)+1,sl_next);}, C1,sb,4, PO##2,2); \
    GAPB(o[3]=__builtin_amdgcn_mfma_f32_32x32x16_bf16(PAFI(PI,2),VFR(3),o[3],0,0,0), if(GL){kload2(kf,kp0+KSL((t)+1),1);}, C1,sb,6, PO##2,3); \
    GAPB(o[0]=__builtin_amdgcn_mfma_f32_32x32x16_bf16(PAFI(PI,3),VFR(4),o[0],0,0,0), if(GV){DMA_V1((t)+1,sl_next);}, C1,sb,8, PO##3,0); \
    GAPB(o[1]=__builtin_amdgcn_mfma_f32_32x32x16_bf16(PAFI(PI,3),VFR(5),o[1],0,0,0), (void)0, C1,sb,10, PO##3,1); \
    GAPB(o[2]=__builtin_amdgcn_mfma_f32_32x32x16_bf16(PAFI(PI,3),VFR(6),o[2],0,0,0), (void)0, C1,sb,12, PO##3,2); \
    GAPB(o[3]=__builtin_amdgcn_mfma_f32_32x32x16_bf16(PAFI(PI,3),VFR(7),o[3],0,0,0), (void)0, C1,sb,14, PO##3,3); \
    l_reg+=sa+c32*sb; \
    }while(0)
  int t=1;
  #undef CMASK
  #define CMASK(P0,P1,t) do{}while(0)
  for(;t+5<NT;t+=2){
    STEP2(pwA,pwB,t,true,true,true);     WAIT_BAR(3); ROT();
    STEP2(pwB,pwA,t+1,true,true,true);   WAIT_BAR(3); ROT();
  }
  #undef CMASK
  #define CMASK(P0,P1,t) do{int jb_=(t)-(NT-4); if(jb_>=0)cmask(P0,P1,jb_,qrel,hi);}while(0)
  #define ENDW(tt) do{ if((tt)+3<NT){WAIT_BAR(3);} else if((tt)+2<NT){WAIT_BAR(2);} else {WAIT_BAR(0);} }while(0)
  for(;t+1<NT;t+=2){
    STEP2(pwA,pwB,t,(t+3<NT),(t+1<NT),(t+1<NT));       ENDW(t);   ROT();
    STEP2(pwB,pwA,t+1,(t+4<NT),(t+2<NT),(t+2<NT));     ENDW(t+1); ROT();
  }
  STEP2(pwA,pwB,NT-1,false,false,false);
  { const int vb=(int)(unsigned)(unsigned long)(vp0+2*sl_cur);
    #pragma unroll
    for(int d0=0;d0<4;++d0){s16x4 lo[4],hh[4];
      #pragma unroll
      for(int ks=0;ks<4;++ks){
        asm volatile("ds_read_b64_tr_b16 %0,%1 offset:%c2":"=&v"(lo[ks]):"v"(vb),"i"(d0*4096+ks*1024):"memory");
        asm volatile("ds_read_b64_tr_b16 %0,%1 offset:%c2":"=&v"(hh[ks]):"v"(vb),"i"(d0*4096+ks*1024+512):"memory");}
      asm volatile("s_waitcnt lgkmcnt(0)":::"memory");SBAR();
      #define PK(k) (bf16x8){lo[k][0],lo[k][1],lo[k][2],lo[k][3],hh[k][0],hh[k][1],hh[k][2],hh[k][3]}
      o[d0]=__builtin_amdgcn_mfma_f32_32x32x16_bf16(PAFI(pwB,0),PK(0),o[d0],0,0,0);
      o[d0]=__builtin_amdgcn_mfma_f32_32x32x16_bf16(PAFI(pwB,1),PK(1),o[d0],0,0,0);
      o[d0]=__builtin_amdgcn_mfma_f32_32x32x16_bf16(PAFI(pwB,2),PK(2),o[d0],0,0,0);
      o[d0]=__builtin_amdgcn_mfma_f32_32x32x16_bf16(PAFI(pwB,3),PK(3),o[d0],0,0,0);
      #undef PK
    } }
  {auto rr=__builtin_amdgcn_permlane32_swap(__float_as_uint(l_reg),__float_as_uint(l_reg),false,false);l_reg=__uint_as_float(rr[0])+__uint_as_float(rr[1]);}
  if(hi==0)wsf[32+r32]=l_reg;
  asm volatile("s_waitcnt lgkmcnt(0)\n\ts_barrier":::"memory");
  float rli[16];
  #pragma unroll
  for(int r=0;r<16;++r)rli[r]=__builtin_amdgcn_rcpf(wsf[32+crow(r,hi)]);
  bf16*Ow=Oh+(rowbase+q0+wid*QBLK)*OP;
  { bf16*stg=(bf16*)(shm)+wid*4096;
    #pragma unroll
    for(int r=0;r<16;++r){const int orow=crow(r,hi);
      #pragma unroll
      for(int d0=0;d0<4;++d0)stg[orow*128+d0*32+r32]=__float2bfloat16(o[d0][r]*rli[r]);}
    asm volatile("s_waitcnt lgkmcnt(0)":::"memory");
    #pragma unroll
    for(int i=0;i<8;++i){const int row=i*4+(lane>>4),ch=lane&15; const u32x4 v=*(const u32x4*)(stg+row*128+ch*8); ATTN_STORE16(Ow+(long)row*OP+ch*8,v);} }
  asm volatile("s_waitcnt lgkmcnt(0)\n\ts_barrier":::"memory");
  #undef DMA_K
  #undef DMA_V
  #undef DMA_V0
  #undef DMA_V1
  #undef CMASK
  #undef ROT
  #undef PKW
  #undef EX
  #undef PIN
  #undef PAFI
  #undef VFR
  #undef VRD
  #undef KSL
  #undef GAPQ
  #undef GAPN
  #undef GAPB
  #undef STEP2
  #undef ENDW
}
#undef SBAR
#undef WAIT_BAR
}

constexpr int NWAVES = 8;
constexpr int M = 32768, DMODEL = 1024, NIN = 3584, SEQL = 4096;
constexpr size_t MiB = 1u << 20;
constexpr size_t WS_ROWSS = 0;
constexpr size_t WS_WIN = 2 * MiB, WS_WO = 10 * MiB, WS_PW = 12 * MiB;
constexpr size_t WS_XN = 16 * MiB, WS_O = WS_XN;
constexpr size_t WS_HG = 80 * MiB, WS_CG = 112 * MiB, WS_Q = 144 * MiB, WS_K = 176 * MiB, WS_V = 208 * MiB, WS_DG = 240 * MiB, WS_U = 272 * MiB;
constexpr size_t WS_Y = 304 * MiB, WS_Y2 = 368 * MiB, WS_END = 432 * MiB;
constexpr int RING_BYTES = 131072, LDS_BYTES = 147456, LDSCTL_OFF = RING_BYTES;
constexpr size_t WS_BAR = 512 * 1024, WS_BAR_BYTES = 16384;
constexpr int NMAX_WORD = 3600, QCTR_WORD = 3712;
#define GAS __attribute__((address_space(1)))
#define LAS __attribute__((address_space(3)))
typedef unsigned short bf16;
typedef unsigned v4u __attribute__((ext_vector_type(4)));
typedef unsigned v2u __attribute__((ext_vector_type(2)));
typedef float f32x4 __attribute__((ext_vector_type(4)));
typedef float f32x2 __attribute__((ext_vector_type(2)));
#define LDS_WAIT() asm volatile("s_waitcnt lgkmcnt(0)" ::: "memory")
__device__ __forceinline__ unsigned pk2(float lo, float hi) { return pg8::cvt_pk_bf16(lo, hi); }
__device__ __forceinline__ float wave_sum(float v) {
#pragma unroll
    for (int o = 1; o < 64; o <<= 1) v += __shfl_xor(v, o);
    return v;
}
__device__ __forceinline__ void p0_transpose_item(const float* W, int K, int N, bf16* WT, int k0, int n0, int dst_row0, LAS float* scr, int lane) {
#pragma unroll
    for (int i = 0; i < 32; ++i) { const int kk = 2 * i + (lane >> 5); scr[kk * 33 + (lane & 31)] = W[(size_t)(k0 + kk) * N + n0 + (lane & 31)]; }
    LDS_WAIT(); asm volatile("" ::: "memory");
    const int c = lane & 7;
#pragma unroll
    for (int j = 0; j < 4; ++j) { const int n = (lane >> 3) + 8 * j; const LAS float* p = scr + (8 * c) * 33 + n;
        v4u o; o.x = pk2(p[0 * 33], p[1 * 33]); o.y = pk2(p[2 * 33], p[3 * 33]); o.z = pk2(p[4 * 33], p[5 * 33]); o.w = pk2(p[6 * 33], p[7 * 33]);
        *(v4u*)(WT + (size_t)(dst_row0 + n) * K + k0 + 8 * c) = o; }
    LDS_WAIT(); asm volatile("" ::: "memory");
}
__device__ __forceinline__ int win_dst_row(int n0) {
    if (n0 >= 1024) return n0;
    if (n0 < 512) return 256 * (n0 >> 7) + (n0 & 127);
    const int n1 = n0 - 512; return 256 * (n1 >> 7) + 128 + (n1 & 127);
}

#define RLX_AGENT __ATOMIC_RELAXED, __HIP_MEMORY_SCOPE_AGENT
#define XB_TMO      128
#define XB_XCNT(j)  (256  + 64 * (j))
#define XB_XSUB(j)  (1280 + 64 * (j))
#define XB_XGEN(j)  (2304 + 64 * (j))
#define XB_TOP      3328
#define XB_TOPGEN   3392
#define XCD_BAR_WORDS 3456
#define XB_SPIN_CAP (1u << 18)

__device__ __forceinline__ unsigned xb_ld(unsigned* p)              { return __hip_atomic_load(p, __ATOMIC_RELAXED, __HIP_MEMORY_SCOPE_AGENT); }
__device__ __forceinline__ unsigned xb_add(unsigned* p, unsigned v) { return __hip_atomic_fetch_add(p, v, __ATOMIC_RELAXED, __HIP_MEMORY_SCOPE_AGENT); }
__device__ __forceinline__ unsigned xb_xcc_id() { return (unsigned)__builtin_amdgcn_s_getreg((3 << 11) | 20) & 0xFu; }
#define XB_SPIN(cond, bar) do { unsigned _sp = 0; while (cond) { __builtin_amdgcn_s_sleep(1); \
    if ((++_sp & 255u) == 0u) { if (xb_ld(&(bar)[XB_TMO])) break; if (_sp > XB_SPIN_CAP) { atomicAdd(&(bar)[XB_TMO], 1u); break; } } } } while (0)

struct XcdBarrier {
    unsigned* bar; unsigned x;
    volatile LAS unsigned* st;
};

__device__ __forceinline__ XcdBarrier xcd_barrier_post(unsigned* bar, volatile LAS unsigned* st) {
    XcdBarrier b; b.bar = bar; b.x = xb_xcc_id(); b.st = st;
    if (threadIdx.x == 0) (void)xb_add(&bar[XB_XCNT(b.x)], 1u);
    return b;
}
__device__ __forceinline__ void xcd_barrier_complete(unsigned* bar, unsigned x, unsigned& nloc, unsigned& nx) {
    const unsigned G = gridDim.x * gridDim.y * gridDim.z;
    unsigned sum, cnt, mine, sp = 0u;
    for (;;) {
        sum = 0u; cnt = 0u; mine = 0u;
#pragma unroll
        for (unsigned j = 0; j < 16; ++j) { const unsigned c = xb_ld(&bar[XB_XCNT(j)]); sum += c; cnt += (c > 0u) ? 1u : 0u; mine = (j == x) ? c : mine; }
        if (sum == G) break;
        __builtin_amdgcn_s_sleep(1);
        if ((++sp & 255u) == 0u) { if (xb_ld(&bar[XB_TMO])) break; if (sp > XB_SPIN_CAP) { atomicAdd(&bar[XB_TMO], 1u); break; } }
    }
    nloc = mine > 0u ? mine : 1u; nx = cnt > 0u ? cnt : 1u;
}

__device__ __forceinline__ void xcd_barrier(const XcdBarrier& b) {
    asm volatile("s_waitcnt vmcnt(0)" ::: "memory");
    __syncthreads();
    if (threadIdx.x == 0) {
        unsigned* bar = b.bar;
        __builtin_amdgcn_s_waitcnt(0);
        unsigned nloc = b.st[0], nx = b.st[1];
        if (nloc == 0u) { xcd_barrier_complete(bar, b.x, nloc, nx); b.st[0] = nloc; b.st[1] = nx; }
        const unsigned old = xb_add(&bar[XB_XSUB(b.x)], 1u);
        const unsigned gen = old / nloc;
        if (old + 1u == (gen + 1u) * nloc) {
            __builtin_amdgcn_fence(__ATOMIC_RELEASE, "agent");
            asm volatile("s_waitcnt vmcnt(0)" ::: "memory");
            const unsigned og = xb_add(&bar[XB_TOP], 1u);
            const unsigned tg = og / nx;
            if (og + 1u == (tg + 1u) * nx) xb_add(&bar[XB_TOPGEN], 1u);
            else XB_SPIN(xb_ld(&bar[XB_TOPGEN]) == tg, bar);
            __builtin_amdgcn_fence(__ATOMIC_ACQUIRE, "agent");
            xb_add(&bar[XB_XGEN(b.x)], 1u);
            asm volatile("s_waitcnt vmcnt(0)" ::: "memory");
        } else {
            XB_SPIN(xb_ld(&bar[XB_XGEN(b.x)]) == gen, bar);
            __builtin_amdgcn_fence(__ATOMIC_ACQUIRE, "agent");
            asm volatile("s_waitcnt vmcnt(0)" ::: "memory");
        }
    }
    __syncthreads();
}

constexpr int CONV_IN_BYTES = 62 * 1024;
__device__ __forceinline__ void conv_phase(LAS unsigned char* lds, int u0, int ustride, int nunits, const bf16* Hg, const float* dw_w, const float* dw_b, const float* ln_g, const float* ln_b, bf16* U, int tid, int lane, int wave) {
    const int cp = tid & 255, tg = tid >> 8;
    f32x2 w[31];
#pragma unroll
    for (int j = 0; j < 31; ++j) w[j] = *(const f32x2*)(dw_w + j * 512 + 2 * cp);
    const f32x2 bias = *(const f32x2*)(dw_b + 2 * cp);
    f32x4 gg[2], bb[2];
#pragma unroll
    for (int j = 0; j < 2; ++j) { gg[j] = *((const f32x4*)ln_g + lane + 64 * j); bb[j] = *((const f32x4*)ln_b + lane + 64 * j); }
    v4u pre[8];
#define CONV_PREFETCH(unit) do { const int row0_ = (unit) * 32, t0_ = row0_ & (SEQL - 1); _Pragma("unroll") for (int k = 0; k < 8; ++k) { const int i = tid + 512 * k, r = i >> 6, ch = i & 63; pre[k] = (v4u){0u, 0u, 0u, 0u}; \
        if (i < 62 * 64 && t0_ - 30 + r >= 0) pre[k] = *(const v4u*)(Hg + (size_t)(row0_ - 30 + r) * 512 + ch * 8); } } while (0)
    if (u0 < nunits) CONV_PREFETCH(u0);
    for (int unit = u0; unit < nunits; unit += ustride) {
        const int row0 = unit * 32;
#pragma unroll
        for (int k = 0; k < 8; ++k) { const int i = tid + 512 * k, r = i >> 6, ch = i & 63; if (i < 62 * 64) *(LAS v4u*)(lds + r * 1024 + ch * 16) = pre[k]; }
        __syncthreads();
        if (unit + ustride < nunits) CONV_PREFETCH(unit + ustride);
#pragma unroll 1
        for (int g = 0; g < 2; ++g) {
            const int tl0 = tg * 16 + g * 8;
            f32x2 acc[8];
#pragma unroll
            for (int o = 0; o < 8; ++o) acc[o] = bias;
#pragma unroll
            for (int i = 0; i < 38; ++i) { const unsigned wv = *(const LAS unsigned*)(lds + (tl0 + i) * 1024 + cp * 4); const f32x2 x = {pg8::bf_lo(wv), pg8::bf_hi(wv)};
#pragma unroll
                for (int o = 0; o < 8; ++o) { const int j = i - o; if (j >= 0 && j <= 30) acc[o] += w[j] * x; } }
#pragma unroll
            for (int o = 0; o < 8; ++o) *(LAS f32x2*)(lds + CONV_IN_BYTES + (tl0 + o) * 2048 + cp * 8) = acc[o];
        }
        __syncthreads();
        f32x4 v[4][2]; float s1[4], s2[4];
#pragma unroll
        for (int k = 0; k < 4; ++k) { const int tl = wave * 4 + k; s1[k] = 0.f;
#pragma unroll
            for (int j = 0; j < 2; ++j) { v[k][j] = *(const LAS f32x4*)(lds + CONV_IN_BYTES + tl * 2048 + (lane + 64 * j) * 16); s1[k] += (v[k][j].x + v[k][j].y) + (v[k][j].z + v[k][j].w); } }
#pragma unroll
        for (int o = 1; o < 64; o <<= 1) {
#pragma unroll
            for (int k = 0; k < 4; ++k) s1[k] += __shfl_xor(s1[k], o); }
#pragma unroll
        for (int k = 0; k < 4; ++k) { const float mean = s1[k] * (1.f / 512.f); s2[k] = 0.f;
#pragma unroll
            for (int j = 0; j < 2; ++j) { v[k][j] = v[k][j] - mean; s2[k] += (v[k][j].x * v[k][j].x + v[k][j].y * v[k][j].y) + (v[k][j].z * v[k][j].z + v[k][j].w * v[k][j].w); } }
#pragma unroll
        for (int o = 1; o < 64; o <<= 1) {
#pragma unroll
            for (int k = 0; k < 4; ++k) s2[k] += __shfl_xor(s2[k], o); }
#pragma unroll
        for (int k = 0; k < 4; ++k) { const int tl = wave * 4 + k; const float rstd = 1.f / sqrtf(s2[k] * (1.f / 512.f) + 1e-5f);
#pragma unroll
            for (int j = 0; j < 2; ++j) { f32x4 y = v[k][j] * rstd * gg[j] + bb[j];
                y.x = pg8::silu_f(y.x); y.y = pg8::silu_f(y.y); y.z = pg8::silu_f(y.z); y.w = pg8::silu_f(y.w);
                v2u o; o.x = pk2(y.x, y.y); o.y = pk2(y.z, y.w); *(v2u*)(U + (size_t)(row0 + tl) * 512 + (lane + 64 * j) * 4) = o; } }
        __syncthreads();
    }
#undef CONV_PREFETCH
}

__device__ __forceinline__ void conv_phase_dyn(LAS unsigned char* lds, int cur, unsigned* qctr, int qbase  , int nunits, const bf16* Hg, const float* dw_w, const float* dw_b, const float* ln_g, const float* ln_b, bf16* U, int tid, int lane, int wave) {
    const int cp = tid & 255, tg = tid >> 8;
    f32x2 w[31];
#pragma unroll
    for (int j = 0; j < 31; ++j) w[j] = *(const f32x2*)(dw_w + j * 512 + 2 * cp);
    const f32x2 bias = *(const f32x2*)(dw_b + 2 * cp);
    f32x4 gg[2], bb[2];
#pragma unroll
    for (int j = 0; j < 2; ++j) { gg[j] = *((const f32x4*)ln_g + lane + 64 * j); bb[j] = *((const f32x4*)ln_b + lane + 64 * j); }
    v4u pre[8];
#define CONV_PREFETCH(unit) do { const int row0_ = (unit) * 32, t0_ = row0_ & (SEQL - 1); _Pragma("unroll") for (int k = 0; k < 8; ++k) { const int i = tid + 512 * k, r = i >> 6, ch = i & 63; pre[k] = (v4u){0u, 0u, 0u, 0u}; \
        if (i < 62 * 64 && t0_ - 30 + r >= 0) pre[k] = *(const v4u*)(Hg + (size_t)(row0_ - 30 + r) * 512 + ch * 8); } } while (0)
    const bool popper = (wave == 0 && lane == 0); volatile LAS unsigned* slot = (volatile LAS unsigned*)(lds + LDSCTL_OFF + 224);
    if (popper) slot[0] = __hip_atomic_fetch_add(qctr, 1u, __ATOMIC_RELAXED, __HIP_MEMORY_SCOPE_AGENT);
    __syncthreads();
    int nxt = qbase + (int)__builtin_amdgcn_readfirstlane(slot[0]);
    if (cur < nunits) CONV_PREFETCH(cur);
    while (cur < nunits) {
        const int unit = cur; const int row0 = unit * 32;
#pragma unroll
        for (int k = 0; k < 8; ++k) { const int i = tid + 512 * k, r = i >> 6, ch = i & 63; if (i < 62 * 64) *(LAS v4u*)(lds + r * 1024 + ch * 16) = pre[k]; }
        __syncthreads();
        unsigned pv = 0u; if (popper) pv = __hip_atomic_fetch_add(qctr, 1u, __ATOMIC_RELAXED, __HIP_MEMORY_SCOPE_AGENT);
        if (nxt < nunits) CONV_PREFETCH(nxt);
#pragma unroll 1
        for (int g = 0; g < 2; ++g) {
            const int tl0 = tg * 16 + g * 8;
            f32x2 acc[8];
#pragma unroll
            for (int o = 0; o < 8; ++o) acc[o] = bias;
#pragma unroll
            for (int i = 0; i < 38; ++i) { const unsigned wv = *(const LAS unsigned*)(lds + (tl0 + i) * 1024 + cp * 4); const f32x2 x = {pg8::bf_lo(wv), pg8::bf_hi(wv)};
#pragma unroll
                for (int o = 0; o < 8; ++o) { const int j = i - o; if (j >= 0 && j <= 30) acc[o] += w[j] * x; } }
#pragma unroll
            for (int o = 0; o < 8; ++o) *(LAS f32x2*)(lds + CONV_IN_BYTES + (tl0 + o) * 2048 + cp * 8) = acc[o];
        }
        __syncthreads();
        f32x4 v[4][2]; float s1[4], s2[4];
#pragma unroll
        for (int k = 0; k < 4; ++k) { const int tl = wave * 4 + k; s1[k] = 0.f;
#pragma unroll
            for (int j = 0; j < 2; ++j) { v[k][j] = *(const LAS f32x4*)(lds + CONV_IN_BYTES + tl * 2048 + (lane + 64 * j) * 16); s1[k] += (v[k][j].x + v[k][j].y) + (v[k][j].z + v[k][j].w); } }
#pragma unroll
        for (int o = 1; o < 64; o <<= 1) {
#pragma unroll
            for (int k = 0; k < 4; ++k) s1[k] += __shfl_xor(s1[k], o); }
#pragma unroll
        for (int k = 0; k < 4; ++k) { const float mean = s1[k] * (1.f / 512.f); s2[k] = 0.f;
#pragma unroll
            for (int j = 0; j < 2; ++j) { v[k][j] = v[k][j] - mean; s2[k] += (v[k][j].x * v[k][j].x + v[k][j].y * v[k][j].y) + (v[k][j].z * v[k][j].z + v[k][j].w * v[k][j].w); } }
#pragma unroll
        for (int o = 1; o < 64; o <<= 1) {
#pragma unroll
            for (int k = 0; k < 4; ++k) s2[k] += __shfl_xor(s2[k], o); }
#pragma unroll
        for (int k = 0; k < 4; ++k) { const int tl = wave * 4 + k; const float rstd = 1.f / sqrtf(s2[k] * (1.f / 512.f) + 1e-5f);
#pragma unroll
            for (int j = 0; j < 2; ++j) { f32x4 y = v[k][j] * rstd * gg[j] + bb[j];
                y.x = pg8::silu_f(y.x); y.y = pg8::silu_f(y.y); y.z = pg8::silu_f(y.z); y.w = pg8::silu_f(y.w);
                v2u o; o.x = pk2(y.x, y.y); o.y = pk2(y.z, y.w); *(v2u*)(U + (size_t)(row0 + tl) * 512 + (lane + 64 * j) * 4) = o; } }
        if (popper) slot[0] = pv;
        __syncthreads();
        cur = nxt; nxt = qbase + (int)__builtin_amdgcn_readfirstlane(slot[0]);
        __syncthreads();
    }
#undef CONV_PREFETCH
}

struct Args { const float* in[16]; float* out; unsigned char* ws; };
__global__ void __launch_bounds__(NWAVES * 64, 2) fwd_megakernel(Args args) {
    extern __shared__ __attribute__((aligned(16))) unsigned char lds[];
    cg::grid_group grid = cg::this_grid();
    LAS unsigned char* L = (LAS unsigned char*)lds;
    const int wave = __builtin_amdgcn_readfirstlane(threadIdx.x >> 6);
#define FRESH_TID() const int lane = lane_id_asm(); const int tid = wave * 64 + lane; (void)tid
    const int G = gridDim.x; const int bx = blockIdx.x; const int vcu = (G % 8 == 0) ? (bx % 8) * (G / 8) + bx / 8 : bx;
    const int gw = vcu * NWAVES + wave, NGW = G * NWAVES;
#define CA4 __attribute__((address_space(4)))
#define PHASE_PTRS() \
    const CA4 Args* A_; { auto kp_ = __builtin_amdgcn_kernarg_segment_ptr(); asm volatile("" : "+s"(kp_)); A_ = (const CA4 Args*)kp_; } \
    unsigned char* ws = A_->ws; (void)ws; \
    const float* x = A_->in[0]; const float* pre_g = A_->in[1]; const float* w_in = A_->in[2]; const float* dw_w = A_->in[3]; const float* dw_b = A_->in[4]; \
    const float* cln_g = A_->in[5]; const float* cln_b = A_->in[6]; const float* pw_w = A_->in[7]; const float* pw_b = A_->in[8]; \
    const float* lq1 = A_->in[9]; const float* lk1 = A_->in[10]; const float* lq2 = A_->in[11]; const float* lk2 = A_->in[12]; \
    const float* sub_g = A_->in[13]; const float* w_out = A_->in[14]; const float* post_g = A_->in[15]; float* out = A_->out; \
    float* rowss = (float*)(ws + WS_ROWSS); \
    bf16 *WinT = (bf16*)(ws + WS_WIN), *WoT = (bf16*)(ws + WS_WO), *PwT = (bf16*)(ws + WS_PW), *XN = (bf16*)(ws + WS_XN), *OB = (bf16*)(ws + WS_O); \
    bf16 *HG = (bf16*)(ws + WS_HG), *CGB = (bf16*)(ws + WS_CG), *QB_ = (bf16*)(ws + WS_Q), *KB = (bf16*)(ws + WS_K), *VB = (bf16*)(ws + WS_V), *DGB = (bf16*)(ws + WS_DG), *UB = (bf16*)(ws + WS_U); \
    bf16 *YB = (bf16*)(ws + WS_Y), *Y2 = (bf16*)(ws + WS_Y2); \
    (void)x; (void)pre_g; (void)w_in; (void)dw_w; (void)dw_b; (void)cln_g; (void)cln_b; (void)pw_w; (void)pw_b; (void)lq1; (void)lk1; (void)lq2; (void)lk2; (void)sub_g; (void)w_out; (void)post_g; (void)out; \
    (void)rowss; (void)WinT; (void)WoT; (void)PwT; (void)XN; (void)OB; (void)HG; (void)CGB; (void)QB_; (void)KB; (void)VB; (void)DGB; (void)UB; (void)YB; (void)Y2
    if (threadIdx.x < 128) ((LAS unsigned*)(L + LDSCTL_OFF))[threadIdx.x] = 0u;
    __syncthreads();
    XcdBarrier bar = xcd_barrier_post((unsigned*)(args.ws + WS_BAR), (volatile LAS unsigned*)(L + LDSCTL_OFF));
    if (args.ws == nullptr) grid.sync();

    {
        PHASE_PTRS(); FRESH_TID();
        LAS float* scr = (LAS float*)(L + wave * 16384);
        constexpr int I_IN = (DMODEL / 64) * (NIN / 32), I_O = (1024 / 64) * (1024 / 32), I_PW = (512 / 64) * (512 / 32);
        for (int it = gw; it < I_IN + I_O + I_PW; it += NGW) {
            int r = it;
            if (r < I_IN) { const int nblk = NIN / 32, kb = r / nblk, nb = r % nblk; p0_transpose_item(w_in, DMODEL, NIN, WinT, 64 * kb, 32 * nb, win_dst_row(32 * nb), scr, lane); continue; } r -= I_IN;
            if (r < I_O) { const int nblk = 1024 / 32, kb = r / nblk, nb = r % nblk; p0_transpose_item(w_out, 1024, 1024, WoT, 64 * kb, 32 * nb, 32 * nb, scr, lane); continue; } r -= I_O;
            { const int nblk = 512 / 32, kb = r / nblk, nb = r % nblk; p0_transpose_item(pw_w, 512, 512, PwT, 64 * kb, 32 * nb, 32 * nb, scr, lane); }
        }
        for (int i = bx * 512 + tid; i < M; i += G * 512) rowss[i] = 0.f;
        f32x4 gv[4];
#pragma unroll
        for (int j = 0; j < 4; ++j) gv[j] = *((const f32x4*)pre_g + lane + 64 * j);
        for (int m0 = gw; m0 < M; m0 += 4 * NGW) {
            f32x4 v[4][4]; float ss[4];
#pragma unroll
            for (int k = 0; k < 4; ++k) { const int m = m0 + k * NGW; const f32x4* xr = (const f32x4*)(x + (size_t)(m < M ? m : m0) * DMODEL) + lane;
#pragma unroll
                for (int j = 0; j < 4; ++j) v[k][j] = __builtin_nontemporal_load(xr + 64 * j); }
#pragma unroll
            for (int k = 0; k < 4; ++k) { ss[k] = 0.f;
#pragma unroll
                for (int j = 0; j < 4; ++j) ss[k] += (v[k][j].x * v[k][j].x + v[k][j].y * v[k][j].y) + (v[k][j].z * v[k][j].z + v[k][j].w * v[k][j].w); }
#pragma unroll
            for (int o = 1; o < 64; o <<= 1) {
#pragma unroll
                for (int k = 0; k < 4; ++k) ss[k] += __shfl_xor(ss[k], o); }
#pragma unroll
            for (int k = 0; k < 4; ++k) { const int m = m0 + k * NGW; if (m < M) { const float rstd = 1.f / sqrtf(ss[k] * (1.f / DMODEL) + 1e-6f);
                v2u* o8 = (v2u*)(XN + (size_t)m * DMODEL) + lane;
#pragma unroll
                for (int j = 0; j < 4; ++j) { const f32x4 y = v[k][j] * rstd * gv[j]; v2u o; o.x = pk2(y.x, y.y); o.y = pk2(y.z, y.w); o8[64 * j] = o; } } }
        }
    }
    xcd_barrier(bar);

    {
        PHASE_PTRS();
        pg8::Gemm g{XN, WinT, M, NIN, DMODEL}; pg8::StaticOrder S; S.init(M, NIN, G, bx);
        pg8::EpiIn E{HG, CGB, QB_, KB, VB, DGB, (unsigned*)(ws + WS_BAR) + NMAX_WORD};
        pg8::gemm_phase<pg8::EpiIn, pg8::StaticOrder, PG8_ALIGN, PG8_SP2>(L, g, S, E, wave);
    }
    xcd_barrier(bar);

    {
        PHASE_PTRS(); FRESH_TID();
        unsigned* ctlw = (unsigned*)(ws + WS_BAR);
        int Wt[8];
#pragma unroll
        for (int i = 0; i < 8; ++i) { const float qm = __uint_as_float(__hip_atomic_load(ctlw + NMAX_WORD + i, RLX_AGENT)), km = __uint_as_float(__hip_atomic_load(ctlw + NMAX_WORD + 8 + i, RLX_AGENT));
            const float Sb = 2.02f * sqrtf(qm * km);
            const float w = (2.f * Sb + 42.f) / (64.f * pg8::alibi_sl(i >> 1)); Wt[i] = w < 64.f ? (int)w + 1 : 64; }
        const unsigned qslot = LDSCTL_OFF + 64;
        float sbmax = 0.f;
#pragma unroll
        for (int i = 0; i < 8; ++i) { const float qm = __uint_as_float(__hip_atomic_load(ctlw + NMAX_WORD + i, RLX_AGENT)), km = __uint_as_float(__hip_atomic_load(ctlw + NMAX_WORD + 8 + i, RLX_AGENT)); sbmax = fmaxf(sbmax, 2.02f * sqrtf(qm * km)); }
        if (sbmax <= 60.f) {
            int u = vcu;
            while (u < 1024) {
                int qb, b, h, c;
                if (u < 512) { qb = 15 - (u >> 5); const int r = u & 31; b = r >> 2; h = 2 + ((r >> 1) & 1); c = r & 1; }
                else { const int v = (u - 512) & 255; h = (u < 768) ? 1 : 0; qb = 15 - (v >> 4); const int r = v & 15; b = r >> 1; c = r & 1; }
                const int hc = 2 * h + c; int W = Wt[0];
#pragma unroll
                for (int i = 1; i < 8; ++i) W = (hc == i) ? Wt[i] : W;
                int T0 = 4 * qb - W; T0 = T0 > 0 ? (T0 & ~1) : 0;
                attn_body::attn_unit2(b, qb, (const attn_body::bf16*)(QB_ + h * 128 + c * 64), (const attn_body::bf16*)(KB + h * 128 + c * 64), (const attn_body::bf16*)(VB + h * 128),
                                      (attn_body::bf16*)(OB + h * 256 + c * 128), pg8::alibi_sl(h), pg8::alibi_c32(h), (char*)lds, wave, T0, ctlw + QCTR_WORD, qslot);
                u = G + (int)__builtin_amdgcn_readfirstlane(*(volatile LAS unsigned*)(L + qslot));
            }
            { const int ucur_ = u - 1024; PHASE_PTRS(); FRESH_TID();
              conv_phase_dyn(L, ucur_, (unsigned*)(ws + WS_BAR) + QCTR_WORD, G - 1024, M / 32, HG, dw_w, dw_b, cln_g, cln_b, UB, tid, lane, wave); }
        } else {
        conv_phase(L, vcu, G, M / 32, HG, dw_w, dw_b, cln_g, cln_b, UB, tid, lane, wave);
        int u = vcu;
        while (u < 2048) {
            const int qb = 15 - (u >> 7), r = u & 127, b = r >> 4, h = (r >> 2) & 3, c = (r >> 1) & 1, vh = r & 1;
            const int hc = 2 * h + c; int W = Wt[0];
#pragma unroll
            for (int i = 1; i < 8; ++i) W = (hc == i) ? Wt[i] : W;
            int T0 = 4 * qb - W; T0 = T0 > 0 ? (T0 & ~1) : 0;
            attn_body::attn_unit<8>(b, qb, (const attn_body::bf16*)(QB_ + h * 128 + c * 64), (const attn_body::bf16*)(KB + h * 128 + c * 64), (const attn_body::bf16*)(VB + h * 128 + vh * 64),
                                    (attn_body::bf16*)(OB + h * 256 + c * 128 + vh * 64), pg8::alibi_sl(h), pg8::alibi_c32(h), (char*)lds, wave, T0, ctlw + QCTR_WORD, qslot);
            u = G + (int)__builtin_amdgcn_readfirstlane(*(volatile LAS unsigned*)(L + qslot));
        }
        }
    }
    xcd_barrier(bar);

    {
        PHASE_PTRS();
        {
            pg8::Gemm g{UB, PwT, M, 512, 512}; pg8::StaticOrder S; S.init(M, 512, G, bx);
            pg8::EpiPw E{CGB, pw_b, YB};
            pg8::gemm_phase<pg8::EpiPw, pg8::StaticOrder, PG8_ALIGN, PG8_SP2>(L, g, S, E, wave);
        }
        FRESH_TID();
        const float lam = expf(wave_sum(lq1[lane] * lk1[lane])) - expf(wave_sum(lq2[lane] * lk2[lane])) + 0.2f;
        const int h = lane >> 4, ec = (lane & 15) * 8;
        float gs[8];
#pragma unroll
        for (int j = 0; j < 8; ++j) gs[j] = sub_g[ec + j] * 0.8f;
        for (int m0 = gw; m0 < M; m0 += 4 * NGW) {
            v4u a[4], bq[4], gt[4];
#pragma unroll
            for (int k = 0; k < 4; ++k) { const int mm = m0 + k * NGW; const size_t m = (size_t)(mm < M ? mm : m0);
                a[k] = *(const v4u*)(OB + m * 1024 + h * 256 + ec); bq[k] = *(const v4u*)(OB + m * 1024 + h * 256 + 128 + ec); gt[k] = *(const v4u*)(DGB + m * 512 + h * 128 + ec); }
#pragma unroll
            for (int k = 0; k < 4; ++k) { const int mm = m0 + k * NGW; if (mm >= M) continue;
                const unsigned aw[4] = {a[k].x, a[k].y, a[k].z, a[k].w}, bw[4] = {bq[k].x, bq[k].y, bq[k].z, bq[k].w}, gw4[4] = {gt[k].x, gt[k].y, gt[k].z, gt[k].w};
                float o[8]; float ss = 0.f;
#pragma unroll
                for (int j = 0; j < 4; ++j) { o[2 * j] = pg8::bf_lo(aw[j]) - lam * pg8::bf_lo(bw[j]); o[2 * j + 1] = pg8::bf_hi(aw[j]) - lam * pg8::bf_hi(bw[j]); ss += o[2 * j] * o[2 * j] + o[2 * j + 1] * o[2 * j + 1]; }
                ss += __shfl_xor(ss, 1); ss += __shfl_xor(ss, 2); ss += __shfl_xor(ss, 4); ss += __shfl_xor(ss, 8);
                const float rstd = 1.f / sqrtf(ss * (1.f / 128.f) + 1e-6f);
                unsigned wv[4];
#pragma unroll
                for (int j = 0; j < 4; ++j) wv[j] = pk2(o[2 * j] * rstd * gs[2 * j] * pg8::bf_lo(gw4[j]), o[2 * j + 1] * rstd * gs[2 * j + 1] * pg8::bf_hi(gw4[j]));
                v4u w; w.x = wv[0]; w.y = wv[1]; w.z = wv[2]; w.w = wv[3];
                *(v4u*)(YB + (size_t)mm * 1024 + 512 + h * 128 + ec) = w; }
        }
    }
    xcd_barrier(bar);

    {
        PHASE_PTRS();
        pg8::Gemm g{YB, WoT, M, 1024, 1024}; pg8::StaticOrder S; S.init(M, 1024, G, bx);
        pg8::EpiOut E{Y2, rowss};
        pg8::gemm_phase<pg8::EpiOut, pg8::StaticOrder, PG8_ALIGN, PG8_SP2>(L, g, S, E, wave);
    }
    xcd_barrier(bar);

    {
        PHASE_PTRS(); FRESH_TID();
        f32x4 gv[4];
#pragma unroll
        for (int j = 0; j < 4; ++j) gv[j] = *((const f32x4*)post_g + lane + 64 * j);
        for (int m0 = gw; m0 < M; m0 += 4 * NGW) {
            f32x4 xv[4][4]; v2u yv[4][4]; float rs[4];
#pragma unroll
            for (int k = 0; k < 4; ++k) { const int mm = m0 + k * NGW; const size_t m = (size_t)(mm < M ? mm : m0); rs[k] = rowss[m];
                const f32x4* xr = (const f32x4*)(x + m * DMODEL) + lane; const v2u* yr = (const v2u*)(Y2 + m * 1024) + lane;
#pragma unroll
                for (int j = 0; j < 4; ++j) { xv[k][j] = __builtin_nontemporal_load(xr + 64 * j); yv[k][j] = yr[64 * j]; } }
#pragma unroll
            for (int k = 0; k < 4; ++k) { const int mm = m0 + k * NGW; if (mm >= M) continue;
                const float rstd = 1.f / sqrtf(rs[k] * (1.f / 1024.f) + 1e-6f); f32x4* orow = (f32x4*)(out + (size_t)mm * DMODEL) + lane;
#pragma unroll
                for (int j = 0; j < 4; ++j) { f32x4 o;
                    o.x = xv[k][j].x + pg8::bf_lo(yv[k][j].x) * rstd * gv[j].x; o.y = xv[k][j].y + pg8::bf_hi(yv[k][j].x) * rstd * gv[j].y; o.z = xv[k][j].z + pg8::bf_lo(yv[k][j].y) * rstd * gv[j].z; o.w = xv[k][j].w + pg8::bf_hi(yv[k][j].y) * rstd * gv[j].w;
                    __builtin_nontemporal_store(o, orow + 64 * j); } }
        }
    }
}

extern "C" void kernel_launch(void* const* d_in, const int* in_sizes, int n_in, void* d_out, int out_size, void* d_ws, size_t ws_size, hipStream_t stream) {
    static int grid = 0;
    if (grid == 0) {
        if (n_in != 16 || out_size != M * DMODEL || ws_size < WS_END) { fprintf(stderr, "kernel_launch: unexpected problem shape (n_in %d, out %d, ws %zu)\n", n_in, out_size, ws_size); grid = -1; return; }
        int dev = 0, cus = 0, per_cu = 0;
        hipGetDevice(&dev); hipDeviceGetAttribute(&cus, hipDeviceAttributeMultiprocessorCount, dev);
        hipFuncSetAttribute((const void*)fwd_megakernel, hipFuncAttributeMaxDynamicSharedMemorySize, LDS_BYTES);
        hipOccupancyMaxActiveBlocksPerMultiprocessor(&per_cu, (const void*)fwd_megakernel, NWAVES * 64, LDS_BYTES);
        if (per_cu < 1) { fprintf(stderr, "kernel_launch: occupancy query reports %d blocks per CU\n", per_cu); per_cu = 1; }
        (void)hipGetLastError();
        grid = cus;
    }
    if (grid < 0) return;
    (void)hipMemsetAsync((char*)d_ws + WS_BAR, 0, WS_BAR_BYTES, stream);
    Args a{};
    for (int i = 0; i < 16; ++i) a.in[i] = (const float*)d_in[i];
    a.out = (float*)d_out; a.ws = (unsigned char*)d_ws;
    void* kargs[] = {&a};
    hipError_t e = hipLaunchCooperativeKernel((const void*)fwd_megakernel, dim3(grid), dim3(NWAVES * 64), kargs, LDS_BYTES, stream);
    if (e != hipSuccess) fprintf(stderr, "cooperative launch failed: %s (grid %d)\n", hipGetErrorString(e), grid);
}
```

```cpp
#include <hip/hip_runtime.h>
#include <hip/hip_cooperative_groups.h>
#include <cstdio>
#include <cstdint>
namespace cg = cooperative_groups;
__device__ __forceinline__ int lane_id_asm() { int l; asm volatile("v_mbcnt_lo_u32_b32 %0, -1, 0\n\tv_mbcnt_hi_u32_b32 %0, -1, %0" : "=v"(l)); return l; }
namespace pg8 {
#define PG8_LAS __attribute__((address_space(3)))
typedef unsigned short bf16_t;
typedef short bf16x8 __attribute__((ext_vector_type(8)));
typedef float f32x4 __attribute__((ext_vector_type(4)));
typedef unsigned u32x4 __attribute__((ext_vector_type(4)));
constexpr int BM = 256, BK = 64, HALF = 128, HTB = HALF * BK * 2  , STAGE_BYTES = 8 * HTB, NXCD = 8, WGM = 8;

__host__ __device__ __forceinline__ int lds_byte(int r, int c) { const int st = (r >> 4) * 2 + (c >> 5), rr = r & 15, cc = c & 31, ob = rr * 64 + cc * 2; return st * 1024 + (ob ^ (((ob >> 9) & 1) << 5)); }
__host__ __device__ __forceinline__ void stage_rc(int b, int& R, int& C) { const int st = b / 1024, sb = b % 1024, swz = sb ^ (((sb >> 9) & 1) << 5); R = (st >> 1) * 16 + swz / 64; C = (st & 1) * 32 + (swz % 64) / 2; }
__host__ __device__ __forceinline__ int perm32(int rho) { const int n = rho >> 4, i = rho & 15; return 8 * (i >> 2) + 4 * n + (i & 3); }

struct Unit { int pm, pn; };
struct Gemm { const bf16_t* A; const bf16_t* Bt; int M, N, K; };

struct StaticOrder {
    int nM, nN, nwg, G, c;
    __host__ __device__ void init(int M, int N, int G_, int c_) { nM = M / BM; nN = N / BM; nwg = nM * nN; G = G_; c = c_; }
    __host__ __device__ bool next(int i, Unit& u) const {
        const long L = (long)i * G + c; if (L >= nwg) return false;
        int wgid = (int)L; { const int q = nwg / NXCD, r = nwg % NXCD, xcd = wgid % NXCD, off = wgid / NXCD; wgid = (xcd < r ? xcd * (q + 1) : r * (q + 1) + (xcd - r) * q) + off; }
        const int nig = WGM * nN, gid = wgid / nig, fm = gid * WGM, gsz = (nM - fm) < WGM ? (nM - fm) : WGM;
        u.pm = fm + ((wgid % nig) % gsz); u.pn = (wgid % nig) / gsz; return true;
    }
    __device__ __forceinline__ void a_ready(const Unit&) const {}
    __device__ __forceinline__ void done(const Unit&) const {}
};

__device__ __forceinline__ unsigned cvt_pk_bf16(float lo, float hi) { unsigned r; asm volatile("v_cvt_pk_bf16_f32 %0, %1, %2" : "=v"(r) : "v"(lo), "v"(hi)); return r; }

typedef float f32x2 __attribute__((ext_vector_type(2)));
__host__ __device__ __forceinline__ float alibi_c32(int h) { return h == 0 ? 2980.9579870417283f : h == 1 ? 7.38905609893065f : h == 2 ? 1.6487212707001282f : 1.1331484530668263f; }
__host__ __device__ __forceinline__ float alibi_sl(int h) { return h == 0 ? 0.36067376022224085f : h == 1 ? 0.09016844005556021f : h == 2 ? 0.022542110013890053f : 0.005635527503472513f; }
__device__ __forceinline__ float sigmoid_f(float v) { return __builtin_amdgcn_rcpf(1.0f + __builtin_amdgcn_exp2f(-1.4426950408889634f * v)); }
__device__ __forceinline__ float silu_f(float v) { return v * sigmoid_f(v); }
__device__ __forceinline__ float bf_lo(unsigned w) { return __uint_as_float(w << 16); }
__device__ __forceinline__ float bf_hi(unsigned w) { return __uint_as_float(w & 0xffff0000u); }
__device__ __forceinline__ u32x4 pack8(const f32x4 v0, const f32x4 v1) { u32x4 w; w.x = cvt_pk_bf16(v0[0], v0[1]); w.y = cvt_pk_bf16(v0[2], v0[3]); w.z = cvt_pk_bf16(v1[0], v1[1]); w.w = cvt_pk_bf16(v1[2], v1[3]); return w; }

struct EpiIn {
    static constexpr bool PERM = true, AFTER_DRAIN = false;
    bf16_t *Hg, *CG, *Q, *K, *V, *DG; unsigned* nmax;
    __device__ __forceinline__ void operator()(const f32x4 (&acc)[2][2][4][2], const Unit& u, int wr, int wc, int fr, int fq) const {
        const int row0 = u.pm * BM + wr * 64 + fr; const int pn = u.pn;
        if (pn < 4) {
            const int col = 128 * pn + wc * 32 + 8 * fq;
#pragma unroll
            for (int ai = 0; ai < 2; ++ai)
#pragma unroll
                for (int m = 0; m < 4; ++m) {
                    f32x4 h0, h1;
#pragma unroll
                    for (int j = 0; j < 4; ++j) { h0[j] = acc[ai][0][m][0][j] * sigmoid_f(acc[ai][1][m][0][j]); h1[j] = acc[ai][0][m][1][j] * sigmoid_f(acc[ai][1][m][1][j]); }
                    *(u32x4*)(Hg + (size_t)(row0 + ai * HALF + m * 16) * 512 + col) = pack8(h0, h1);
                }
        } else {
            const int role = (pn - 4) >> 1, colt = 256 * ((pn - 4) & 1) + wc * 32 + 8 * fq;
            bf16_t* base = role == 0 ? CG : role == 1 ? Q : role == 2 ? K : role == 3 ? V : DG;
            float mx[2] = {0.f, 0.f};
#pragma unroll
            for (int ai = 0; ai < 2; ++ai)
#pragma unroll
                for (int m = 0; m < 4; ++m)
#pragma unroll
                    for (int bj = 0; bj < 2; ++bj) {
                        f32x4 v0 = acc[ai][bj][m][0], v1 = acc[ai][bj][m][1];
                        if (role == 0 || role == 4) {
#pragma unroll
                            for (int j = 0; j < 4; ++j) { v0[j] = silu_f(v0[j]); v1[j] = silu_f(v1[j]); }
                        } else if (role == 1) { v0 = v0 * 0.18033688011112042f; v1 = v1 * 0.18033688011112042f; }
                        else if (role == 3) {
                            if (m >= 2) {
                                const int h = 2 * ((pn - 4) & 1) + bj;
                                const float c = alibi_c32(h);
                                v0 = v0 * c; v1 = v1 * c;
                            }
                        }
                        *(u32x4*)(base + (size_t)(row0 + ai * HALF + m * 16) * 512 + colt + bj * HALF) = pack8(v0, v1);
                        if (role == 1 || role == 2) { float ss = (v0[0] * v0[0] + v0[1] * v0[1]) + (v0[2] * v0[2] + v0[3] * v0[3]) + (v1[0] * v1[0] + v1[1] * v1[1]) + (v1[2] * v1[2] + v1[3] * v1[3]);
                            ss += __shfl_xor(ss, 16); ss += __shfl_xor(ss, 32); mx[bj] = fmaxf(mx[bj], ss); }
                    }
            if (role == 1 || role == 2) {
#pragma unroll
                for (int bj = 0; bj < 2; ++bj) { float v = mx[bj]; v = fmaxf(v, __shfl_xor(v, 1)); v = fmaxf(v, __shfl_xor(v, 2)); v = fmaxf(v, __shfl_xor(v, 4)); v = fmaxf(v, __shfl_xor(v, 8));
                    if (fr == 0 && fq == 0) atomicMax(nmax + (role - 1) * 8 + 4 * ((pn - 4) & 1) + 2 * bj + (wc >> 1), __float_as_uint(v)); }
            }
        }
    }
};
struct EpiPw {
    static constexpr bool PERM = true, AFTER_DRAIN = false;
    const bf16_t* CG; const float* bias; bf16_t* Y;
    __device__ __forceinline__ void operator()(const f32x4 (&acc)[2][2][4][2], const Unit& u, int wr, int wc, int fr, int fq) const {
        const int row0 = u.pm * BM + wr * 64 + fr; const int col0 = u.pn * BM + wc * 32 + 8 * fq;
        f32x4 bv[2][2];
#pragma unroll
        for (int bj = 0; bj < 2; ++bj)
#pragma unroll
            for (int n = 0; n < 2; ++n) bv[bj][n] = *(const f32x4*)(bias + col0 + bj * HALF + 4 * n);
#pragma unroll
        for (int ai = 0; ai < 2; ++ai)
#pragma unroll
            for (int m = 0; m < 4; ++m) { const size_t row = (size_t)(row0 + ai * HALF + m * 16);
#pragma unroll
                for (int bj = 0; bj < 2; ++bj) {
                    const u32x4 g = *(const u32x4*)(CG + row * 512 + col0 + bj * HALF);
                    f32x4 v0 = acc[ai][bj][m][0] + bv[bj][0], v1 = acc[ai][bj][m][1] + bv[bj][1];
                    v0[0] *= bf_lo(g.x); v0[1] *= bf_hi(g.x); v0[2] *= bf_lo(g.y); v0[3] *= bf_hi(g.y);
                    v1[0] *= bf_lo(g.z); v1[1] *= bf_hi(g.z); v1[2] *= bf_lo(g.w); v1[3] *= bf_hi(g.w);
                    *(u32x4*)(Y + row * 1024 + col0 + bj * HALF) = pack8(v0, v1);
                } }
    }
};
struct EpiOut {
    static constexpr bool PERM = true, AFTER_DRAIN = false;
    bf16_t* Y2; float* rowss;
    __device__ __forceinline__ void operator()(const f32x4 (&acc)[2][2][4][2], const Unit& u, int wr, int wc, int fr, int fq) const {
        const int row0 = u.pm * BM + wr * 64 + fr; const int col0 = u.pn * BM + wc * 32 + 8 * fq;
#pragma unroll
        for (int ai = 0; ai < 2; ++ai)
#pragma unroll
            for (int m = 0; m < 4; ++m) { const size_t row = (size_t)(row0 + ai * HALF + m * 16); float ss = 0.f;
#pragma unroll
                for (int bj = 0; bj < 2; ++bj) {
                    const f32x4 v0 = acc[ai][bj][m][0], v1 = acc[ai][bj][m][1];
                    ss += (v0[0] * v0[0] + v0[1] * v0[1]) + (v0[2] * v0[2] + v0[3] * v0[3]) + (v1[0] * v1[0] + v1[1] * v1[1]) + (v1[2] * v1[2] + v1[3] * v1[3]);
                    *(u32x4*)(Y2 + row * 1024 + col0 + bj * HALF) = pack8(v0, v1);
                }
                ss += __shfl_xor(ss, 16); ss += __shfl_xor(ss, 32);
                if (fq == 0) atomicAdd(rowss + row, ss);
            }
    }
};


template <class Epi, class Sched, bool ALIGN_EPI = false, bool SP2 = false>
__device__ __forceinline__ void gemm_phase(PG8_LAS unsigned char* lds, const Gemm g, const Sched& S, const Epi& E, int wid_in) {
    const int lane = lane_id_asm();
    int wid_o = wid_in; asm volatile("" : "+s"(wid_o)); const int wid = wid_o, tid = wid * 64 + lane, wr = wid >> 2, wc = wid & 3, fr = lane & 15, fq = lane >> 4;
    const int K = g.K, nt = K / BK;
    unsigned voffA[2], voffB[2];
#pragma unroll
    for (int i = 0; i < 2; ++i) { int R, C; stage_rc(tid * 16 + i * 8192, R, C); const int Rb = Epi::PERM ? ((R & ~31) + perm32(R & 31)) : R;
        voffA[i] = (unsigned)(R * K + C) * 2u; voffB[i] = (unsigned)(Rb * K + C) * 2u; }
    const size_t kstep = (size_t)(BK * 2);
    const size_t hstep = (size_t)HALF * K * 2;
    const size_t tstep = 2 * hstep;
    const unsigned ldsw = (unsigned)wid * 1024u;
    const int aoff = lds_byte(wr * 64 + fr, fq * 8), boff = lds_byte(wc * 32 + fr, fq * 8);
#define PG8_SA(b, h) (((b) * 2 + (h)) * HTB)
#define PG8_SB(b, h) ((4 + (b) * 2 + (h)) * HTB)
#define PG8_STAGE(bufoff, gbase, voff) do { _Pragma("unroll") for (int _i = 0; _i < 2; ++_i) \
        __builtin_amdgcn_global_load_lds((const unsigned*)((const char*)(gbase) + (voff)[_i]), (PG8_LAS unsigned*)(lds + (bufoff) + ldsw + _i * 8192), 16, 0, 0); } while (0)
#define PG8_LDA(dst, b, h) do { _Pragma("unroll") for (int m = 0; m < 4; ++m) _Pragma("unroll") for (int k = 0; k < 2; ++k) dst[m][k] = *(const PG8_LAS bf16x8*)(lds + PG8_SA(b, h) + aoff + m * 2048 + k * 1024); } while (0)
#define PG8_LDB(dst, b, h) do { _Pragma("unroll") for (int n = 0; n < 2; ++n) _Pragma("unroll") for (int k = 0; k < 2; ++k) dst[n][k] = *(const PG8_LAS bf16x8*)(lds + PG8_SB(b, h) + boff + n * 2048 + k * 1024); } while (0)
#define PG8_MMA(ai, bj, At, Bt) do { __builtin_amdgcn_s_setprio(1); _Pragma("unroll") for (int m = 0; m < 4; ++m) _Pragma("unroll") for (int n = 0; n < 2; ++n) _Pragma("unroll") for (int k = 0; k < 2; ++k) \
        acc[ai][bj][m][n] = __builtin_amdgcn_mfma_f32_16x16x32_bf16(Bt[n][k], At[m][k], acc[ai][bj][m][n], 0, 0, 0); __builtin_amdgcn_s_setprio(0); } while (0)
#define PG8_WAIT_V(n) asm volatile("s_waitcnt vmcnt(" #n ")" ::: "memory")
#define PG8_WAIT_L(n) asm volatile("s_waitcnt lgkmcnt(" #n ")" ::: "memory")
#define PG8_BAR __builtin_amdgcn_s_barrier()
#define PG8_SCHED __builtin_amdgcn_sched_barrier(0)
    Unit cur, nxt; int ui = 0;
    if (!S.next(0, cur)) return;
    f32x4 acc[2][2][4][2];
#pragma unroll
    for (int a = 0; a < 2; ++a)
#pragma unroll
        for (int b = 0; b < 2; ++b)
#pragma unroll
            for (int m = 0; m < 4; ++m)
#pragma unroll
                for (int n = 0; n < 2; ++n) acc[a][b][m][n] = (f32x4){0.f, 0.f, 0.f, 0.f};
    bf16x8 At[4][2], B0[2][2], B1[2][2];
    const char* cA = (const char*)g.A + (size_t)cur.pm * tstep; const char* cB = (const char*)g.Bt + (size_t)cur.pn * tstep;
    S.a_ready(cur);
    if constexpr (SP2) {
        PG8_STAGE(PG8_SB(0, 0), cB, voffB); PG8_STAGE(PG8_SB(0, 1), cB + hstep, voffB); PG8_STAGE(PG8_SA(0, 0), cA, voffA); PG8_STAGE(PG8_SA(0, 1), cA + hstep, voffA);
        if (wr == 1) PG8_BAR;
        PG8_WAIT_V(2); PG8_BAR;
        PG8_STAGE(PG8_SB(1, 0), cB + kstep, voffB); PG8_STAGE(PG8_SA(1, 0), cA + kstep, voffA); PG8_STAGE(PG8_SB(1, 1), cB + hstep + kstep, voffB);
        PG8_WAIT_V(6); PG8_BAR;
    } else {
        PG8_STAGE(PG8_SB(0, 0), cB, voffB); PG8_STAGE(PG8_SA(0, 0), cA, voffA); PG8_STAGE(PG8_SB(0, 1), cB + hstep, voffB); PG8_STAGE(PG8_SA(0, 1), cA + hstep, voffA);
        if (wr == 1) PG8_BAR;
        PG8_WAIT_V(4); PG8_BAR;
        PG8_STAGE(PG8_SB(1, 0), cB + kstep, voffB); PG8_STAGE(PG8_SA(1, 0), cA + kstep, voffA); PG8_STAGE(PG8_SB(1, 1), cB + hstep + kstep, voffB);
        PG8_WAIT_V(6); PG8_BAR;
    }
    for (;;) {
        const bool has_next = S.next(ui + 1, nxt);
        const char* nA = has_next ? (const char*)g.A + (size_t)nxt.pm * tstep : cA; const char* nB = has_next ? (const char*)g.Bt + (size_t)nxt.pn * tstep : cB;
        for (int t = 0; t < nt; t += 2) {
            const bool last = (t == nt - 2);
            const char* a1 = cA + (size_t)(t + 1) * kstep;
            const char* a2 = last ? nA : cA + (size_t)(t + 2) * kstep; const char* b2 = last ? nB : cB + (size_t)(t + 2) * kstep;
            const char* a3 = a2 + kstep; const char* b3 = b2 + kstep;
            if (last && has_next) S.a_ready(nxt);
            if constexpr (SP2) {
            PG8_LDB(B0, 0, 0); PG8_LDB(B1, 0, 1); PG8_SCHED; PG8_LDA(At, 0, 0); PG8_STAGE(PG8_SA(1, 1), a1 + hstep, voffA);
            PG8_WAIT_V(8); PG8_WAIT_L(0); PG8_BAR; PG8_MMA(0, 0, At, B0); PG8_MMA(0, 1, At, B1); PG8_BAR; PG8_SCHED;
            PG8_LDA(At, 0, 1); PG8_STAGE(PG8_SB(0, 0), b2, voffB); PG8_STAGE(PG8_SB(0, 1), b2 + hstep, voffB); PG8_STAGE(PG8_SA(0, 0), a2, voffA);
            PG8_WAIT_V(8); PG8_WAIT_L(0); PG8_BAR; PG8_MMA(1, 0, At, B0); PG8_MMA(1, 1, At, B1); PG8_BAR; PG8_SCHED;
            PG8_LDB(B0, 1, 0); PG8_LDB(B1, 1, 1); PG8_SCHED; PG8_LDA(At, 1, 0); PG8_STAGE(PG8_SA(0, 1), a2 + hstep, voffA);
            PG8_WAIT_V(8); PG8_WAIT_L(0); PG8_BAR; PG8_MMA(0, 0, At, B0); PG8_MMA(0, 1, At, B1); PG8_BAR; PG8_SCHED;
            PG8_LDA(At, 1, 1); PG8_STAGE(PG8_SB(1, 0), b3, voffB); PG8_STAGE(PG8_SB(1, 1), b3 + hstep, voffB); PG8_STAGE(PG8_SA(1, 0), a3, voffA);
            PG8_WAIT_V(8); PG8_WAIT_L(0); PG8_BAR; PG8_MMA(1, 0, At, B0); PG8_MMA(1, 1, At, B1); PG8_BAR; PG8_SCHED;
            } else {
            PG8_LDB(B0, 0, 0); PG8_SCHED; PG8_LDA(At, 0, 0); PG8_STAGE(PG8_SA(1, 1), a1 + hstep, voffA);
            PG8_WAIT_L(8); PG8_BAR; PG8_WAIT_L(0); PG8_MMA(0, 0, At, B0); PG8_BAR; PG8_SCHED;
            PG8_LDB(B1, 0, 1); PG8_STAGE(PG8_SB(0, 0), b2, voffB);
            PG8_BAR; PG8_WAIT_L(0); PG8_MMA(0, 1, At, B1); PG8_BAR;
            PG8_LDA(At, 0, 1); PG8_STAGE(PG8_SA(0, 0), a2, voffA);
            PG8_BAR; PG8_WAIT_L(0); PG8_MMA(1, 0, At, B0); PG8_BAR; PG8_SCHED;
            PG8_STAGE(PG8_SB(0, 1), b2 + hstep, voffB);
            PG8_WAIT_V(6); PG8_BAR; PG8_MMA(1, 1, At, B1); PG8_BAR;
            PG8_LDB(B0, 1, 0); PG8_SCHED; PG8_LDA(At, 1, 0); PG8_STAGE(PG8_SA(0, 1), a2 + hstep, voffA);
            PG8_WAIT_L(8); PG8_BAR; PG8_WAIT_L(0); PG8_MMA(0, 0, At, B0); PG8_BAR; PG8_SCHED;
            PG8_LDB(B1, 1, 1); PG8_STAGE(PG8_SB(1, 0), b3, voffB);
            PG8_BAR; PG8_WAIT_L(0); PG8_MMA(0, 1, At, B1); PG8_BAR;
            PG8_LDA(At, 1, 1); PG8_STAGE(PG8_SA(1, 0), a3, voffA);
            PG8_BAR; PG8_WAIT_L(0); PG8_MMA(1, 0, At, B0); PG8_BAR; PG8_SCHED;
            PG8_STAGE(PG8_SB(1, 1), b3 + hstep, voffB);
            PG8_WAIT_V(6); PG8_BAR; PG8_MMA(1, 1, At, B1); PG8_BAR;
            }
        }
        if constexpr (ALIGN_EPI) { if (wr == 0) PG8_BAR; }
        if constexpr (!Epi::AFTER_DRAIN) { E(acc, cur, wr, wc, fr, fq); S.done(cur); }
        if (!has_next) break;
#pragma unroll
        for (int a = 0; a < 2; ++a)
#pragma unroll
            for (int b = 0; b < 2; ++b)
#pragma unroll
                for (int m = 0; m < 4; ++m)
#pragma unroll
                    for (int n = 0; n < 2; ++n) acc[a][b][m][n] = (f32x4){0.f, 0.f, 0.f, 0.f};
        cur = nxt; cA = nA; cB = nB; ++ui;
        if constexpr (ALIGN_EPI) { if (wr == 1) PG8_BAR; }
    }
    PG8_WAIT_V(0);
    if constexpr (!ALIGN_EPI) { if (wr == 0) PG8_BAR; }
    PG8_BAR;
    if constexpr (Epi::AFTER_DRAIN) { E.fused(acc, cur, wr, wc, fr, fq, lds, wid, lane); S.done(cur); }
#undef PG8_SA
#undef PG8_SB
#undef PG8_STAGE
#undef PG8_LDA
#undef PG8_LDB
#undef PG8_MMA
#undef PG8_WAIT_V
#undef PG8_WAIT_L
#undef PG8_BAR
#undef PG8_SCHED
}
}

#ifndef PG8_SP2
#define PG8_SP2 true
#endif
#ifndef PG8_ALIGN
#define PG8_ALIGN true
#endif
#include <hip/hip_bf16.h>
#include <cmath>
namespace attn_body {
using bf16=__hip_bfloat16;
using bf16x8=__attribute__((ext_vector_type(8)))short;
using s16x4=__attribute__((ext_vector_type(4)))short;
using f32x16=__attribute__((ext_vector_type(16)))float;
using u32x4=__attribute__((ext_vector_type(4)))unsigned;
constexpr int BATCH=8,SEQ=4096,D=64;
constexpr int QP=512,KP=512,VP=512,OP=1024;
constexpr int NW=8,QBLK=32,QB=QBLK*NW,KVBLK=64,NQB=SEQ/QB;
constexpr int ATTN_UNIT_ROWS=QB;
__device__ __forceinline__ int crow(int r,int hi){return (r&3)+8*(r>>2)+4*hi;}
#define SBAR() __builtin_amdgcn_sched_barrier(0)
__device__ __forceinline__ void cmask(f32x16&p0,f32x16&p1,int jb,int qrel,int hi){
  const float NEG=-INFINITY; int kb=64*jb+4*hi;
  #pragma unroll
  for(int r=0;r<16;++r){int kv=kb+(r&3)+8*(r>>2); if(kv>qrel)p0[r]=NEG; if(kv+32>qrel)p1[r]=NEG;}
}

constexpr int NSLOT=3, SLOTB=8192;
constexpr int LDS_K=0, LDS_V=NSLOT*SLOTB, LDS_WS=2*NSLOT*SLOTB, LDS_OST=LDS_WS+NW*64*4, LDS_BYTES=LDS_OST+NW*4096;
constexpr float C2=0.125f*1.4426950408889634f;
__device__ __forceinline__ void glds16(const void*sbase,unsigned voff,unsigned lds_dst){unsigned keep;
  asm volatile("s_mov_b32 %0, m0\n\ts_mov_b32 m0, %2\n\ts_nop 0\n\tglobal_load_lds_dwordx4 %1, %3\n\ts_mov_b32 m0, %0":"=&s"(keep):"v"(voff),"s"(lds_dst),"s"(sbase):"memory");}
__device__ __forceinline__ float max3f(float a,float b,float c){float r;asm("v_max3_f32 %0, %1, %2, %3":"=v"(r):"v"(a),"v"(b),"v"(c));return r;}
__device__ __forceinline__ float max2f(float a,float b){float r;asm("v_max_f32_e32 %0, %1, %2":"=v"(r):"v"(a),"v"(b));return r;}
__device__ __forceinline__ float fadd_s(float a,float b){float r;asm("v_add_f32_e32 %0, %1, %2":"=v"(r):"v"(a),"v"(b));return r;}
__device__ __forceinline__ float fsub_s(float a,float b){float r;asm("v_sub_f32_e32 %0, %1, %2":"=v"(r):"v"(a),"v"(b));return r;}
typedef float f32x2_t __attribute__((ext_vector_type(2))); typedef __bf16 bf16x2_t __attribute__((ext_vector_type(2)));
__device__ __forceinline__ unsigned cvtpk_s(float lo,float hi){f32x2_t v={lo,hi};bf16x2_t b=__builtin_convertvector(v,bf16x2_t);return __builtin_bit_cast(unsigned,b);}
#define WAIT_BAR(N) asm volatile("s_waitcnt vmcnt(" #N ") lgkmcnt(0)\n\ts_barrier":::"memory")

__device__ __forceinline__ void qkt(f32x16&p0,f32x16&p1,const char*Kslot,const bf16x8*qr,const f32x16&negm,int r32,int hi){
  const char*kb=Kslot+hi*1024+r32*16;
  #pragma unroll
  for(int d0=0;d0<4;++d0){
    const bf16x8 b0=*reinterpret_cast<const bf16x8*>(kb+d0*2048);
    const bf16x8 b1=*reinterpret_cast<const bf16x8*>(kb+d0*2048+512);
    if(d0==0){p0=__builtin_amdgcn_mfma_f32_32x32x16_bf16(b0,qr[0],negm,0,0,0);p1=__builtin_amdgcn_mfma_f32_32x32x16_bf16(b1,qr[0],negm,0,0,0);}
    else{p0=__builtin_amdgcn_mfma_f32_32x32x16_bf16(b0,qr[d0],p0,0,0,0);p1=__builtin_amdgcn_mfma_f32_32x32x16_bf16(b1,qr[d0],p1,0,0,0);}}
}
typedef __attribute__((address_space(3))) const char* lds_cptr;
typedef short v4i16_t __attribute__((ext_vector_type(4)));
__device__ __forceinline__ void kload8(bf16x8*kf,lds_cptr kp){
  kf[0]=*(const __attribute__((address_space(3))) bf16x8*)(kp);      kf[1]=*(const __attribute__((address_space(3))) bf16x8*)(kp+512);
  kf[2]=*(const __attribute__((address_space(3))) bf16x8*)(kp+2048); kf[3]=*(const __attribute__((address_space(3))) bf16x8*)(kp+2560);
  kf[4]=*(const __attribute__((address_space(3))) bf16x8*)(kp+4096); kf[5]=*(const __attribute__((address_space(3))) bf16x8*)(kp+4608);
  kf[6]=*(const __attribute__((address_space(3))) bf16x8*)(kp+6144); kf[7]=*(const __attribute__((address_space(3))) bf16x8*)(kp+6656);
}
__device__ __forceinline__ void kload2(bf16x8*kf,lds_cptr kp,int j){ kf[2*j]=*(const __attribute__((address_space(3))) bf16x8*)(kp+j*2048); kf[2*j+1]=*(const __attribute__((address_space(3))) bf16x8*)(kp+j*2048+512); }
__device__ __forceinline__ s16x4 vtr(lds_cptr p){ return __builtin_bit_cast(s16x4,__builtin_amdgcn_ds_read_tr16_b64_v4i16((__attribute__((address_space(3))) v4i16_t*)p)); }
__device__ __forceinline__ float rowmax(const f32x16&p0,const f32x16&p1){
  float a=max3f(p0[0],p0[1],p1[0]),b=max3f(p0[2],p0[3],p1[1]);a=max3f(a,p1[2],p1[3]);
  #pragma unroll
  for(int r=4;r<16;r+=4){a=max3f(a,p0[r],p0[r+1]);b=max3f(b,p0[r+2],p0[r+3]);a=max3f(a,p1[r],p1[r+1]);b=max3f(b,p1[r+2],p1[r+3]);}
  const float m=max2f(a,b);
  auto rr=__builtin_amdgcn_permlane32_swap(__float_as_uint(m),__float_as_uint(m),false,false);
  return max2f(__uint_as_float(rr[0]),__uint_as_float(rr[1]));
}
__device__ __forceinline__ void pv(f32x16*o,int vb,bf16x8 pa0,bf16x8 pa1,bf16x8 pa2,bf16x8 pa3){
  #pragma unroll
  for(int d0=0;d0<2;++d0){s16x4 lo[4],hi[4];
    #pragma unroll
    for(int ks=0;ks<4;++ks){
      asm volatile("ds_read_b64_tr_b16 %0,%1 offset:%c2":"=&v"(lo[ks]):"v"(vb),"i"(d0*4096+ks*1024):"memory");
      asm volatile("ds_read_b64_tr_b16 %0,%1 offset:%c2":"=&v"(hi[ks]):"v"(vb),"i"(d0*4096+ks*1024+512):"memory");}
    asm volatile("s_waitcnt lgkmcnt(0)":::"memory");SBAR();
    #define PK(k) (bf16x8){lo[k][0],lo[k][1],lo[k][2],lo[k][3],hi[k][0],hi[k][1],hi[k][2],hi[k][3]}
    o[d0]=__builtin_amdgcn_mfma_f32_32x32x16_bf16(pa0,PK(0),o[d0],0,0,0);
    o[d0]=__builtin_amdgcn_mfma_f32_32x32x16_bf16(pa1,PK(1),o[d0],0,0,0);
    o[d0]=__builtin_amdgcn_mfma_f32_32x32x16_bf16(pa2,PK(2),o[d0],0,0,0);
    o[d0]=__builtin_amdgcn_mfma_f32_32x32x16_bf16(pa3,PK(3),o[d0],0,0,0);
    #undef PK
  }
}

#ifndef ATTN_STORE16
#define ATTN_STORE16(p,v) (*(u32x4*)(p)=(v))
#endif
template<int THRL> __device__ __forceinline__ void attn_unit(int b,int qb,const bf16*Qh,const bf16*__restrict__ Kh0,const bf16*__restrict__ Vh0,bf16*Oh,float sl,float c32,char*shm,int wid_in,int T0,unsigned*qctr,unsigned qslot){
  const int lane=lane_id_asm(),r32=lane&31,hi=lane>>5; int wid=wid_in; asm volatile("":"+s"(wid));
  const long rowbase=(long)b*SEQ; const int q0=qb*QB;
  const bf16*Qw=Qh+(rowbase+q0+wid*QBLK)*QP;
  const bf16*Kh=Kh0+(rowbase+(long)T0*KVBLK)*KP,*Vh=Vh0+(rowbase+(long)T0*KVBLK)*VP;
  const unsigned lds0=(unsigned)(uintptr_t)shm;
  float*wsf=(float*)(shm+LDS_WS)+wid*64;
  const unsigned koff=(unsigned)(lane*KP+wid*8)*2u;
  const unsigned voff=(unsigned)((16*(wid&3)+(lane>>2))*VP+(wid>>2)*32+(lane&3)*8)*2u;
  const unsigned kdst=lds0+LDS_K+wid*1024, vdst=lds0+LDS_V+wid*1024;
  #define DMA_K(t,slot) glds16(Kh+(long)(t)*KVBLK*KP,koff,(unsigned)__builtin_amdgcn_readfirstlane(kdst+(slot)))
  #define DMA_V(t,slot) glds16(Vh+(long)(t)*KVBLK*VP,voff,(unsigned)__builtin_amdgcn_readfirstlane(vdst+(slot)))
  const char*Kbase=shm+LDS_K; bf16x8 kf[8];
  const lds_cptr shm3=(lds_cptr)shm; const lds_cptr kp0=shm3+LDS_K+hi*1024+r32*16; const lds_cptr vp0=shm3+LDS_V+((lane>>4)&1)*32+(lane&3)*8+(4*hi+((lane&15)>>2))*64;
  const int NT=(q0+QB)/KVBLK-T0;
  DMA_K(0,0);DMA_V(0,0);DMA_K(1,SLOTB);
  bf16x8 qr[4];
  #pragma unroll
  for(int d0=0;d0<4;++d0)qr[d0]=*reinterpret_cast<const bf16x8*>(&Qw[(long)r32*QP+d0*16+hi*8]);
  float l_reg=0.f;f32x16 o[2];o[0]=f32x16{};o[1]=f32x16{};f32x16 negm;
  { float hb_=sl*(float)(4*hi); asm volatile("":"+v"(hb_));
    _Pragma("unroll") for(int r=0;r<16;++r)negm[r]=hb_+sl*(float)((r&3)+8*(r>>2)); }
  asm volatile("":"+v"(negm)); const float sl64=64.f*sl;
  const int qrel=wid*QBLK+r32;
  #define CMASK(P0,P1,t) do{int jb_=(t)-(NT-4); if(jb_>=0)cmask(P0,P1,jb_,qrel,hi);}while(0)
  bool resc=false;
  #define START(P0,P1) do{ const float rm=rowmax(P0,P1); resc=false; \
    { const float dl=rm; \
      _Pragma("unroll") for(int r=0;r<16;++r){P0[r]=fsub_s(P0[r],dl);P1[r]=fsub_s(P1[r],dl);} \
      _Pragma("unroll") for(int r=0;r<16;++r)negm[r]-=dl; asm volatile("":"+v"(negm)); } \
    _Pragma("unroll") for(int r=0;r<16;++r)P0[r]=__builtin_amdgcn_exp2f(P0[r]); }while(0)
  #define RESC() do{ if(resc){ asm volatile("s_waitcnt lgkmcnt(0)":::"memory"); \
      _Pragma("unroll") for(int d_=0;d_<2;++d_) _Pragma("unroll") for(int r=0;r<16;++r)o[d_][r]*=wsf[crow(r,hi)]; } }while(0)
  f32x16 pA0,pA1,pB0,pB1;
  int sl_prev=0,sl_cur=0,sl_next=SLOTB;
  #define ROT() do{sl_prev=sl_cur;sl_cur=sl_next;sl_next=(sl_next==(NSLOT-1)*SLOTB)?0:sl_next+SLOTB;}while(0)
  DMA_K(2,2*SLOTB);
  unsigned nxt_=0u; if(wid==0&&lane==0)nxt_=__hip_atomic_fetch_add(qctr,1u,__ATOMIC_RELAXED,__HIP_MEMORY_SCOPE_AGENT);
  WAIT_BAR(3);
  qkt(pA0,pA1,Kbase,qr,negm,r32,hi);asm volatile("s_nop 15\n\ts_nop 7":"+v"(pA0),"+v"(pA1));CMASK(pA0,pA1,0);
  START(pA0,pA1);
  _Pragma("unroll") for(int r=0;r<16;++r)pA1[r]=__builtin_amdgcn_exp2f(pA1[r]);
  WAIT_BAR(0);
  if(wid==0&&lane==0)*(volatile __attribute__((address_space(3))) unsigned*)(shm3+qslot)=nxt_;
  DMA_K(3,0);DMA_V(1,SLOTB);
  ROT();
  kload8(kf,kp0+sl_cur);
  WAIT_BAR(2);
  s16x4 vlo[8],vhi[8]; u32x4 pw0,pw1,pw2,pw3;
  #define PKW(P,B) cvtpk_s(P[B],P[B+1])
  #define PAF(k) __builtin_bit_cast(bf16x8,pw##k)
  #define VFR(i) (bf16x8){vlo[i][0],vlo[i][1],vlo[i][2],vlo[i][3],vhi[i][0],vhi[i][1],vhi[i][2],vhi[i][3]}
  #define PIN(x) asm volatile("":"+v"(x))
  #define MX3(a,b,c) __builtin_fmaxf(__builtin_fmaxf((a),(b)),(c))
  #define GAPA(MF,SA,A0,A1,A2,A3,W0,W1,PW) do{ MF; SA+=A0; SA+=A1; SA+=A2; SA+=A3; PIN(SA); W0; W1; PIN(PW); SBAR(); }while(0)
  #define GAPA2(MF,A0,A1,B0_,B1_,W0,W1,PW) do{ MF; sacc+=A0; sacc+=A1; saccb=B0_+B1_; PIN(sacc); PIN(saccb); W0; W1; PIN(PW); SBAR(); }while(0)
  #define EX(v) __builtin_amdgcn_exp2f(v)
  #define GAPB(MF,X,B) do{ MF; X[B]=EX(X[B]); X[B+1]=EX(X[B+1]); X[B+2]=EX(X[B+2]); X[B+3]=EX(X[B+3]); PIN(X); SBAR(); }while(0)
  #define VRD(i) do{ vlo[i]=vtr(vp_+(((i)>>2)*4096+((i)&3)*1024)); vhi[i]=vtr(vp_+(((i)>>2)*4096+((i)&3)*1024+512)); }while(0)
  #define KRD(G,j) do{ if(G){ kload2(kf,kp0+sl_next,j); SBAR(); } }while(0)
  #define STEP(C0,C1,P0,P1,t,GK,GV,GL) do{ SBAR(); \
    _Pragma("unroll") for(int r=0;r<16;++r)negm[r]+=sl64; asm volatile("":"+v"(negm)); SBAR(); \
    const lds_cptr vp_=vp0+sl_prev; \
    VRD(0); SBAR(); float sacc=(P0[0]+P0[1]); float saccb; \
    GAPA(C0=__builtin_amdgcn_mfma_f32_32x32x16_bf16(kf[0],qr[0],negm,0,0,0), sacc, P0[2],P0[3],P0[4],P0[5],     pw0[0]=PKW(P0,0), pw0[1]=PKW(P0,2), pw0); \
    VRD(4); SBAR(); GAPA(C1=__builtin_amdgcn_mfma_f32_32x32x16_bf16(kf[1],qr[0],negm,0,0,0), sacc, P0[6],P0[7],P0[8],P0[9],     pw0[2]=PKW(P0,4), pw0[3]=PKW(P0,6), pw0); \
    VRD(1); SBAR(); GAPA(C0=__builtin_amdgcn_mfma_f32_32x32x16_bf16(kf[2],qr[1],C0,0,0,0),   sacc, P0[10],P0[11],P0[12],P0[13], pw1[0]=PKW(P0,8), pw1[1]=PKW(P0,10), pw1); \
    VRD(5); SBAR(); GAPA2(C1=__builtin_amdgcn_mfma_f32_32x32x16_bf16(kf[3],qr[1],C1,0,0,0),   P0[14],P0[15],P1[0],P1[1],   pw1[2]=PKW(P0,12),pw1[3]=PKW(P0,14), pw1); \
    VRD(2); SBAR(); GAPA(C0=__builtin_amdgcn_mfma_f32_32x32x16_bf16(kf[4],qr[2],C0,0,0,0),   saccb, P1[2],P1[3],P1[4],P1[5],     pw2[0]=PKW(P1,0), pw2[1]=PKW(P1,2), pw2); \
    VRD(6); SBAR(); GAPA(C1=__builtin_amdgcn_mfma_f32_32x32x16_bf16(kf[5],qr[2],C1,0,0,0),   saccb, P1[6],P1[7],P1[8],P1[9],     pw2[2]=PKW(P1,4), pw2[3]=PKW(P1,6), pw2); \
    VRD(3); SBAR(); GAPA(C0=__builtin_amdgcn_mfma_f32_32x32x16_bf16(kf[6],qr[3],C0,0,0,0),   saccb, P1[10],P1[11],P1[12],P1[13], pw3[0]=PKW(P1,8), pw3[1]=PKW(P1,10), pw3); \
    VRD(7); SBAR(); GAPA(C1=__builtin_amdgcn_mfma_f32_32x32x16_bf16(kf[7],qr[3],C1,0,0,0),   saccb, P1[14],P1[15],0.f,0.f,       pw3[2]=PKW(P1,12),pw3[3]=PKW(P1,14), pw3); \
    l_reg+=sacc+c32*saccb; \
    if(GK){DMA_K((t)+3,sl_cur);} if(GV){DMA_V((t)+1,sl_next);} \
    CMASK(C0,C1,t); \
    { float a=MX3(C0[0],C0[1],C1[0]),b=MX3(C0[2],C0[3],C1[1]); a=MX3(a,C1[2],C1[3]); \
      _Pragma("unroll") for(int r=4;r<16;r+=4){a=MX3(a,C0[r],C0[r+1]);b=MX3(b,C0[r+2],C0[r+3]);a=MX3(a,C1[r],C1[r+1]);b=MX3(b,C1[r+2],C1[r+3]);} \
      float rm=__builtin_fmaxf(a,b); { auto rr=__builtin_amdgcn_permlane32_swap(__float_as_uint(rm),__float_as_uint(rm),false,false); rm=__builtin_fmaxf(__uint_as_float(rr[0]),__uint_as_float(rr[1])); } \
      resc=false; \
      if(__builtin_expect(__any(rm>(float)THRL),0)){ const float dl=__builtin_fmaxf(rm,0.f); \
        _Pragma("unroll") for(int r=0;r<16;++r){C0[r]-=dl;C1[r]-=dl;} \
        _Pragma("unroll") for(int r=0;r<16;++r)negm[r]-=dl; asm volatile("":"+v"(negm)); \
        const float f=__builtin_amdgcn_exp2f(-dl); l_reg*=f; if(hi==0)wsf[r32]=f; resc=true; } } \
    SBAR(); \
    GAPB(o[0]=__builtin_amdgcn_mfma_f32_32x32x16_bf16(PAF(0),VFR(0),o[0],0,0,0), C0,0); \
    GAPB(o[1]=__builtin_amdgcn_mfma_f32_32x32x16_bf16(PAF(0),VFR(4),o[1],0,0,0), C0,4); \
    KRD(GL,0); GAPB(o[0]=__builtin_amdgcn_mfma_f32_32x32x16_bf16(PAF(1),VFR(1),o[0],0,0,0), C0,8); \
    KRD(GL,1); GAPB(o[1]=__builtin_amdgcn_mfma_f32_32x32x16_bf16(PAF(1),VFR(5),o[1],0,0,0), C0,12); \
    KRD(GL,2); GAPB(o[0]=__builtin_amdgcn_mfma_f32_32x32x16_bf16(PAF(2),VFR(2),o[0],0,0,0), C1,0); \
    KRD(GL,3); GAPB(o[1]=__builtin_amdgcn_mfma_f32_32x32x16_bf16(PAF(2),VFR(6),o[1],0,0,0), C1,4); \
    GAPB(o[0]=__builtin_amdgcn_mfma_f32_32x32x16_bf16(PAF(3),VFR(3),o[0],0,0,0), C1,8); \
    GAPB(o[1]=__builtin_amdgcn_mfma_f32_32x32x16_bf16(PAF(3),VFR(7),o[1],0,0,0), C1,12); \
    }while(0)
  int t=1;
  #undef CMASK
  #define CMASK(P0,P1,t) do{}while(0)
  for(;t+5<NT;t+=2){
    STEP(pB0,pB1,pA0,pA1,t,true,true,true);     WAIT_BAR(2); RESC(); ROT();
    STEP(pA0,pA1,pB0,pB1,t+1,true,true,true);   WAIT_BAR(2); RESC(); ROT();
  }
  #undef CMASK
  #define CMASK(P0,P1,t) do{int jb_=(t)-(NT-4); if(jb_>=0)cmask(P0,P1,jb_,qrel,hi);}while(0)
  #define ENDW(tt) do{ if((tt)+3<NT){WAIT_BAR(2);} else if((tt)+2<NT){WAIT_BAR(1);} else {WAIT_BAR(0);} }while(0)
  for(;t+1<NT;t+=2){
    STEP(pB0,pB1,pA0,pA1,t,(t+3<NT),(t+1<NT),(t+1<NT));       ENDW(t);   RESC(); ROT();
    STEP(pA0,pA1,pB0,pB1,t+1,(t+4<NT),(t+2<NT),(t+2<NT));     ENDW(t+1); RESC(); ROT();
  }
  STEP(pB0,pB1,pA0,pA1,NT-1,false,false,false); RESC();
  { float sacc=pB0[0]+pB0[1]; _Pragma("unroll") for(int r=2;r<16;++r)sacc+=pB0[r]; float saccb=pB1[0]+pB1[1]; _Pragma("unroll") for(int r=2;r<16;++r)saccb+=pB1[r]; l_reg+=sacc+c32*saccb;
    pw0=(u32x4){PKW(pB0,0),PKW(pB0,2),PKW(pB0,4),PKW(pB0,6)};pw1=(u32x4){PKW(pB0,8),PKW(pB0,10),PKW(pB0,12),PKW(pB0,14)};pw2=(u32x4){PKW(pB1,0),PKW(pB1,2),PKW(pB1,4),PKW(pB1,6)};pw3=(u32x4){PKW(pB1,8),PKW(pB1,10),PKW(pB1,12),PKW(pB1,14)};
    SBAR(); pv(o,(int)(unsigned)(unsigned long)(vp0+sl_cur),PAF(0),PAF(1),PAF(2),PAF(3)); }
  #undef PKW
  #undef PAF
  #undef VFR
  #undef PIN
  #undef MX3
  #undef GAPA
  #undef GAPA2
  #undef GAPB
  #undef EX
  #undef VRD
  #undef KRD
  #undef STEP
  #undef ENDW
  {auto rr=__builtin_amdgcn_permlane32_swap(__float_as_uint(l_reg),__float_as_uint(l_reg),false,false);l_reg=__uint_as_float(rr[0])+__uint_as_float(rr[1]);}
  if(hi==0)wsf[32+r32]=l_reg;asm volatile("s_waitcnt lgkmcnt(0)":::"memory");
  float rli[16];
  #pragma unroll
  for(int r=0;r<16;++r)rli[r]=__builtin_amdgcn_rcpf(wsf[32+crow(r,hi)]);
  bf16*Ow=Oh+(rowbase+q0+wid*QBLK)*OP;
  { bf16*stg=(bf16*)(shm+LDS_OST)+wid*2048;
    #pragma unroll
    for(int r=0;r<16;++r){const int orow=crow(r,hi);
      #pragma unroll
      for(int d0=0;d0<2;++d0)stg[orow*64+d0*32+r32]=__float2bfloat16(o[d0][r]*rli[r]);}
    asm volatile("s_waitcnt lgkmcnt(0)":::"memory");
    #pragma unroll
    for(int i=0;i<4;++i){const int row=i*8+(lane>>3),ch=lane&7; const u32x4 v=*(const u32x4*)(stg+row*64+ch*8); ATTN_STORE16(Ow+(long)row*OP+ch*8,v);} }
  asm volatile("s_waitcnt lgkmcnt(0)\n\ts_barrier":::"memory");
  #undef DMA_K
  #undef DMA_V
  #undef CMASK
  #undef START
  #undef RESC
  #undef ROT
}
constexpr int ATTN_LDS_BYTES=LDS_BYTES;
constexpr int A2_K=0, A2_V=4*8192, A2_WS=A2_V+3*16384, A2_BYTES=A2_WS+NW*256;
__device__ __forceinline__ void attn_unit2(int b,int qb,const bf16*Qh,const bf16*__restrict__ Kh0,const bf16*__restrict__ Vh0,bf16*Oh,float sl,float c32,char*shm,int wid_in,int T0,unsigned*qctr,unsigned qslot){
  const int lane=lane_id_asm(),r32=lane&31,hi=lane>>5; int wid=wid_in; asm volatile("":"+s"(wid));
  const long rowbase=(long)b*SEQ; const int q0=qb*QB;
  const bf16*Qw=Qh+(rowbase+q0+wid*QBLK)*QP;
  const bf16*Kh=Kh0+(rowbase+(long)T0*KVBLK)*KP,*Vh=Vh0+(rowbase+(long)T0*KVBLK)*VP;
  const unsigned lds0=(unsigned)(uintptr_t)shm;
  float*wsf=(float*)(shm+A2_WS)+wid*64;
  const unsigned koff=(unsigned)(lane*KP+wid*8)*2u;
  const unsigned voff=(unsigned)((16*(wid&3)+(lane>>2))*VP+(wid>>2)*32+(lane&3)*8)*2u;
  const unsigned kdst=lds0+A2_K+wid*1024, vdst=lds0+A2_V+wid*1024;
  #define DMA_K(t,slot) glds16(Kh+(long)(t)*KVBLK*KP,koff,(unsigned)__builtin_amdgcn_readfirstlane(kdst+(slot)))
  #define DMA_V0(t,slot) glds16(Vh+(long)(t)*KVBLK*VP,voff,(unsigned)__builtin_amdgcn_readfirstlane(vdst+2*(slot)))
  #define DMA_V1(t,slot) glds16(Vh+(long)(t)*KVBLK*VP+64,voff,(unsigned)__builtin_amdgcn_readfirstlane(vdst+2*(slot)+8192))
  #define DMA_V(t,slot) do{ DMA_V0(t,slot); DMA_V1(t,slot); }while(0)
  const char*Kbase=shm+A2_K; bf16x8 kf[8];
  const lds_cptr shm3=(lds_cptr)shm; const lds_cptr kp0=shm3+A2_K+hi*1024+r32*16; const lds_cptr vp0=shm3+A2_V+((lane>>4)&1)*32+(lane&3)*8+(4*hi+((lane&15)>>2))*64;
  const int NT=(q0+QB)/KVBLK-T0;
  DMA_K(0,0);DMA_V(0,0);DMA_K(1,8192);
  bf16x8 qr[4];
  #pragma unroll
  for(int d0=0;d0<4;++d0)qr[d0]=*reinterpret_cast<const bf16x8*>(&Qw[(long)r32*QP+d0*16+hi*8]);
  float l_reg=0.f;f32x16 o[4];o[0]=f32x16{};o[1]=f32x16{};o[2]=f32x16{};o[3]=f32x16{};f32x16 negm;
  { float hb_=sl*(float)(64*T0-q0-QBLK*wid-r32+4*hi); asm volatile("":"+v"(hb_));
    _Pragma("unroll") for(int r=0;r<16;++r)negm[r]=hb_+sl*(float)((r&3)+8*(r>>2)); }
  asm volatile("":"+v"(negm)); const float sl64=64.f*sl;
  const int qrel=wid*QBLK+r32;
  #define CMASK(P0,P1,t) do{int jb_=(t)-(NT-4); if(jb_>=0)cmask(P0,P1,jb_,qrel,hi);}while(0)
  int sl_prev=0,sl_cur=0,sl_next=8192;
  #define ROT() do{sl_prev=sl_cur;sl_cur=sl_next;sl_next=(sl_next==2*8192)?0:sl_next+8192;}while(0)
  DMA_K(2,2*8192);
  #define KSL(t) (((t)&3)*8192)
  unsigned nxt_=0u; if(wid==0&&lane==0)nxt_=__hip_atomic_fetch_add(qctr,1u,__ATOMIC_RELAXED,__HIP_MEMORY_SCOPE_AGENT);
  WAIT_BAR(3);
  u32x4 pwA0,pwA1,pwA2,pwA3,pwB0,pwB1,pwB2,pwB3;
  #define PKW(P,B) cvtpk_s(P[B],P[B+1])
  #define EX(v) __builtin_amdgcn_exp2f(v)
  #define PIN(x) asm volatile("":"+v"(x))
  { f32x16 c0,c1; qkt(c0,c1,Kbase,qr,negm,r32,hi); CMASK(c0,c1,0);
    float sa=0.f,sb=0.f;
    _Pragma("unroll") for(int r=0;r<16;++r){c0[r]=EX(c0[r]);c1[r]=EX(c1[r]);sa+=c0[r];sb+=c1[r];}
    l_reg+=sa+c32*sb;
    pwA0=(u32x4){PKW(c0,0),PKW(c0,2),PKW(c0,4),PKW(c0,6)};pwA1=(u32x4){PKW(c0,8),PKW(c0,10),PKW(c0,12),PKW(c0,14)};pwA2=(u32x4){PKW(c1,0),PKW(c1,2),PKW(c1,4),PKW(c1,6)};pwA3=(u32x4){PKW(c1,8),PKW(c1,10),PKW(c1,12),PKW(c1,14)}; }
  WAIT_BAR(0);
  if(wid==0&&lane==0)*(volatile __attribute__((address_space(3))) unsigned*)(shm3+qslot)=nxt_;
  DMA_K(3,3*8192);DMA_V(1,8192);
  ROT();
  kload2(kf,kp0+KSL(1),0); kload2(kf,kp0+KSL(1),1);
  _Pragma("unroll") for(int r=0;r<16;++r)negm[r]+=sl64;
  s16x4 vlo[8],vhi[8];
  #define PAFI(PI,k) __builtin_bit_cast(bf16x8,PI##k)
  #define VFR(i) (bf16x8){vlo[i][0],vlo[i][1],vlo[i][2],vlo[i][3],vhi[i][0],vhi[i][1],vhi[i][2],vhi[i][3]}
  #define VRD(ks,d) do{ vlo[((ks)&1)*4+(d)]=vtr(vp_+((d)*4096+(ks)*1024)); vhi[((ks)&1)*4+(d)]=vtr(vp_+((d)*4096+(ks)*1024+512)); }while(0)
  #define GAPQ(MF) do{ MF; SBAR(); }while(0)
  #define GAPN(MF,B) do{ MF; negm[B]+=sl64; negm[B+1]+=sl64; negm[B+2]+=sl64; negm[B+3]+=sl64; PIN(negm); SBAR(); }while(0)
  #define GAPB(MF,RD,X,SA,B,PO,W) do{ MF; RD; X[B]=EX(X[B]); X[B+1]=EX(X[B+1]); SA+=X[B]; SA+=X[B+1]; PO[W]=PKW(X,B); PIN(X); PIN(SA); PIN(PO); SBAR(); }while(0)
  #define STEP2(PI,PO,t,GK,GV,GL) do{ SBAR(); \
    const lds_cptr vp_=vp0+2*sl_prev; const lds_cptr kq_=kp0+KSL(t); f32x16 C0,C1; float sa=0.f,sb=0.f; \
    kload2(kf,kq_,2); VRD(0,0); SBAR(); kload2(kf,kq_,3); VRD(0,1); SBAR(); \
    GAPQ(C0=__builtin_amdgcn_mfma_f32_32x32x16_bf16(kf[0],qr[0],negm,0,0,0)); \
    VRD(0,2); SBAR(); GAPQ(C1=__builtin_amdgcn_mfma_f32_32x32x16_bf16(kf[1],qr[0],negm,0,0,0)); \
    VRD(0,3); SBAR(); GAPN(C0=__builtin_amdgcn_mfma_f32_32x32x16_bf16(kf[2],qr[1],C0,0,0,0),0); \
    VRD(1,0); SBAR(); GAPN(C1=__builtin_amdgcn_mfma_f32_32x32x16_bf16(kf[3],qr[1],C1,0,0,0),4); \
    VRD(1,1); SBAR(); GAPN(C0=__builtin_amdgcn_mfma_f32_32x32x16_bf16(kf[4],qr[2],C0,0,0,0),8); \
    VRD(1,2); SBAR(); GAPN(C1=__builtin_amdgcn_mfma_f32_32x32x16_bf16(kf[5],qr[2],C1,0,0,0),12); \
    VRD(1,3); SBAR(); GAPQ(C0=__builtin_amdgcn_mfma_f32_32x32x16_bf16(kf[6],qr[3],C0,0,0,0)); \
    GAPQ(C1=__builtin_amdgcn_mfma_f32_32x32x16_bf16(kf[7],qr[3],C1,0,0,0)); \
    CMASK(C0,C1,t); SBAR(); \
    GAPB(o[0]=__builtin_amdgcn_mfma_f32_32x32x16_bf16(PAFI(PI,0),VFR(0),o[0],0,0,0), VRD(2,0), C0,sa,0, PO##0,0); \
    GAPB(o[1]=__builtin_amdgcn_mfma_f32_32x32x16_bf16(PAFI(PI,0),VFR(1),o[1],0,0,0), VRD(2,1), C0,sa,2, PO##0,1); \
    GAPB(o[2]=__builtin_amdgcn_mfma_f32_32x32x16_bf16(PAFI(PI,0),VFR(2),o[2],0,0,0), VRD(2,2), C0,sa,4, PO##0,2); \
    GAPB(o[3]=__builtin_amdgcn_mfma_f32_32x32x16_bf16(PAFI(PI,0),VFR(3),o[3],0,0,0), VRD(2,3), C0,sa,6, PO##0,3); \
    GAPB(o[0]=__builtin_amdgcn_mfma_f32_32x32x16_bf16(PAFI(PI,1),VFR(4),o[0],0,0,0), VRD(3,0), C0,sa,8, PO##1,0); \
    GAPB(o[1]=__builtin_amdgcn_mfma_f32_32x32x16_bf16(PAFI(PI,1),VFR(5),o[1],0,0,0), VRD(3,1), C0,sa,10, PO##1,1); \
    GAPB(o[2]=__builtin_amdgcn_mfma_f32_32x32x16_bf16(PAFI(PI,1),VFR(6),o[2],0,0,0), VRD(3,2), C0,sa,12, PO##1,2); \
    GAPB(o[3]=__builtin_amdgcn_mfma_f32_32x32x16_bf16(PAFI(PI,1),VFR(7),o[3],0,0,0), VRD(3,3), C0,sa,14, PO##1,3); \
    GAPB(o[0]=__builtin_amdgcn_mfma_f32_32x32x16_bf16(PAFI(PI,2),VFR(0),o[0],0,0,0), if(GK){DMA_K((t)+3,KSL((t)+3));}, C1,sb,0, PO##2,0); \
    GAPB(o[1]=__builtin_amdgcn_mfma_f32_32x32x16_bf16(PAFI(PI,2),VFR(1),o[1],0,0,0), if(GL){kload2(kf,kp0+KSL((t)+1),0);}, C1,sb,2, PO##2,1); \
    GAPB(o[2]=__builtin_amdgcn_mfma_f32_32x32x16_bf16(PAFI(PI,2),VFR(2),o[2],0,0,0), if(GV){DMA_V0((t)+1,sl_next);}, C1,sb,4, PO##2,2); \
    GAPB(o[3]=__builtin_amdgcn_mfma_f32_32x32x16_bf16(PAFI(PI,2),VFR(3),o[3],0,0,0), if(GL){kload2(kf,kp0+KSL((t)+1),1);}, C1,sb,6, PO##2,3); \
    GAPB(o[0]=__builtin_amdgcn_mfma_f32_32x32x16_bf16(PAFI(PI,3),VFR(4),o[0],0,0,0), if(GV){DMA_V1((t)+1,sl_next);}, C1,sb,8, PO##3,0); \
    GAPB(o[1]=__builtin_amdgcn_mfma_f32_32x32x16_bf16(PAFI(PI,3),VFR(5),o[1],0,0,0), (void)0, C1,sb,10, PO##3,1); \
    GAPB(o[2]=__builtin_amdgcn_mfma_f32_32x32x16_bf16(PAFI(PI,3),VFR(6),o[2],0,0,0), (void)0, C1,sb,12, PO##3,2); \
    GAPB(o[3]=__builtin_amdgcn_mfma_f32_32x32x16_bf16(PAFI(PI,3),VFR(7),o[3],0,0,0), (void)0, C1,sb,14, PO##3,3); \
    l_reg+=sa+c32*sb; \
    }while(0)
  int t=1;
  #undef CMASK
  #define CMASK(P0,P1,t) do{}while(0)
  for(;t+5<NT;t+=2){
    STEP2(pwA,pwB,t,true,true,true);     WAIT_BAR(3); ROT();
    STEP2(pwB,pwA,t+1,true,true,true);   WAIT_BAR(3); ROT();
  }
  #undef CMASK
  #define CMASK(P0,P1,t) do{int jb_=(t)-(NT-4); if(jb_>=0)cmask(P0,P1,jb_,qrel,hi);}while(0)
  #define ENDW(tt) do{ if((tt)+3<NT){WAIT_BAR(3);} else if((tt)+2<NT){WAIT_BAR(2);} else {WAIT_BAR(0);} }while(0)
  for(;t+1<NT;t+=2){
    STEP2(pwA,pwB,t,(t+3<NT),(t+1<NT),(t+1<NT));       ENDW(t);   ROT();
    STEP2(pwB,pwA,t+1,(t+4<NT),(t+2<NT),(t+2<NT));     ENDW(t+1); ROT();
  }
  STEP2(pwA,pwB,NT-1,false,false,false);
  { const int vb=(int)(unsigned)(unsigned long)(vp0+2*sl_cur);
    #pragma unroll
    for(int d0=0;d0<4;++d0){s16x4 lo[4],hh[4];
      #pragma unroll
      for(int ks=0;ks<4;++ks){
        asm volatile("ds_read_b64_tr_b16 %0,%1 offset:%c2":"=&v"(lo[ks]):"v"(vb),"i"(d0*4096+ks*1024):"memory");
        asm volatile("ds_read_b64_tr_b16 %0,%1 offset:%c2":"=&v"(hh[ks]):"v"(vb),"i"(d0*4096+ks*1024+512):"memory");}
      asm volatile("s_waitcnt lgkmcnt(0)":::"memory");SBAR();
      #define PK(k) (bf16x8){lo[k][0],lo[k][1],lo[k][2],lo[k][3],hh[k][0],hh[k][1],hh[k][2],hh[k][3]}
      o[d0]=__builtin_amdgcn_mfma_f32_32x32x16_bf16(PAFI(pwB,0),PK(0),o[d0],0,0,0);
      o[d0]=__builtin_amdgcn_mfma_f32_32x32x16_bf16(PAFI(pwB,1),PK(1),o[d0],0,0,0);
      o[d0]=__builtin_amdgcn_mfma_f32_32x32x16_bf16(PAFI(pwB,2),PK(2),o[d0],0,0,0);
      o[d0]=__builtin_amdgcn_mfma_f32_32x32x16_bf16(PAFI(pwB,3),PK(3),o[d0],0,0,0);
      #undef PK
    } }
  {auto rr=__builtin_amdgcn_permlane32_swap(__float_as_uint(l_reg),__float_as_uint(l_reg),false,false);l_reg=__uint_as_float(rr[0])+__uint_as_float(rr[1]);}
  if(hi==0)wsf[32+r32]=l_reg;
  asm volatile("s_waitcnt lgkmcnt(0)\n\ts_barrier":::"memory");
  float rli[16];
  #pragma unroll
  for(int r=0;r<16;++r)rli[r]=__builtin_amdgcn_rcpf(wsf[32+crow(r,hi)]);
  bf16*Ow=Oh+(rowbase+q0+wid*QBLK)*OP;
  { bf16*stg=(bf16*)(shm)+wid*4096;
    #pragma unroll
    for(int r=0;r<16;++r){const int orow=crow(r,hi);
      #pragma unroll
      for(int d0=0;d0<4;++d0)stg[orow*128+d0*32+r32]=__float2bfloat16(o[d0][r]*rli[r]);}
    asm volatile("s_waitcnt lgkmcnt(0)":::"memory");
    #pragma unroll
    for(int i=0;i<8;++i){const int row=i*4+(lane>>4),ch=lane&15; const u32x4 v=*(const u32x4*)(stg+row*128+ch*8); ATTN_STORE16(Ow+(long)row*OP+ch*8,v);} }
  asm volatile("s_waitcnt lgkmcnt(0)\n\ts_barrier":::"memory");
  #undef DMA_K
  #undef DMA_V
  #undef DMA_V0
  #undef DMA_V1
  #undef CMASK
  #undef ROT
  #undef PKW
  #undef EX
  #undef PIN
  #undef PAFI
  #undef VFR
  #undef VRD
  #undef KSL
  #undef GAPQ
  #undef GAPN
  #undef GAPB
  #undef STEP2
  #undef ENDW
}
#undef SBAR
#undef WAIT_BAR
}

constexpr int NWAVES = 8;
constexpr int M = 32768, DMODEL = 1024, NIN = 3584, SEQL = 4096;
constexpr size_t MiB = 1u << 20;
constexpr size_t WS_ROWSS = 0;
constexpr size_t WS_WIN = 2 * MiB, WS_WO = 10 * MiB, WS_PW = 12 * MiB;
constexpr size_t WS_XN = 16 * MiB, WS_O = WS_XN;
constexpr size_t WS_HG = 80 * MiB, WS_CG = 112 * MiB, WS_Q = 144 * MiB, WS_K = 176 * MiB, WS_V = 208 * MiB, WS_DG = 240 * MiB, WS_U = 272 * MiB;
constexpr size_t WS_Y = 304 * MiB, WS_Y2 = 368 * MiB, WS_END = 432 * MiB;
constexpr int RING_BYTES = 131072, LDS_BYTES = 147456, LDSCTL_OFF = RING_BYTES;
constexpr size_t WS_BAR = 512 * 1024, WS_BAR_BYTES = 24576;
constexpr int NMAX_WORD = 3600, QCTR_WORD = 3712, GB_WORD = 4096, QG_WORD = 4608, NMG_WORD = 5120;
#define GAS __attribute__((address_space(1)))
#define LAS __attribute__((address_space(3)))
typedef unsigned short bf16;
typedef unsigned v4u __attribute__((ext_vector_type(4)));
typedef unsigned v2u __attribute__((ext_vector_type(2)));
typedef float f32x4 __attribute__((ext_vector_type(4)));
typedef float f32x2 __attribute__((ext_vector_type(2)));
#define LDS_WAIT() asm volatile("s_waitcnt lgkmcnt(0)" ::: "memory")
__device__ __forceinline__ unsigned pk2(float lo, float hi) { return pg8::cvt_pk_bf16(lo, hi); }
__device__ __forceinline__ float wave_sum(float v) {
#pragma unroll
    for (int o = 1; o < 64; o <<= 1) v += __shfl_xor(v, o);
    return v;
}
__device__ __forceinline__ void p0_transpose_item(const float* W, int K, int N, bf16* WT, int k0, int n0, int dst_row0, LAS float* scr, int lane) {
#pragma unroll
    for (int i = 0; i < 32; ++i) { const int kk = 2 * i + (lane >> 5); scr[kk * 33 + (lane & 31)] = W[(size_t)(k0 + kk) * N + n0 + (lane & 31)]; }
    LDS_WAIT(); asm volatile("" ::: "memory");
    const int c = lane & 7;
#pragma unroll
    for (int j = 0; j < 4; ++j) { const int n = (lane >> 3) + 8 * j; const LAS float* p = scr + (8 * c) * 33 + n;
        v4u o; o.x = pk2(p[0 * 33], p[1 * 33]); o.y = pk2(p[2 * 33], p[3 * 33]); o.z = pk2(p[4 * 33], p[5 * 33]); o.w = pk2(p[6 * 33], p[7 * 33]);
        *(v4u*)(WT + (size_t)(dst_row0 + n) * K + k0 + 8 * c) = o; }
    LDS_WAIT(); asm volatile("" ::: "memory");
}
__device__ __forceinline__ int win_dst_row(int n0) {
    if (n0 >= 1024) return n0;
    if (n0 < 512) return 256 * (n0 >> 7) + (n0 & 127);
    const int n1 = n0 - 512; return 256 * (n1 >> 7) + 128 + (n1 & 127);
}

#define RLX_AGENT __ATOMIC_RELAXED, __HIP_MEMORY_SCOPE_AGENT
#define XB_TMO      128
#define XB_XCNT(j)  (256  + 64 * (j))
#define XB_XSUB(j)  (1280 + 64 * (j))
#define XB_XGEN(j)  (2304 + 64 * (j))
#define XB_TOP      3328
#define XB_TOPGEN   3392
#define XCD_BAR_WORDS 3456
#define XB_SPIN_CAP (1u << 18)

__device__ __forceinline__ unsigned xb_ld(unsigned* p)              { return __hip_atomic_load(p, __ATOMIC_RELAXED, __HIP_MEMORY_SCOPE_AGENT); }
__device__ __forceinline__ unsigned xb_add(unsigned* p, unsigned v) { return __hip_atomic_fetch_add(p, v, __ATOMIC_RELAXED, __HIP_MEMORY_SCOPE_AGENT); }
__device__ __forceinline__ unsigned xb_xcc_id() { return (unsigned)__builtin_amdgcn_s_getreg((3 << 11) | 20) & 0xFu; }
#define XB_SPIN(cond, bar) do { unsigned _sp = 0; while (cond) { __builtin_amdgcn_s_sleep(1); \
    if ((++_sp & 255u) == 0u) { if (xb_ld(&(bar)[XB_TMO])) break; if (_sp > XB_SPIN_CAP) { atomicAdd(&(bar)[XB_TMO], 1u); break; } } } } while (0)

struct XcdBarrier {
    unsigned* bar; unsigned x;
    volatile LAS unsigned* st;
};

__device__ __forceinline__ XcdBarrier xcd_barrier_post(unsigned* bar, volatile LAS unsigned* st) {
    XcdBarrier b; b.bar = bar; b.x = xb_xcc_id(); b.st = st;
    if (threadIdx.x == 0) (void)xb_add(&bar[XB_XCNT(b.x)], 1u);
    return b;
}
__device__ __forceinline__ void xcd_barrier_complete(unsigned* bar, unsigned x, unsigned& nloc, unsigned& nx) {
    const unsigned G = gridDim.x * gridDim.y * gridDim.z;
    unsigned sum, cnt, mine, sp = 0u;
    for (;;) {
        sum = 0u; cnt = 0u; mine = 0u;
#pragma unroll
        for (unsigned j = 0; j < 16; ++j) { const unsigned c = xb_ld(&bar[XB_XCNT(j)]); sum += c; cnt += (c > 0u) ? 1u : 0u; mine = (j == x) ? c : mine; }
        if (sum == G) break;
        __builtin_amdgcn_s_sleep(1);
        if ((++sp & 255u) == 0u) { if (xb_ld(&bar[XB_TMO])) break; if (sp > XB_SPIN_CAP) { atomicAdd(&bar[XB_TMO], 1u); break; } }
    }
    nloc = mine > 0u ? mine : 1u; nx = cnt > 0u ? cnt : 1u;
}

__device__ __forceinline__ void xcd_barrier(const XcdBarrier& b) {
    asm volatile("s_waitcnt vmcnt(0)" ::: "memory");
    __syncthreads();
    if (threadIdx.x == 0) {
        unsigned* bar = b.bar;
        __builtin_amdgcn_s_waitcnt(0);
        unsigned nloc = b.st[0], nx = b.st[1];
        if (nloc == 0u) { xcd_barrier_complete(bar, b.x, nloc, nx); b.st[0] = nloc; b.st[1] = nx; }
        const unsigned old = xb_add(&bar[XB_XSUB(b.x)], 1u);
        const unsigned gen = old / nloc;
        if (old + 1u == (gen + 1u) * nloc) {
            __builtin_amdgcn_fence(__ATOMIC_RELEASE, "agent");
            asm volatile("s_waitcnt vmcnt(0)" ::: "memory");
            const unsigned og = xb_add(&bar[XB_TOP], 1u);
            const unsigned tg = og / nx;
            if (og + 1u == (tg + 1u) * nx) xb_add(&bar[XB_TOPGEN], 1u);
            else XB_SPIN(xb_ld(&bar[XB_TOPGEN]) == tg, bar);
            __builtin_amdgcn_fence(__ATOMIC_ACQUIRE, "agent");
            xb_add(&bar[XB_XGEN(b.x)], 1u);
            asm volatile("s_waitcnt vmcnt(0)" ::: "memory");
        } else {
            XB_SPIN(xb_ld(&bar[XB_XGEN(b.x)]) == gen, bar);
            __builtin_amdgcn_fence(__ATOMIC_ACQUIRE, "agent");
            asm volatile("s_waitcnt vmcnt(0)" ::: "memory");
        }
    }
    __syncthreads();
}

__device__ __forceinline__ void group_barrier(unsigned* ctr, unsigned target) {
    asm volatile("s_waitcnt vmcnt(0)" ::: "memory");
    __syncthreads();
    if (threadIdx.x == 0) {
        __builtin_amdgcn_fence(__ATOMIC_RELEASE, "agent");
        asm volatile("s_waitcnt vmcnt(0)" ::: "memory");
        __hip_atomic_fetch_add(ctr, 1u, __ATOMIC_RELAXED, __HIP_MEMORY_SCOPE_AGENT);
        unsigned sp = 0u;
        while (__hip_atomic_load(ctr, __ATOMIC_RELAXED, __HIP_MEMORY_SCOPE_AGENT) < target && ++sp < (1u << 22)) __builtin_amdgcn_s_sleep(1);
        __builtin_amdgcn_fence(__ATOMIC_ACQUIRE, "agent");
        asm volatile("s_waitcnt vmcnt(0)" ::: "memory");
    }
    __syncthreads();
}

constexpr int CONV_IN_BYTES = 62 * 1024;
__device__ __forceinline__ void conv_phase(LAS unsigned char* lds, int u0, int ustride, int nunits, const bf16* Hg, const float* dw_w, const float* dw_b, const float* ln_g, const float* ln_b, bf16* U, int tid, int lane, int wave) {
    const int cp = tid & 255, tg = tid >> 8;
    f32x2 w[31];
#pragma unroll
    for (int j = 0; j < 31; ++j) w[j] = *(const f32x2*)(dw_w + j * 512 + 2 * cp);
    const f32x2 bias = *(const f32x2*)(dw_b + 2 * cp);
    f32x4 gg[2], bb[2];
#pragma unroll
    for (int j = 0; j < 2; ++j) { gg[j] = *((const f32x4*)ln_g + lane + 64 * j); bb[j] = *((const f32x4*)ln_b + lane + 64 * j); }
    v4u pre[8];
#define CONV_PREFETCH(unit) do { const int row0_ = (unit) * 32, t0_ = row0_ & (SEQL - 1); _Pragma("unroll") for (int k = 0; k < 8; ++k) { const int i = tid + 512 * k, r = i >> 6, ch = i & 63; pre[k] = (v4u){0u, 0u, 0u, 0u}; \
        if (i < 62 * 64 && t0_ - 30 + r >= 0) pre[k] = *(const v4u*)(Hg + (size_t)(row0_ - 30 + r) * 512 + ch * 8); } } while (0)
    if (u0 < nunits) CONV_PREFETCH(u0);
    for (int unit = u0; unit < nunits; unit += ustride) {
        const int row0 = unit * 32;
#pragma unroll
        for (int k = 0; k < 8; ++k) { const int i = tid + 512 * k, r = i >> 6, ch = i & 63; if (i < 62 * 64) *(LAS v4u*)(lds + r * 1024 + ch * 16) = pre[k]; }
        __syncthreads();
        if (unit + ustride < nunits) CONV_PREFETCH(unit + ustride);
#pragma unroll 1
        for (int g = 0; g < 2; ++g) {
            const int tl0 = tg * 16 + g * 8;
            f32x2 acc[8];
#pragma unroll
            for (int o = 0; o < 8; ++o) acc[o] = bias;
#pragma unroll
            for (int i = 0; i < 38; ++i) { const unsigned wv = *(const LAS unsigned*)(lds + (tl0 + i) * 1024 + cp * 4); const f32x2 x = {pg8::bf_lo(wv), pg8::bf_hi(wv)};
#pragma unroll
                for (int o = 0; o < 8; ++o) { const int j = i - o; if (j >= 0 && j <= 30) acc[o] += w[j] * x; } }
#pragma unroll
            for (int o = 0; o < 8; ++o) *(LAS f32x2*)(lds + CONV_IN_BYTES + (tl0 + o) * 2048 + cp * 8) = acc[o];
        }
        __syncthreads();
        f32x4 v[4][2]; float s1[4], s2[4];
#pragma unroll
        for (int k = 0; k < 4; ++k) { const int tl = wave * 4 + k; s1[k] = 0.f;
#pragma unroll
            for (int j = 0; j < 2; ++j) { v[k][j] = *(const LAS f32x4*)(lds + CONV_IN_BYTES + tl * 2048 + (lane + 64 * j) * 16); s1[k] += (v[k][j].x + v[k][j].y) + (v[k][j].z + v[k][j].w); } }
#pragma unroll
        for (int o = 1; o < 64; o <<= 1) {
#pragma unroll
            for (int k = 0; k < 4; ++k) s1[k] += __shfl_xor(s1[k], o); }
#pragma unroll
        for (int k = 0; k < 4; ++k) { const float mean = s1[k] * (1.f / 512.f); s2[k] = 0.f;
#pragma unroll
            for (int j = 0; j < 2; ++j) { v[k][j] = v[k][j] - mean; s2[k] += (v[k][j].x * v[k][j].x + v[k][j].y * v[k][j].y) + (v[k][j].z * v[k][j].z + v[k][j].w * v[k][j].w); } }
#pragma unroll
        for (int o = 1; o < 64; o <<= 1) {
#pragma unroll
            for (int k = 0; k < 4; ++k) s2[k] += __shfl_xor(s2[k], o); }
#pragma unroll
        for (int k = 0; k < 4; ++k) { const int tl = wave * 4 + k; const float rstd = 1.f / sqrtf(s2[k] * (1.f / 512.f) + 1e-5f);
#pragma unroll
            for (int j = 0; j < 2; ++j) { f32x4 y = v[k][j] * rstd * gg[j] + bb[j];
                y.x = pg8::silu_f(y.x); y.y = pg8::silu_f(y.y); y.z = pg8::silu_f(y.z); y.w = pg8::silu_f(y.w);
                v2u o; o.x = pk2(y.x, y.y); o.y = pk2(y.z, y.w); *(v2u*)(U + (size_t)(row0 + tl) * 512 + (lane + 64 * j) * 4) = o; } }
        __syncthreads();
    }
#undef CONV_PREFETCH
}

__device__ __forceinline__ void conv_phase_dyn(LAS unsigned char* lds, int cur, unsigned* qctr, int qbase  , int nunits, const bf16* Hg, const float* dw_w, const float* dw_b, const float* ln_g, const float* ln_b, bf16* U, int tid, int lane, int wave) {
    const int cp = tid & 255, tg = tid >> 8;
    f32x2 w[31];
#pragma unroll
    for (int j = 0; j < 31; ++j) w[j] = *(const f32x2*)(dw_w + j * 512 + 2 * cp);
    const f32x2 bias = *(const f32x2*)(dw_b + 2 * cp);
    f32x4 gg[2], bb[2];
#pragma unroll
    for (int j = 0; j < 2; ++j) { gg[j] = *((const f32x4*)ln_g + lane + 64 * j); bb[j] = *((const f32x4*)ln_b + lane + 64 * j); }
    v4u pre[8];
#define CONV_PREFETCH(unit) do { const int row0_ = (unit) * 32, t0_ = row0_ & (SEQL - 1); _Pragma("unroll") for (int k = 0; k < 8; ++k) { const int i = tid + 512 * k, r = i >> 6, ch = i & 63; pre[k] = (v4u){0u, 0u, 0u, 0u}; \
        if (i < 62 * 64 && t0_ - 30 + r >= 0) pre[k] = *(const v4u*)(Hg + (size_t)(row0_ - 30 + r) * 512 + ch * 8); } } while (0)
    const bool popper = (wave == 0 && lane == 0); volatile LAS unsigned* slot = (volatile LAS unsigned*)(lds + LDSCTL_OFF + 224);
    if (popper) slot[0] = __hip_atomic_fetch_add(qctr, 1u, __ATOMIC_RELAXED, __HIP_MEMORY_SCOPE_AGENT);
    __syncthreads();
    int nxt = qbase + (int)__builtin_amdgcn_readfirstlane(slot[0]);
    if (cur < nunits) CONV_PREFETCH(cur);
    while (cur < nunits) {
        const int unit = cur; const int row0 = unit * 32;
#pragma unroll
        for (int k = 0; k < 8; ++k) { const int i = tid + 512 * k, r = i >> 6, ch = i & 63; if (i < 62 * 64) *(LAS v4u*)(lds + r * 1024 + ch * 16) = pre[k]; }
        __syncthreads();
        unsigned pv = 0u; if (popper) pv = __hip_atomic_fetch_add(qctr, 1u, __ATOMIC_RELAXED, __HIP_MEMORY_SCOPE_AGENT);
        if (nxt < nunits) CONV_PREFETCH(nxt);
#pragma unroll 1
        for (int g = 0; g < 2; ++g) {
            const int tl0 = tg * 16 + g * 8;
            f32x2 acc[8];
#pragma unroll
            for (int o = 0; o < 8; ++o) acc[o] = bias;
#pragma unroll
            for (int i = 0; i < 38; ++i) { const unsigned wv = *(const LAS unsigned*)(lds + (tl0 + i) * 1024 + cp * 4); const f32x2 x = {pg8::bf_lo(wv), pg8::bf_hi(wv)};
#pragma unroll
                for (int o = 0; o < 8; ++o) { const int j = i - o; if (j >= 0 && j <= 30) acc[o] += w[j] * x; } }
#pragma unroll
            for (int o = 0; o < 8; ++o) *(LAS f32x2*)(lds + CONV_IN_BYTES + (tl0 + o) * 2048 + cp * 8) = acc[o];
        }
        __syncthreads();
        f32x4 v[4][2]; float s1[4], s2[4];
#pragma unroll
        for (int k = 0; k < 4; ++k) { const int tl = wave * 4 + k; s1[k] = 0.f;
#pragma unroll
            for (int j = 0; j < 2; ++j) { v[k][j] = *(const LAS f32x4*)(lds + CONV_IN_BYTES + tl * 2048 + (lane + 64 * j) * 16); s1[k] += (v[k][j].x + v[k][j].y) + (v[k][j].z + v[k][j].w); } }
#pragma unroll
        for (int o = 1; o < 64; o <<= 1) {
#pragma unroll
            for (int k = 0; k < 4; ++k) s1[k] += __shfl_xor(s1[k], o); }
#pragma unroll
        for (int k = 0; k < 4; ++k) { const float mean = s1[k] * (1.f / 512.f); s2[k] = 0.f;
#pragma unroll
            for (int j = 0; j < 2; ++j) { v[k][j] = v[k][j] - mean; s2[k] += (v[k][j].x * v[k][j].x + v[k][j].y * v[k][j].y) + (v[k][j].z * v[k][j].z + v[k][j].w * v[k][j].w); } }
#pragma unroll
        for (int o = 1; o < 64; o <<= 1) {
#pragma unroll
            for (int k = 0; k < 4; ++k) s2[k] += __shfl_xor(s2[k], o); }
#pragma unroll
        for (int k = 0; k < 4; ++k) { const int tl = wave * 4 + k; const float rstd = 1.f / sqrtf(s2[k] * (1.f / 512.f) + 1e-5f);
#pragma unroll
            for (int j = 0; j < 2; ++j) { f32x4 y = v[k][j] * rstd * gg[j] + bb[j];
                y.x = pg8::silu_f(y.x); y.y = pg8::silu_f(y.y); y.z = pg8::silu_f(y.z); y.w = pg8::silu_f(y.w);
                v2u o; o.x = pk2(y.x, y.y); o.y = pk2(y.z, y.w); *(v2u*)(U + (size_t)(row0 + tl) * 512 + (lane + 64 * j) * 4) = o; } }
        if (popper) slot[0] = pv;
        __syncthreads();
        cur = nxt; nxt = qbase + (int)__builtin_amdgcn_readfirstlane(slot[0]);
        __syncthreads();
    }
#undef CONV_PREFETCH
}

struct Args { const float* in[16]; float* out; unsigned char* ws; };
__global__ void __launch_bounds__(NWAVES * 64, 2) fwd_megakernel(Args args) {
    extern __shared__ __attribute__((aligned(16))) unsigned char lds[];
    cg::grid_group grid = cg::this_grid();
    LAS unsigned char* L = (LAS unsigned char*)lds;
    const int wave = __builtin_amdgcn_readfirstlane(threadIdx.x >> 6);
#define FRESH_TID() const int lane = lane_id_asm(); const int tid = wave * 64 + lane; (void)tid
    const int G = gridDim.x; const int bx = blockIdx.x; const int vcu = (G % 8 == 0) ? (bx % 8) * (G / 8) + bx / 8 : bx;
    const int gw = vcu * NWAVES + wave, NGW = G * NWAVES;
    const bool grp = (G == 256); const int NGRP = grp ? 8 : 1, GS = G / NGRP, gi = grp ? (bx & 7) : 0, gj = grp ? (bx >> 3) : bx, NB = 8 / NGRP, RPG = M / NGRP;
    const int gwl = gj * NWAVES + wave, NGWL = GS * NWAVES; unsigned gbt = 0u;
#define GROUP_BAR() do { gbt += (unsigned)GS; group_barrier((unsigned*)(args.ws + WS_BAR) + GB_WORD + 64 * gi, gbt); } while (0)
#define CA4 __attribute__((address_space(4)))
#define PHASE_PTRS() \
    const CA4 Args* A_; { auto kp_ = __builtin_amdgcn_kernarg_segment_ptr(); asm volatile("" : "+s"(kp_)); A_ = (const CA4 Args*)kp_; } \
    unsigned char* ws = A_->ws; (void)ws; \
    const float* x = A_->in[0]; const float* pre_g = A_->in[1]; const float* w_in = A_->in[2]; const float* dw_w = A_->in[3]; const float* dw_b = A_->in[4]; \
    const float* cln_g = A_->in[5]; const float* cln_b = A_->in[6]; const float* pw_w = A_->in[7]; const float* pw_b = A_->in[8]; \
    const float* lq1 = A_->in[9]; const float* lk1 = A_->in[10]; const float* lq2 = A_->in[11]; const float* lk2 = A_->in[12]; \
    const float* sub_g = A_->in[13]; const float* w_out = A_->in[14]; const float* post_g = A_->in[15]; float* out = A_->out; \
    float* rowss = (float*)(ws + WS_ROWSS); \
    bf16 *WinT = (bf16*)(ws + WS_WIN), *WoT = (bf16*)(ws + WS_WO), *PwT = (bf16*)(ws + WS_PW), *XN = (bf16*)(ws + WS_XN), *OB = (bf16*)(ws + WS_O); \
    bf16 *HG = (bf16*)(ws + WS_HG), *CGB = (bf16*)(ws + WS_CG), *QB_ = (bf16*)(ws + WS_Q), *KB = (bf16*)(ws + WS_K), *VB = (bf16*)(ws + WS_V), *DGB = (bf16*)(ws + WS_DG), *UB = (bf16*)(ws + WS_U); \
    bf16 *YB = (bf16*)(ws + WS_Y), *Y2 = (bf16*)(ws + WS_Y2); \
    (void)x; (void)pre_g; (void)w_in; (void)dw_w; (void)dw_b; (void)cln_g; (void)cln_b; (void)pw_w; (void)pw_b; (void)lq1; (void)lk1; (void)lq2; (void)lk2; (void)sub_g; (void)w_out; (void)post_g; (void)out; \
    (void)rowss; (void)WinT; (void)WoT; (void)PwT; (void)XN; (void)OB; (void)HG; (void)CGB; (void)QB_; (void)KB; (void)VB; (void)DGB; (void)UB; (void)YB; (void)Y2
    if (threadIdx.x < 128) ((LAS unsigned*)(L + LDSCTL_OFF))[threadIdx.x] = 0u;
    __syncthreads();
    XcdBarrier bar = xcd_barrier_post((unsigned*)(args.ws + WS_BAR), (volatile LAS unsigned*)(L + LDSCTL_OFF));
    if (args.ws == nullptr) grid.sync();

    {
        PHASE_PTRS(); FRESH_TID();
        LAS float* scr = (LAS float*)(L + wave * 16384);
        constexpr int I_IN = (DMODEL / 64) * (NIN / 32), I_O = (1024 / 64) * (1024 / 32), I_PW = (512 / 64) * (512 / 32);
        for (int it = gw; it < I_IN + I_O + I_PW; it += NGW) {
            int r = it;
            if (r < I_IN) { const int nblk = NIN / 32, kb = r / nblk, nb = r % nblk; p0_transpose_item(w_in, DMODEL, NIN, WinT, 64 * kb, 32 * nb, win_dst_row(32 * nb), scr, lane); continue; } r -= I_IN;
            if (r < I_O) { const int nblk = 1024 / 32, kb = r / nblk, nb = r % nblk; p0_transpose_item(w_out, 1024, 1024, WoT, 64 * kb, 32 * nb, 32 * nb, scr, lane); continue; } r -= I_O;
            { const int nblk = 512 / 32, kb = r / nblk, nb = r % nblk; p0_transpose_item(pw_w, 512, 512, PwT, 64 * kb, 32 * nb, 32 * nb, scr, lane); }
        }
        for (int i = bx * 512 + tid; i < M; i += G * 512) rowss[i] = 0.f;
        f32x4 gv[4];
#pragma unroll
        for (int j = 0; j < 4; ++j) gv[j] = *((const f32x4*)pre_g + lane + 64 * j);
        for (int m0 = gw; m0 < M; m0 += 4 * NGW) {
            f32x4 v[4][4]; float ss[4];
#pragma unroll
            for (int k = 0; k < 4; ++k) { const int m = m0 + k * NGW; const f32x4* xr = (const f32x4*)(x + (size_t)(m < M ? m : m0) * DMODEL) + lane;
#pragma unroll
                for (int j = 0; j < 4; ++j) v[k][j] = __builtin_nontemporal_load(xr + 64 * j); }
#pragma unroll
            for (int k = 0; k < 4; ++k) { ss[k] = 0.f;
#pragma unroll
                for (int j = 0; j < 4; ++j) ss[k] += (v[k][j].x * v[k][j].x + v[k][j].y * v[k][j].y) + (v[k][j].z * v[k][j].z + v[k][j].w * v[k][j].w); }
#pragma unroll
            for (int o = 1; o < 64; o <<= 1) {
#pragma unroll
                for (int k = 0; k < 4; ++k) ss[k] += __shfl_xor(ss[k], o); }
#pragma unroll
            for (int k = 0; k < 4; ++k) { const int m = m0 + k * NGW; if (m < M) { const float rstd = 1.f / sqrtf(ss[k] * (1.f / DMODEL) + 1e-6f);
                v2u* o8 = (v2u*)(XN + (size_t)m * DMODEL) + lane;
#pragma unroll
                for (int j = 0; j < 4; ++j) { const f32x4 y = v[k][j] * rstd * gv[j]; v2u o; o.x = pk2(y.x, y.y); o.y = pk2(y.z, y.w); o8[64 * j] = o; } } }
        }
    }
    xcd_barrier(bar);

    {
        PHASE_PTRS();
        pg8::Gemm g{XN, WinT, M, NIN, DMODEL}; pg8::StaticOrder S; S.init(M, NIN, G, bx);
        pg8::EpiIn E{HG, CGB, QB_, KB, VB, DGB, (unsigned*)(ws + WS_BAR) + NMG_WORD + 16 * gi};
        pg8::gemm_phase<pg8::EpiIn, pg8::StaticOrder, PG8_ALIGN, PG8_SP2>(L, g, S, E, wave);
    }
    GROUP_BAR();

    {
        PHASE_PTRS(); FRESH_TID();
        unsigned* ctlw = (unsigned*)(ws + WS_BAR); unsigned* nmx = ctlw + NMG_WORD + 16 * gi; unsigned* qg = ctlw + QG_WORD + 64 * gi;
        int Wt[8]; float sbmax = 0.f;
#pragma unroll
        for (int i = 0; i < 8; ++i) { const float qm = __uint_as_float(__hip_atomic_load(nmx + i, RLX_AGENT)), km = __uint_as_float(__hip_atomic_load(nmx + 8 + i, RLX_AGENT));
            const float Sb = 2.02f * sqrtf(qm * km);
            sbmax = fmaxf(sbmax, Sb);
            const float w = (2.f * Sb + 42.f) / (64.f * pg8::alibi_sl(i >> 1)); Wt[i] = w < 64.f ? (int)w + 1 : 64; }
        const unsigned qslot = LDSCTL_OFF + 64;
        const int NA = 128 * NB, convbase = (RPG / 32) * gi;
        if (sbmax <= 60.f) {
            int u = gj;
            while (u < NA) {
                const int b = gi * NB + (u >> 7), ul = u & 127; int qb, h, c;
                if (ul < 44) { qb = 15 - (ul >> 2); h = 2 + ((ul >> 1) & 1); c = ul & 1; }
                else if (ul < 76) { const int v = ul - 44; h = 1; qb = 15 - (v >> 1); c = v & 1; }
                else if (ul < 96) { const int v = ul - 76; qb = 4 - (v >> 2); h = 2 + ((v >> 1) & 1); c = v & 1; }
                else { const int v = ul - 96; h = 0; qb = 15 - (v >> 1); c = v & 1; }
                const int hc = 2 * h + c; int W = Wt[0];
#pragma unroll
                for (int i = 1; i < 8; ++i) W = (hc == i) ? Wt[i] : W;
                int T0 = 4 * qb - W; T0 = T0 > 0 ? (T0 & ~1) : 0;
                attn_body::attn_unit2(b, qb, (const attn_body::bf16*)(QB_ + h * 128 + c * 64), (const attn_body::bf16*)(KB + h * 128 + c * 64), (const attn_body::bf16*)(VB + h * 128),
                                      (attn_body::bf16*)(OB + h * 256 + c * 128), pg8::alibi_sl(h), pg8::alibi_c32(h), (char*)lds, wave, T0, qg, qslot);
                u = GS + (int)__builtin_amdgcn_readfirstlane(*(volatile LAS unsigned*)(L + qslot));
            }
            { const int ucur_ = convbase + (u - NA), qbase_ = convbase + GS - NA, uend_ = convbase + NA; PHASE_PTRS(); FRESH_TID();
              conv_phase_dyn(L, ucur_, (unsigned*)(ws + WS_BAR) + QG_WORD + 64 * gi, qbase_, uend_, HG, dw_w, dw_b, cln_g, cln_b, UB, tid, lane, wave); }
        } else {
        conv_phase(L, convbase + gj, GS, convbase + NA, HG, dw_w, dw_b, cln_g, cln_b, UB, tid, lane, wave);
        int u = gj;
        while (u < 2 * NA) {
            const int b = gi * NB + (u >> 8), r = u & 255, qb = 15 - (r >> 4), h = (r >> 2) & 3, c = (r >> 1) & 1, vh = r & 1;
            const int hc = 2 * h + c; int W = Wt[0];
#pragma unroll
            for (int i = 1; i < 8; ++i) W = (hc == i) ? Wt[i] : W;
            int T0 = 4 * qb - W; T0 = T0 > 0 ? (T0 & ~1) : 0;
            attn_body::attn_unit<8>(b, qb, (const attn_body::bf16*)(QB_ + h * 128 + c * 64), (const attn_body::bf16*)(KB + h * 128 + c * 64), (const attn_body::bf16*)(VB + h * 128 + vh * 64),
                                    (attn_body::bf16*)(OB + h * 256 + c * 128 + vh * 64), pg8::alibi_sl(h), pg8::alibi_c32(h), (char*)lds, wave, T0, qg, qslot);
            u = GS + (int)__builtin_amdgcn_readfirstlane(*(volatile LAS unsigned*)(L + qslot));
        }
        }
    }
    GROUP_BAR();

    {
        PHASE_PTRS();
        {
            pg8::Gemm g{UB, PwT, M, 512, 512}; pg8::StaticOrder S; S.init(M, 512, G, bx);
            pg8::EpiPw E{CGB, pw_b, YB};
            pg8::gemm_phase<pg8::EpiPw, pg8::StaticOrder, PG8_ALIGN, PG8_SP2>(L, g, S, E, wave);
        }
        FRESH_TID();
        const float lam = expf(wave_sum(lq1[lane] * lk1[lane])) - expf(wave_sum(lq2[lane] * lk2[lane])) + 0.2f;
        const int h = lane >> 4, ec = (lane & 15) * 8;
        float gs[8];
#pragma unroll
        for (int j = 0; j < 8; ++j) gs[j] = sub_g[ec + j] * 0.8f;
        for (int m0 = gwl; m0 < RPG; m0 += 4 * NGWL) {
            v4u a[4], bq[4], gt[4];
#pragma unroll
            for (int k = 0; k < 4; ++k) { const int ml = m0 + k * NGWL; const size_t m = (size_t)(RPG * gi + (ml < RPG ? ml : m0));
                a[k] = *(const v4u*)(OB + m * 1024 + h * 256 + ec); bq[k] = *(const v4u*)(OB + m * 1024 + h * 256 + 128 + ec); gt[k] = *(const v4u*)(DGB + m * 512 + h * 128 + ec); }
#pragma unroll
            for (int k = 0; k < 4; ++k) { const int ml = m0 + k * NGWL; if (ml >= RPG) continue; const int mm = RPG * gi + ml;
                const unsigned aw[4] = {a[k].x, a[k].y, a[k].z, a[k].w}, bw[4] = {bq[k].x, bq[k].y, bq[k].z, bq[k].w}, gw4[4] = {gt[k].x, gt[k].y, gt[k].z, gt[k].w};
                float o[8]; float ss = 0.f;
#pragma unroll
                for (int j = 0; j < 4; ++j) { o[2 * j] = pg8::bf_lo(aw[j]) - lam * pg8::bf_lo(bw[j]); o[2 * j + 1] = pg8::bf_hi(aw[j]) - lam * pg8::bf_hi(bw[j]); ss += o[2 * j] * o[2 * j] + o[2 * j + 1] * o[2 * j + 1]; }
                ss += __shfl_xor(ss, 1); ss += __shfl_xor(ss, 2); ss += __shfl_xor(ss, 4); ss += __shfl_xor(ss, 8);
                const float rstd = 1.f / sqrtf(ss * (1.f / 128.f) + 1e-6f);
                unsigned wv[4];
#pragma unroll
                for (int j = 0; j < 4; ++j) wv[j] = pk2(o[2 * j] * rstd * gs[2 * j] * pg8::bf_lo(gw4[j]), o[2 * j + 1] * rstd * gs[2 * j + 1] * pg8::bf_hi(gw4[j]));
                v4u w; w.x = wv[0]; w.y = wv[1]; w.z = wv[2]; w.w = wv[3];
                *(v4u*)(YB + (size_t)mm * 1024 + 512 + h * 128 + ec) = w; }
        }
    }
    GROUP_BAR();

    {
        PHASE_PTRS();
        pg8::Gemm g{YB, WoT, M, 1024, 1024}; pg8::StaticOrder S; S.init(M, 1024, G, bx);
        pg8::EpiOut E{Y2, rowss};
        pg8::gemm_phase<pg8::EpiOut, pg8::StaticOrder, PG8_ALIGN, PG8_SP2>(L, g, S, E, wave);
    }
    GROUP_BAR();

    {
        PHASE_PTRS(); FRESH_TID();
        f32x4 gv[4];
#pragma unroll
        for (int j = 0; j < 4; ++j) gv[j] = *((const f32x4*)post_g + lane + 64 * j);
        for (int m0 = gwl; m0 < RPG; m0 += 4 * NGWL) {
            f32x4 xv[4][4]; v2u yv[4][4]; float rs[4];
#pragma unroll
            for (int k = 0; k < 4; ++k) { const int ml = m0 + k * NGWL; const size_t m = (size_t)(RPG * gi + (ml < RPG ? ml : m0)); rs[k] = rowss[m];
                const f32x4* xr = (const f32x4*)(x + m * DMODEL) + lane; const v2u* yr = (const v2u*)(Y2 + m * 1024) + lane;
#pragma unroll
                for (int j = 0; j < 4; ++j) { xv[k][j] = __builtin_nontemporal_load(xr + 64 * j); yv[k][j] = yr[64 * j]; } }
#pragma unroll
            for (int k = 0; k < 4; ++k) { const int ml = m0 + k * NGWL; if (ml >= RPG) continue; const int mm = RPG * gi + ml;
                const float rstd = 1.f / sqrtf(rs[k] * (1.f / 1024.f) + 1e-6f); f32x4* orow = (f32x4*)(out + (size_t)mm * DMODEL) + lane;
#pragma unroll
                for (int j = 0; j < 4; ++j) { f32x4 o;
                    o.x = xv[k][j].x + pg8::bf_lo(yv[k][j].x) * rstd * gv[j].x; o.y = xv[k][j].y + pg8::bf_hi(yv[k][j].x) * rstd * gv[j].y; o.z = xv[k][j].z + pg8::bf_lo(yv[k][j].y) * rstd * gv[j].z; o.w = xv[k][j].w + pg8::bf_hi(yv[k][j].y) * rstd * gv[j].w;
                    __builtin_nontemporal_store(o, orow + 64 * j); } }
        }
    }
}

extern "C" void kernel_launch(void* const* d_in, const int* in_sizes, int n_in, void* d_out, int out_size, void* d_ws, size_t ws_size, hipStream_t stream) {
    static int grid = 0;
    if (grid == 0) {
        if (n_in != 16 || out_size != M * DMODEL || ws_size < WS_END) { fprintf(stderr, "kernel_launch: unexpected problem shape (n_in %d, out %d, ws %zu)\n", n_in, out_size, ws_size); grid = -1; return; }
        int dev = 0, cus = 0, per_cu = 0;
        hipGetDevice(&dev); hipDeviceGetAttribute(&cus, hipDeviceAttributeMultiprocessorCount, dev);
        hipFuncSetAttribute((const void*)fwd_megakernel, hipFuncAttributeMaxDynamicSharedMemorySize, LDS_BYTES);
        hipOccupancyMaxActiveBlocksPerMultiprocessor(&per_cu, (const void*)fwd_megakernel, NWAVES * 64, LDS_BYTES);
        if (per_cu < 1) { fprintf(stderr, "kernel_launch: occupancy query reports %d blocks per CU\n", per_cu); per_cu = 1; }
        (void)hipGetLastError();
        grid = cus;
    }
    if (grid < 0) return;
    (void)hipMemsetAsync((char*)d_ws + WS_BAR, 0, WS_BAR_BYTES, stream);
    Args a{};
    for (int i = 0; i < 16; ++i) a.in[i] = (const float*)d_in[i];
    a.out = (float*)d_out; a.ws = (unsigned char*)d_ws;
    void* kargs[] = {&a};
    hipError_t e = hipLaunchCooperativeKernel((const void*)fwd_megakernel, dim3(grid), dim3(NWAVES * 64), kargs, LDS_BYTES, stream);
    if (e != hipSuccess) fprintf(stderr, "cooperative launch failed: %s (grid %d)\n", hipGetErrorString(e), grid);
}
```

```cpp
#include <hip/hip_runtime.h>
#include <hip/hip_cooperative_groups.h>
#include <cstdio>
#include <cstdint>
namespace cg = cooperative_groups;
__device__ __forceinline__ int lane_id_asm() { int l; asm volatile("v_mbcnt_lo_u32_b32 %0, -1, 0\n\tv_mbcnt_hi_u32_b32 %0, -1, %0" : "=v"(l)); return l; }
namespace pg8 {
#define PG8_LAS __attribute__((address_space(3)))
typedef unsigned short bf16_t;
typedef short bf16x8 __attribute__((ext_vector_type(8)));
typedef float f32x4 __attribute__((ext_vector_type(4)));
typedef unsigned u32x4 __attribute__((ext_vector_type(4)));
constexpr int BM = 256, BK = 64, HALF = 128, HTB = HALF * BK * 2  , STAGE_BYTES = 8 * HTB, NXCD = 8, WGM = 8;

__host__ __device__ __forceinline__ int lds_byte(int r, int c) { const int st = (r >> 4) * 2 + (c >> 5), rr = r & 15, cc = c & 31, ob = rr * 64 + cc * 2; return st * 1024 + (ob ^ (((ob >> 9) & 1) << 5)); }
__host__ __device__ __forceinline__ void stage_rc(int b, int& R, int& C) { const int st = b / 1024, sb = b % 1024, swz = sb ^ (((sb >> 9) & 1) << 5); R = (st >> 1) * 16 + swz / 64; C = (st & 1) * 32 + (swz % 64) / 2; }
__host__ __device__ __forceinline__ int perm32(int rho) { const int n = rho >> 4, i = rho & 15; return 8 * (i >> 2) + 4 * n + (i & 3); }

struct Unit { int pm, pn; };
struct Gemm { const bf16_t* A; const bf16_t* Bt; int M, N, K; };

struct StaticOrder {
    int nM, nN, nwg, G, c;
    __host__ __device__ void init(int M, int N, int G_, int c_) { nM = M / BM; nN = N / BM; nwg = nM * nN; G = G_; c = c_; }
    __host__ __device__ bool next(int i, Unit& u) const {
        const long L = (long)i * G + c; if (L >= nwg) return false;
        int wgid = (int)L; { const int q = nwg / NXCD, r = nwg % NXCD, xcd = wgid % NXCD, off = wgid / NXCD; wgid = (xcd < r ? xcd * (q + 1) : r * (q + 1) + (xcd - r) * q) + off; }
        const int nig = WGM * nN, gid = wgid / nig, fm = gid * WGM, gsz = (nM - fm) < WGM ? (nM - fm) : WGM;
        u.pm = fm + ((wgid % nig) % gsz); u.pn = (wgid % nig) / gsz; return true;
    }
    __device__ __forceinline__ void a_ready(const Unit&) const {}
    __device__ __forceinline__ void done(const Unit&) const {}
};

__device__ __forceinline__ unsigned cvt_pk_bf16(float lo, float hi) { unsigned r; asm volatile("v_cvt_pk_bf16_f32 %0, %1, %2" : "=v"(r) : "v"(lo), "v"(hi)); return r; }

typedef float f32x2 __attribute__((ext_vector_type(2)));
__host__ __device__ __forceinline__ float alibi_c32(int h) { return h == 0 ? 2980.9579870417283f : h == 1 ? 7.38905609893065f : h == 2 ? 1.6487212707001282f : 1.1331484530668263f; }
__host__ __device__ __forceinline__ float alibi_sl(int h) { return h == 0 ? 0.36067376022224085f : h == 1 ? 0.09016844005556021f : h == 2 ? 0.022542110013890053f : 0.005635527503472513f; }
__device__ __forceinline__ float sigmoid_f(float v) { return __builtin_amdgcn_rcpf(1.0f + __builtin_amdgcn_exp2f(-1.4426950408889634f * v)); }
__device__ __forceinline__ float silu_f(float v) { return v * sigmoid_f(v); }
__device__ __forceinline__ float bf_lo(unsigned w) { return __uint_as_float(w << 16); }
__device__ __forceinline__ float bf_hi(unsigned w) { return __uint_as_float(w & 0xffff0000u); }
__device__ __forceinline__ u32x4 pack8(const f32x4 v0, const f32x4 v1) { u32x4 w; w.x = cvt_pk_bf16(v0[0], v0[1]); w.y = cvt_pk_bf16(v0[2], v0[3]); w.z = cvt_pk_bf16(v1[0], v1[1]); w.w = cvt_pk_bf16(v1[2], v1[3]); return w; }

struct EpiIn {
    static constexpr bool PERM = true, AFTER_DRAIN = false;
    bf16_t *Hg, *CG, *Q, *K, *V, *DG; unsigned* nmax;
    __device__ __forceinline__ void operator()(const f32x4 (&acc)[2][2][4][2], const Unit& u, int wr, int wc, int fr, int fq) const {
        const int row0 = u.pm * BM + wr * 64 + fr; const int pn = u.pn;
        if (pn < 4) {
            const int col = 128 * pn + wc * 32 + 8 * fq;
#pragma unroll
            for (int ai = 0; ai < 2; ++ai)
#pragma unroll
                for (int m = 0; m < 4; ++m) {
                    f32x4 h0, h1;
#pragma unroll
                    for (int j = 0; j < 4; ++j) { h0[j] = acc[ai][0][m][0][j] * sigmoid_f(acc[ai][1][m][0][j]); h1[j] = acc[ai][0][m][1][j] * sigmoid_f(acc[ai][1][m][1][j]); }
                    *(u32x4*)(Hg + (size_t)(row0 + ai * HALF + m * 16) * 512 + col) = pack8(h0, h1);
                }
        } else {
            const int role = (pn - 4) >> 1, colt = 256 * ((pn - 4) & 1) + wc * 32 + 8 * fq;
            bf16_t* base = role == 0 ? CG : role == 1 ? Q : role == 2 ? K : role == 3 ? V : DG;
            float mx[2] = {0.f, 0.f};
#pragma unroll
            for (int ai = 0; ai < 2; ++ai)
#pragma unroll
                for (int m = 0; m < 4; ++m)
#pragma unroll
                    for (int bj = 0; bj < 2; ++bj) {
                        f32x4 v0 = acc[ai][bj][m][0], v1 = acc[ai][bj][m][1];
                        if (role == 0 || role == 4) {
#pragma unroll
                            for (int j = 0; j < 4; ++j) { v0[j] = silu_f(v0[j]); v1[j] = silu_f(v1[j]); }
                        } else if (role == 1) { v0 = v0 * 0.18033688011112042f; v1 = v1 * 0.18033688011112042f; }
                        else if (role == 3) {
                            if (m >= 2) {
                                const int h = 2 * ((pn - 4) & 1) + bj;
                                const float c = alibi_c32(h);
                                v0 = v0 * c; v1 = v1 * c;
                            }
                        }
                        *(u32x4*)(base + (size_t)(row0 + ai * HALF + m * 16) * 512 + colt + bj * HALF) = pack8(v0, v1);
                        if (role == 1 || role == 2) { float ss = (v0[0] * v0[0] + v0[1] * v0[1]) + (v0[2] * v0[2] + v0[3] * v0[3]) + (v1[0] * v1[0] + v1[1] * v1[1]) + (v1[2] * v1[2] + v1[3] * v1[3]);
                            ss += __shfl_xor(ss, 16); ss += __shfl_xor(ss, 32); mx[bj] = fmaxf(mx[bj], ss); }
                    }
            if (role == 1 || role == 2) {
#pragma unroll
                for (int bj = 0; bj < 2; ++bj) { float v = mx[bj]; v = fmaxf(v, __shfl_xor(v, 1)); v = fmaxf(v, __shfl_xor(v, 2)); v = fmaxf(v, __shfl_xor(v, 4)); v = fmaxf(v, __shfl_xor(v, 8));
                    if (fr == 0 && fq == 0) atomicMax(nmax + (role - 1) * 8 + 4 * ((pn - 4) & 1) + 2 * bj + (wc >> 1), __float_as_uint(v)); }
            }
        }
    }
};
struct EpiPw {
    static constexpr bool PERM = true, AFTER_DRAIN = false;
    const bf16_t* CG; const float* bias; bf16_t* Y;
    __device__ __forceinline__ void operator()(const f32x4 (&acc)[2][2][4][2], const Unit& u, int wr, int wc, int fr, int fq) const {
        const int row0 = u.pm * BM + wr * 64 + fr; const int col0 = u.pn * BM + wc * 32 + 8 * fq;
        f32x4 bv[2][2];
#pragma unroll
        for (int bj = 0; bj < 2; ++bj)
#pragma unroll
            for (int n = 0; n < 2; ++n) bv[bj][n] = *(const f32x4*)(bias + col0 + bj * HALF + 4 * n);
#pragma unroll
        for (int ai = 0; ai < 2; ++ai)
#pragma unroll
            for (int m = 0; m < 4; ++m) { const size_t row = (size_t)(row0 + ai * HALF + m * 16);
#pragma unroll
                for (int bj = 0; bj < 2; ++bj) {
                    const u32x4 g = *(const u32x4*)(CG + row * 512 + col0 + bj * HALF);
                    f32x4 v0 = acc[ai][bj][m][0] + bv[bj][0], v1 = acc[ai][bj][m][1] + bv[bj][1];
                    v0[0] *= bf_lo(g.x); v0[1] *= bf_hi(g.x); v0[2] *= bf_lo(g.y); v0[3] *= bf_hi(g.y);
                    v1[0] *= bf_lo(g.z); v1[1] *= bf_hi(g.z); v1[2] *= bf_lo(g.w); v1[3] *= bf_hi(g.w);
                    *(u32x4*)(Y + row * 1024 + col0 + bj * HALF) = pack8(v0, v1);
                } }
    }
};
struct EpiOut {
    static constexpr bool PERM = true, AFTER_DRAIN = false;
    bf16_t* Y2; float* rowss;
    __device__ __forceinline__ void operator()(const f32x4 (&acc)[2][2][4][2], const Unit& u, int wr, int wc, int fr, int fq) const {
        const int row0 = u.pm * BM + wr * 64 + fr; const int col0 = u.pn * BM + wc * 32 + 8 * fq;
#pragma unroll
        for (int ai = 0; ai < 2; ++ai)
#pragma unroll
            for (int m = 0; m < 4; ++m) { const size_t row = (size_t)(row0 + ai * HALF + m * 16); float ss = 0.f;
#pragma unroll
                for (int bj = 0; bj < 2; ++bj) {
                    const f32x4 v0 = acc[ai][bj][m][0], v1 = acc[ai][bj][m][1];
                    ss += (v0[0] * v0[0] + v0[1] * v0[1]) + (v0[2] * v0[2] + v0[3] * v0[3]) + (v1[0] * v1[0] + v1[1] * v1[1]) + (v1[2] * v1[2] + v1[3] * v1[3]);
                    *(u32x4*)(Y2 + row * 1024 + col0 + bj * HALF) = pack8(v0, v1);
                }
                ss += __shfl_xor(ss, 16); ss += __shfl_xor(ss, 32);
                if (fq == 0) atomicAdd(rowss + row, ss);
            }
    }
};


template <class Epi, class Sched, bool ALIGN_EPI = false, bool SP2 = false>
__device__ __forceinline__ void gemm_phase(PG8_LAS unsigned char* lds, const Gemm g, const Sched& S, const Epi& E, int wid_in) {
    const int lane = lane_id_asm();
    int wid_o = wid_in; asm volatile("" : "+s"(wid_o)); const int wid = wid_o, tid = wid * 64 + lane, wr = wid >> 2, wc = wid & 3, fr = lane & 15, fq = lane >> 4;
    const int K = g.K, nt = K / BK;
    unsigned voffA[2], voffB[2];
#pragma unroll
    for (int i = 0; i < 2; ++i) { int R, C; stage_rc(tid * 16 + i * 8192, R, C); const int Rb = Epi::PERM ? ((R & ~31) + perm32(R & 31)) : R;
        voffA[i] = (unsigned)(R * K + C) * 2u; voffB[i] = (unsigned)(Rb * K + C) * 2u; }
    const size_t kstep = (size_t)(BK * 2);
    const size_t hstep = (size_t)HALF * K * 2;
    const size_t tstep = 2 * hstep;
    const unsigned ldsw = (unsigned)wid * 1024u;
    const int aoff = lds_byte(wr * 64 + fr, fq * 8), boff = lds_byte(wc * 32 + fr, fq * 8);
#define PG8_SA(b, h) (((b) * 2 + (h)) * HTB)
#define PG8_SB(b, h) ((4 + (b) * 2 + (h)) * HTB)
#define PG8_STAGE(bufoff, gbase, voff) do { _Pragma("unroll") for (int _i = 0; _i < 2; ++_i) \
        __builtin_amdgcn_global_load_lds((const unsigned*)((const char*)(gbase) + (voff)[_i]), (PG8_LAS unsigned*)(lds + (bufoff) + ldsw + _i * 8192), 16, 0, 0); } while (0)
#define PG8_LDA(dst, b, h) do { _Pragma("unroll") for (int m = 0; m < 4; ++m) _Pragma("unroll") for (int k = 0; k < 2; ++k) dst[m][k] = *(const PG8_LAS bf16x8*)(lds + PG8_SA(b, h) + aoff + m * 2048 + k * 1024); } while (0)
#define PG8_LDB(dst, b, h) do { _Pragma("unroll") for (int n = 0; n < 2; ++n) _Pragma("unroll") for (int k = 0; k < 2; ++k) dst[n][k] = *(const PG8_LAS bf16x8*)(lds + PG8_SB(b, h) + boff + n * 2048 + k * 1024); } while (0)
#define PG8_MMA(ai, bj, At, Bt) do { __builtin_amdgcn_s_setprio(1); _Pragma("unroll") for (int m = 0; m < 4; ++m) _Pragma("unroll") for (int n = 0; n < 2; ++n) _Pragma("unroll") for (int k = 0; k < 2; ++k) \
        acc[ai][bj][m][n] = __builtin_amdgcn_mfma_f32_16x16x32_bf16(Bt[n][k], At[m][k], acc[ai][bj][m][n], 0, 0, 0); __builtin_amdgcn_s_setprio(0); } while (0)
#define PG8_WAIT_V(n) asm volatile("s_waitcnt vmcnt(" #n ")" ::: "memory")
#define PG8_WAIT_L(n) asm volatile("s_waitcnt lgkmcnt(" #n ")" ::: "memory")
#define PG8_BAR __builtin_amdgcn_s_barrier()
#define PG8_SCHED __builtin_amdgcn_sched_barrier(0)
    Unit cur, nxt; int ui = 0;
    if (!S.next(0, cur)) return;
    f32x4 acc[2][2][4][2];
#pragma unroll
    for (int a = 0; a < 2; ++a)
#pragma unroll
        for (int b = 0; b < 2; ++b)
#pragma unroll
            for (int m = 0; m < 4; ++m)
#pragma unroll
                for (int n = 0; n < 2; ++n) acc[a][b][m][n] = (f32x4){0.f, 0.f, 0.f, 0.f};
    bf16x8 At[4][2], B0[2][2], B1[2][2];
    const char* cA = (const char*)g.A + (size_t)cur.pm * tstep; const char* cB = (const char*)g.Bt + (size_t)cur.pn * tstep;
    S.a_ready(cur);
    if constexpr (SP2) {
        PG8_STAGE(PG8_SB(0, 0), cB, voffB); PG8_STAGE(PG8_SB(0, 1), cB + hstep, voffB); PG8_STAGE(PG8_SA(0, 0), cA, voffA); PG8_STAGE(PG8_SA(0, 1), cA + hstep, voffA);
        if (wr == 1) PG8_BAR;
        PG8_WAIT_V(2); PG8_BAR;
        PG8_STAGE(PG8_SB(1, 0), cB + kstep, voffB); PG8_STAGE(PG8_SA(1, 0), cA + kstep, voffA); PG8_STAGE(PG8_SB(1, 1), cB + hstep + kstep, voffB);
        PG8_WAIT_V(6); PG8_BAR;
    } else {
        PG8_STAGE(PG8_SB(0, 0), cB, voffB); PG8_STAGE(PG8_SA(0, 0), cA, voffA); PG8_STAGE(PG8_SB(0, 1), cB + hstep, voffB); PG8_STAGE(PG8_SA(0, 1), cA + hstep, voffA);
        if (wr == 1) PG8_BAR;
        PG8_WAIT_V(4); PG8_BAR;
        PG8_STAGE(PG8_SB(1, 0), cB + kstep, voffB); PG8_STAGE(PG8_SA(1, 0), cA + kstep, voffA); PG8_STAGE(PG8_SB(1, 1), cB + hstep + kstep, voffB);
        PG8_WAIT_V(6); PG8_BAR;
    }
    for (;;) {
        const bool has_next = S.next(ui + 1, nxt);
        const char* nA = has_next ? (const char*)g.A + (size_t)nxt.pm * tstep : cA; const char* nB = has_next ? (const char*)g.Bt + (size_t)nxt.pn * tstep : cB;
        for (int t = 0; t < nt; t += 2) {
            const bool last = (t == nt - 2);
            const char* a1 = cA + (size_t)(t + 1) * kstep;
            const char* a2 = last ? nA : cA + (size_t)(t + 2) * kstep; const char* b2 = last ? nB : cB + (size_t)(t + 2) * kstep;
            const char* a3 = a2 + kstep; const char* b3 = b2 + kstep;
            if (last && has_next) S.a_ready(nxt);
            if constexpr (SP2) {
            PG8_LDB(B0, 0, 0); PG8_LDB(B1, 0, 1); PG8_SCHED; PG8_LDA(At, 0, 0); PG8_STAGE(PG8_SA(1, 1), a1 + hstep, voffA);
            PG8_WAIT_V(8); PG8_WAIT_L(0); PG8_BAR; PG8_MMA(0, 0, At, B0); PG8_MMA(0, 1, At, B1); PG8_BAR; PG8_SCHED;
            PG8_LDA(At, 0, 1); PG8_STAGE(PG8_SB(0, 0), b2, voffB); PG8_STAGE(PG8_SB(0, 1), b2 + hstep, voffB); PG8_STAGE(PG8_SA(0, 0), a2, voffA);
            PG8_WAIT_V(8); PG8_WAIT_L(0); PG8_BAR; PG8_MMA(1, 0, At, B0); PG8_MMA(1, 1, At, B1); PG8_BAR; PG8_SCHED;
            PG8_LDB(B0, 1, 0); PG8_LDB(B1, 1, 1); PG8_SCHED; PG8_LDA(At, 1, 0); PG8_STAGE(PG8_SA(0, 1), a2 + hstep, voffA);
            PG8_WAIT_V(8); PG8_WAIT_L(0); PG8_BAR; PG8_MMA(0, 0, At, B0); PG8_MMA(0, 1, At, B1); PG8_BAR; PG8_SCHED;
            PG8_LDA(At, 1, 1); PG8_STAGE(PG8_SB(1, 0), b3, voffB); PG8_STAGE(PG8_SB(1, 1), b3 + hstep, voffB); PG8_STAGE(PG8_SA(1, 0), a3, voffA);
            PG8_WAIT_V(8); PG8_WAIT_L(0); PG8_BAR; PG8_MMA(1, 0, At, B0); PG8_MMA(1, 1, At, B1); PG8_BAR; PG8_SCHED;
            } else {
            PG8_LDB(B0, 0, 0); PG8_SCHED; PG8_LDA(At, 0, 0); PG8_STAGE(PG8_SA(1, 1), a1 + hstep, voffA);
            PG8_WAIT_L(8); PG8_BAR; PG8_WAIT_L(0); PG8_MMA(0, 0, At, B0); PG8_BAR; PG8_SCHED;
            PG8_LDB(B1, 0, 1); PG8_STAGE(PG8_SB(0, 0), b2, voffB);
            PG8_BAR; PG8_WAIT_L(0); PG8_MMA(0, 1, At, B1); PG8_BAR;
            PG8_LDA(At, 0, 1); PG8_STAGE(PG8_SA(0, 0), a2, voffA);
            PG8_BAR; PG8_WAIT_L(0); PG8_MMA(1, 0, At, B0); PG8_BAR; PG8_SCHED;
            PG8_STAGE(PG8_SB(0, 1), b2 + hstep, voffB);
            PG8_WAIT_V(6); PG8_BAR; PG8_MMA(1, 1, At, B1); PG8_BAR;
            PG8_LDB(B0, 1, 0); PG8_SCHED; PG8_LDA(At, 1, 0); PG8_STAGE(PG8_SA(0, 1), a2 + hstep, voffA);
            PG8_WAIT_L(8); PG8_BAR; PG8_WAIT_L(0); PG8_MMA(0, 0, At, B0); PG8_BAR; PG8_SCHED;
            PG8_LDB(B1, 1, 1); PG8_STAGE(PG8_SB(1, 0), b3, voffB);
            PG8_BAR; PG8_WAIT_L(0); PG8_MMA(0, 1, At, B1); PG8_BAR;
            PG8_LDA(At, 1, 1); PG8_STAGE(PG8_SA(1, 0), a3, voffA);
            PG8_BAR; PG8_WAIT_L(0); PG8_MMA(1, 0, At, B0); PG8_BAR; PG8_SCHED;
            PG8_STAGE(PG8_SB(1, 1), b3 + hstep, voffB);
            PG8_WAIT_V(6); PG8_BAR; PG8_MMA(1, 1, At, B1); PG8_BAR;
            }
        }
        if constexpr (ALIGN_EPI) { if (wr == 0) PG8_BAR; }
        if constexpr (!Epi::AFTER_DRAIN) { E(acc, cur, wr, wc, fr, fq); S.done(cur); }
        if (!has_next) break;
#pragma unroll
        for (int a = 0; a < 2; ++a)
#pragma unroll
            for (int b = 0; b < 2; ++b)
#pragma unroll
                for (int m = 0; m < 4; ++m)
#pragma unroll
                    for (int n = 0; n < 2; ++n) acc[a][b][m][n] = (f32x4){0.f, 0.f, 0.f, 0.f};
        cur = nxt; cA = nA; cB = nB; ++ui;
        if constexpr (ALIGN_EPI) { if (wr == 1) PG8_BAR; }
    }
    PG8_WAIT_V(0);
    if constexpr (!ALIGN_EPI) { if (wr == 0) PG8_BAR; }
    PG8_BAR;
    if constexpr (Epi::AFTER_DRAIN) { E.fused(acc, cur, wr, wc, fr, fq, lds, wid, lane); S.done(cur); }
#undef PG8_SA
#undef PG8_SB
#undef PG8_STAGE
#undef PG8_LDA
#undef PG8_LDB
#undef PG8_MMA
#undef PG8_WAIT_V
#undef PG8_WAIT_L
#undef PG8_BAR
#undef PG8_SCHED
}
}

#ifndef PG8_SP2
#define PG8_SP2 true
#endif
#ifndef PG8_ALIGN
#define PG8_ALIGN true
#endif
#include <hip/hip_bf16.h>
#include <cmath>
namespace attn_body {
using bf16=__hip_bfloat16;
using bf16x8=__attribute__((ext_vector_type(8)))short;
using s16x4=__attribute__((ext_vector_type(4)))short;
using f32x16=__attribute__((ext_vector_type(16)))float;
using u32x4=__attribute__((ext_vector_type(4)))unsigned;
constexpr int BATCH=8,SEQ=4096,D=64;
constexpr int QP=512,KP=512,VP=512,OP=1024;
constexpr int NW=8,QBLK=32,QB=QBLK*NW,KVBLK=64,NQB=SEQ/QB;
constexpr int ATTN_UNIT_ROWS=QB;
__device__ __forceinline__ int crow(int r,int hi){return (r&3)+8*(r>>2)+4*hi;}
#define SBAR() __builtin_amdgcn_sched_barrier(0)
__device__ __forceinline__ void cmask(f32x16&p0,f32x16&p1,int jb,int qrel,int hi){
  const float NEG=-INFINITY; int kb=64*jb+4*hi;
  #pragma unroll
  for(int r=0;r<16;++r){int kv=kb+(r&3)+8*(r>>2); if(kv>qrel)p0[r]=NEG; if(kv+32>qrel)p1[r]=NEG;}
}

constexpr int NSLOT=3, SLOTB=8192;
constexpr int LDS_K=0, LDS_V=NSLOT*SLOTB, LDS_WS=2*NSLOT*SLOTB, LDS_OST=LDS_WS+NW*64*4, LDS_BYTES=LDS_OST+NW*4096;
constexpr float C2=0.125f*1.4426950408889634f;
__device__ __forceinline__ void glds16(const void*sbase,unsigned voff,unsigned lds_dst){unsigned keep;
  asm volatile("s_mov_b32 %0, m0\n\ts_mov_b32 m0, %2\n\ts_nop 0\n\tglobal_load_lds_dwordx4 %1, %3\n\ts_mov_b32 m0, %0":"=&s"(keep):"v"(voff),"s"(lds_dst),"s"(sbase):"memory");}
__device__ __forceinline__ float max3f(float a,float b,float c){float r;asm("v_max3_f32 %0, %1, %2, %3":"=v"(r):"v"(a),"v"(b),"v"(c));return r;}
__device__ __forceinline__ float max2f(float a,float b){float r;asm("v_max_f32_e32 %0, %1, %2":"=v"(r):"v"(a),"v"(b));return r;}
__device__ __forceinline__ float fadd_s(float a,float b){float r;asm("v_add_f32_e32 %0, %1, %2":"=v"(r):"v"(a),"v"(b));return r;}
__device__ __forceinline__ float fsub_s(float a,float b){float r;asm("v_sub_f32_e32 %0, %1, %2":"=v"(r):"v"(a),"v"(b));return r;}
typedef float f32x2_t __attribute__((ext_vector_type(2))); typedef __bf16 bf16x2_t __attribute__((ext_vector_type(2)));
__device__ __forceinline__ unsigned cvtpk_s(float lo,float hi){f32x2_t v={lo,hi};bf16x2_t b=__builtin_convertvector(v,bf16x2_t);return __builtin_bit_cast(unsigned,b);}
#define WAIT_BAR(N) asm volatile("s_waitcnt vmcnt(" #N ") lgkmcnt(0)\n\ts_barrier":::"memory")

__device__ __forceinline__ void qkt(f32x16&p0,f32x16&p1,const char*Kslot,const bf16x8*qr,const f32x16&negm,int r32,int hi){
  const char*kb=Kslot+hi*1024+r32*16;
  #pragma unroll
  for(int d0=0;d0<4;++d0){
    const bf16x8 b0=*reinterpret_cast<const bf16x8*>(kb+d0*2048);
    const bf16x8 b1=*reinterpret_cast<const bf16x8*>(kb+d0*2048+512);
    if(d0==0){p0=__builtin_amdgcn_mfma_f32_32x32x16_bf16(b0,qr[0],negm,0,0,0);p1=__builtin_amdgcn_mfma_f32_32x32x16_bf16(b1,qr[0],negm,0,0,0);}
    else{p0=__builtin_amdgcn_mfma_f32_32x32x16_bf16(b0,qr[d0],p0,0,0,0);p1=__builtin_amdgcn_mfma_f32_32x32x16_bf16(b1,qr[d0],p1,0,0,0);}}
}
typedef __attribute__((address_space(3))) const char* lds_cptr;
typedef short v4i16_t __attribute__((ext_vector_type(4)));
__device__ __forceinline__ void kload8(bf16x8*kf,lds_cptr kp){
  kf[0]=*(const __attribute__((address_space(3))) bf16x8*)(kp);      kf[1]=*(const __attribute__((address_space(3))) bf16x8*)(kp+512);
  kf[2]=*(const __attribute__((address_space(3))) bf16x8*)(kp+2048); kf[3]=*(const __attribute__((address_space(3))) bf16x8*)(kp+2560);
  kf[4]=*(const __attribute__((address_space(3))) bf16x8*)(kp+4096); kf[5]=*(const __attribute__((address_space(3))) bf16x8*)(kp+4608);
  kf[6]=*(const __attribute__((address_space(3))) bf16x8*)(kp+6144); kf[7]=*(const __attribute__((address_space(3))) bf16x8*)(kp+6656);
}
__device__ __forceinline__ void kload2(bf16x8*kf,lds_cptr kp,int j){ kf[2*j]=*(const __attribute__((address_space(3))) bf16x8*)(kp+j*2048); kf[2*j+1]=*(const __attribute__((address_space(3))) bf16x8*)(kp+j*2048+512); }
__device__ __forceinline__ s16x4 vtr(lds_cptr p){ return __builtin_bit_cast(s16x4,__builtin_amdgcn_ds_read_tr16_b64_v4i16((__attribute__((address_space(3))) v4i16_t*)p)); }
__device__ __forceinline__ float rowmax(const f32x16&p0,const f32x16&p1){
  float a=max3f(p0[0],p0[1],p1[0]),b=max3f(p0[2],p0[3],p1[1]);a=max3f(a,p1[2],p1[3]);
  #pragma unroll
  for(int r=4;r<16;r+=4){a=max3f(a,p0[r],p0[r+1]);b=max3f(b,p0[r+2],p0[r+3]);a=max3f(a,p1[r],p1[r+1]);b=max3f(b,p1[r+2],p1[r+3]);}
  const float m=max2f(a,b);
  auto rr=__builtin_amdgcn_permlane32_swap(__float_as_uint(m),__float_as_uint(m),false,false);
  return max2f(__uint_as_float(rr[0]),__uint_as_float(rr[1]));
}
__device__ __forceinline__ void pv(f32x16*o,int vb,bf16x8 pa0,bf16x8 pa1,bf16x8 pa2,bf16x8 pa3){
  #pragma unroll
  for(int d0=0;d0<2;++d0){s16x4 lo[4],hi[4];
    #pragma unroll
    for(int ks=0;ks<4;++ks){
      asm volatile("ds_read_b64_tr_b16 %0,%1 offset:%c2":"=&v"(lo[ks]):"v"(vb),"i"(d0*4096+ks*1024):"memory");
      asm volatile("ds_read_b64_tr_b16 %0,%1 offset:%c2":"=&v"(hi[ks]):"v"(vb),"i"(d0*4096+ks*1024+512):"memory");}
    asm volatile("s_waitcnt lgkmcnt(0)":::"memory");SBAR();
    #define PK(k) (bf16x8){lo[k][0],lo[k][1],lo[k][2],lo[k][3],hi[k][0],hi[k][1],hi[k][2],hi[k][3]}
    o[d0]=__builtin_amdgcn_mfma_f32_32x32x16_bf16(pa0,PK(0),o[d0],0,0,0);
    o[d0]=__builtin_amdgcn_mfma_f32_32x32x16_bf16(pa1,PK(1),o[d0],0,0,0);
    o[d0]=__builtin_amdgcn_mfma_f32_32x32x16_bf16(pa2,PK(2),o[d0],0,0,0);
    o[d0]=__builtin_amdgcn_mfma_f32_32x32x16_bf16(pa3,PK(3),o[d0],0,0,0);
    #undef PK
  }
}

#ifndef ATTN_STORE16
#define ATTN_STORE16(p,v) (*(u32x4*)(p)=(v))
#endif
template<int THRL> __device__ __forceinline__ void attn_unit(int b,int qb,const bf16*Qh,const bf16*__restrict__ Kh0,const bf16*__restrict__ Vh0,bf16*Oh,float sl,float c32,char*shm,int wid_in,int T0,unsigned*qctr,unsigned qslot){
  const int lane=lane_id_asm(),r32=lane&31,hi=lane>>5; int wid=wid_in; asm volatile("":"+s"(wid));
  const long rowbase=(long)b*SEQ; const int q0=qb*QB;
  const bf16*Qw=Qh+(rowbase+q0+wid*QBLK)*QP;
  const bf16*Kh=Kh0+(rowbase+(long)T0*KVBLK)*KP,*Vh=Vh0+(rowbase+(long)T0*KVBLK)*VP;
  const unsigned lds0=(unsigned)(uintptr_t)shm;
  float*wsf=(float*)(shm+LDS_WS)+wid*64;
  const unsigned koff=(unsigned)(lane*KP+wid*8)*2u;
  const unsigned voff=(unsigned)((16*(wid&3)+(lane>>2))*VP+(wid>>2)*32+(lane&3)*8)*2u;
  const unsigned kdst=lds0+LDS_K+wid*1024, vdst=lds0+LDS_V+wid*1024;
  #define DMA_K(t,slot) glds16(Kh+(long)(t)*KVBLK*KP,koff,(unsigned)__builtin_amdgcn_readfirstlane(kdst+(slot)))
  #define DMA_V(t,slot) glds16(Vh+(long)(t)*KVBLK*VP,voff,(unsigned)__builtin_amdgcn_readfirstlane(vdst+(slot)))
  const char*Kbase=shm+LDS_K; bf16x8 kf[8];
  const lds_cptr shm3=(lds_cptr)shm; const lds_cptr kp0=shm3+LDS_K+hi*1024+r32*16; const lds_cptr vp0=shm3+LDS_V+((lane>>4)&1)*32+(lane&3)*8+(4*hi+((lane&15)>>2))*64;
  const int NT=(q0+QB)/KVBLK-T0;
  DMA_K(0,0);DMA_V(0,0);DMA_K(1,SLOTB);
  bf16x8 qr[4];
  #pragma unroll
  for(int d0=0;d0<4;++d0)qr[d0]=*reinterpret_cast<const bf16x8*>(&Qw[(long)r32*QP+d0*16+hi*8]);
  float l_reg=0.f;f32x16 o[2];o[0]=f32x16{};o[1]=f32x16{};f32x16 negm;
  { float hb_=sl*(float)(4*hi); asm volatile("":"+v"(hb_));
    _Pragma("unroll") for(int r=0;r<16;++r)negm[r]=hb_+sl*(float)((r&3)+8*(r>>2)); }
  asm volatile("":"+v"(negm)); const float sl64=64.f*sl;
  const int qrel=wid*QBLK+r32;
  #define CMASK(P0,P1,t) do{int jb_=(t)-(NT-4); if(jb_>=0)cmask(P0,P1,jb_,qrel,hi);}while(0)
  bool resc=false;
  #define START(P0,P1) do{ const float rm=rowmax(P0,P1); resc=false; \
    { const float dl=rm; \
      _Pragma("unroll") for(int r=0;r<16;++r){P0[r]=fsub_s(P0[r],dl);P1[r]=fsub_s(P1[r],dl);} \
      _Pragma("unroll") for(int r=0;r<16;++r)negm[r]-=dl; asm volatile("":"+v"(negm)); } \
    _Pragma("unroll") for(int r=0;r<16;++r)P0[r]=__builtin_amdgcn_exp2f(P0[r]); }while(0)
  #define RESC() do{ if(resc){ asm volatile("s_waitcnt lgkmcnt(0)":::"memory"); \
      _Pragma("unroll") for(int d_=0;d_<2;++d_) _Pragma("unroll") for(int r=0;r<16;++r)o[d_][r]*=wsf[crow(r,hi)]; } }while(0)
  f32x16 pA0,pA1,pB0,pB1;
  int sl_prev=0,sl_cur=0,sl_next=SLOTB;
  #define ROT() do{sl_prev=sl_cur;sl_cur=sl_next;sl_next=(sl_next==(NSLOT-1)*SLOTB)?0:sl_next+SLOTB;}while(0)
  DMA_K(2,2*SLOTB);
  unsigned nxt_=0u; if(wid==0&&lane==0)nxt_=__hip_atomic_fetch_add(qctr,1u,__ATOMIC_RELAXED,__HIP_MEMORY_SCOPE_AGENT);
  WAIT_BAR(3);
  qkt(pA0,pA1,Kbase,qr,negm,r32,hi);asm volatile("s_nop 15\n\ts_nop 7":"+v"(pA0),"+v"(pA1));CMASK(pA0,pA1,0);
  START(pA0,pA1);
  _Pragma("unroll") for(int r=0;r<16;++r)pA1[r]=__builtin_amdgcn_exp2f(pA1[r]);
  WAIT_BAR(0);
  if(wid==0&&lane==0)*(volatile __attribute__((address_space(3))) unsigned*)(shm3+qslot)=nxt_;
  DMA_K(3,0);DMA_V(1,SLOTB);
  ROT();
  kload8(kf,kp0+sl_cur);
  WAIT_BAR(2);
  s16x4 vlo[8],vhi[8]; u32x4 pw0,pw1,pw2,pw3;
  #define PKW(P,B) cvtpk_s(P[B],P[B+1])
  #define PAF(k) __builtin_bit_cast(bf16x8,pw##k)
  #define VFR(i) (bf16x8){vlo[i][0],vlo[i][1],vlo[i][2],vlo[i][3],vhi[i][0],vhi[i][1],vhi[i][2],vhi[i][3]}
  #define PIN(x) asm volatile("":"+v"(x))
  #define MX3(a,b,c) __builtin_fmaxf(__builtin_fmaxf((a),(b)),(c))
  #define GAPA(MF,SA,A0,A1,A2,A3,W0,W1,PW) do{ MF; SA+=A0; SA+=A1; SA+=A2; SA+=A3; PIN(SA); W0; W1; PIN(PW); SBAR(); }while(0)
  #define GAPA2(MF,A0,A1,B0_,B1_,W0,W1,PW) do{ MF; sacc+=A0; sacc+=A1; saccb=B0_+B1_; PIN(sacc); PIN(saccb); W0; W1; PIN(PW); SBAR(); }while(0)
  #define EX(v) __builtin_amdgcn_exp2f(v)
  #define GAPB(MF,X,B) do{ MF; X[B]=EX(X[B]); X[B+1]=EX(X[B+1]); X[B+2]=EX(X[B+2]); X[B+3]=EX(X[B+3]); PIN(X); SBAR(); }while(0)
  #define VRD(i) do{ vlo[i]=vtr(vp_+(((i)>>2)*4096+((i)&3)*1024)); vhi[i]=vtr(vp_+(((i)>>2)*4096+((i)&3)*1024+512)); }while(0)
  #define KRD(G,j) do{ if(G){ kload2(kf,kp0+sl_next,j); SBAR(); } }while(0)
  #define STEP(C0,C1,P0,P1,t,GK,GV,GL) do{ SBAR(); \
    _Pragma("unroll") for(int r=0;r<16;++r)negm[r]+=sl64; asm volatile("":"+v"(negm)); SBAR(); \
    const lds_cptr vp_=vp0+sl_prev; \
    VRD(0); SBAR(); float sacc=(P0[0]+P0[1]); float saccb; \
    GAPA(C0=__builtin_amdgcn_mfma_f32_32x32x16_bf16(kf[0],qr[0],negm,0,0,0), sacc, P0[2],P0[3],P0[4],P0[5],     pw0[0]=PKW(P0,0), pw0[1]=PKW(P0,2), pw0); \
    VRD(4); SBAR(); GAPA(C1=__builtin_amdgcn_mfma_f32_32x32x16_bf16(kf[1],qr[0],negm,0,0,0), sacc, P0[6],P0[7],P0[8],P0[9],     pw0[2]=PKW(P0,4), pw0[3]=PKW(P0,6), pw0); \
    VRD(1); SBAR(); GAPA(C0=__builtin_amdgcn_mfma_f32_32x32x16_bf16(kf[2],qr[1],C0,0,0,0),   sacc, P0[10],P0[11],P0[12],P0[13], pw1[0]=PKW(P0,8), pw1[1]=PKW(P0,10), pw1); \
    VRD(5); SBAR(); GAPA2(C1=__builtin_amdgcn_mfma_f32_32x32x16_bf16(kf[3],qr[1],C1,0,0,0),   P0[14],P0[15],P1[0],P1[1],   pw1[2]=PKW(P0,12),pw1[3]=PKW(P0,14), pw1); \
    VRD(2); SBAR(); GAPA(C0=__builtin_amdgcn_mfma_f32_32x32x16_bf16(kf[4],qr[2],C0,0,0,0),   saccb, P1[2],P1[3],P1[4],P1[5],     pw2[0]=PKW(P1,0), pw2[1]=PKW(P1,2), pw2); \
    VRD(6); SBAR(); GAPA(C1=__builtin_amdgcn_mfma_f32_32x32x16_bf16(kf[5],qr[2],C1,0,0,0),   saccb, P1[6],P1[7],P1[8],P1[9],     pw2[2]=PKW(P1,4), pw2[3]=PKW(P1,6), pw2); \
    VRD(3); SBAR(); GAPA(C0=__builtin_amdgcn_mfma_f32_32x32x16_bf16(kf[6],qr[3],C0,0,0,0),   saccb, P1[10],P1[11],P1[12],P1[13], pw3[0]=PKW(P1,8), pw3[1]=PKW(P1,10), pw3); \
    VRD(7); SBAR(); GAPA(C1=__builtin_amdgcn_mfma_f32_32x32x16_bf16(kf[7],qr[3],C1,0,0,0),   saccb, P1[14],P1[15],0.f,0.f,       pw3[2]=PKW(P1,12),pw3[3]=PKW(P1,14), pw3); \
    l_reg+=sacc+c32*saccb; \
    if(GK){DMA_K((t)+3,sl_cur);} if(GV){DMA_V((t)+1,sl_next);} \
    CMASK(C0,C1,t); \
    { float a=MX3(C0[0],C0[1],C1[0]),b=MX3(C0[2],C0[3],C1[1]); a=MX3(a,C1[2],C1[3]); \
      _Pragma("unroll") for(int r=4;r<16;r+=4){a=MX3(a,C0[r],C0[r+1]);b=MX3(b,C0[r+2],C0[r+3]);a=MX3(a,C1[r],C1[r+1]);b=MX3(b,C1[r+2],C1[r+3]);} \
      float rm=__builtin_fmaxf(a,b); { auto rr=__builtin_amdgcn_permlane32_swap(__float_as_uint(rm),__float_as_uint(rm),false,false); rm=__builtin_fmaxf(__uint_as_float(rr[0]),__uint_as_float(rr[1])); } \
      resc=false; \
      if(__builtin_expect(__any(rm>(float)THRL),0)){ const float dl=__builtin_fmaxf(rm,0.f); \
        _Pragma("unroll") for(int r=0;r<16;++r){C0[r]-=dl;C1[r]-=dl;} \
        _Pragma("unroll") for(int r=0;r<16;++r)negm[r]-=dl; asm volatile("":"+v"(negm)); \
        const float f=__builtin_amdgcn_exp2f(-dl); l_reg*=f; if(hi==0)wsf[r32]=f; resc=true; } } \
    SBAR(); \
    GAPB(o[0]=__builtin_amdgcn_mfma_f32_32x32x16_bf16(PAF(0),VFR(0),o[0],0,0,0), C0,0); \
    GAPB(o[1]=__builtin_amdgcn_mfma_f32_32x32x16_bf16(PAF(0),VFR(4),o[1],0,0,0), C0,4); \
    KRD(GL,0); GAPB(o[0]=__builtin_amdgcn_mfma_f32_32x32x16_bf16(PAF(1),VFR(1),o[0],0,0,0), C0,8); \
    KRD(GL,1); GAPB(o[1]=__builtin_amdgcn_mfma_f32_32x32x16_bf16(PAF(1),VFR(5),o[1],0,0,0), C0,12); \
    KRD(GL,2); GAPB(o[0]=__builtin_amdgcn_mfma_f32_32x32x16_bf16(PAF(2),VFR(2),o[0],0,0,0), C1,0); \
    KRD(GL,3); GAPB(o[1]=__builtin_amdgcn_mfma_f32_32x32x16_bf16(PAF(2),VFR(6),o[1],0,0,0), C1,4); \
    GAPB(o[0]=__builtin_amdgcn_mfma_f32_32x32x16_bf16(PAF(3),VFR(3),o[0],0,0,0), C1,8); \
    GAPB(o[1]=__builtin_amdgcn_mfma_f32_32x32x16_bf16(PAF(3),VFR(7),o[1],0,0,0), C1,12); \
    }while(0)
  int t=1;
  #undef CMASK
  #define CMASK(P0,P1,t) do{}while(0)
  for(;t+5<NT;t+=2){
    STEP(pB0,pB1,pA0,pA1,t,true,true,true);     WAIT_BAR(2); RESC(); ROT();
    STEP(pA0,pA1,pB0,pB1,t+1,true,true,true);   WAIT_BAR(2); RESC(); ROT();
  }
  #undef CMASK
  #define CMASK(P0,P1,t) do{int jb_=(t)-(NT-4); if(jb_>=0)cmask(P0,P1,jb_,qrel,hi);}while(0)
  #define ENDW(tt) do{ if((tt)+3<NT){WAIT_BAR(2);} else if((tt)+2<NT){WAIT_BAR(1);} else {WAIT_BAR(0);} }while(0)
  for(;t+1<NT;t+=2){
    STEP(pB0,pB1,pA0,pA1,t,(t+3<NT),(t+1<NT),(t+1<NT));       ENDW(t);   RESC(); ROT();
    STEP(pA0,pA1,pB0,pB1,t+1,(t+4<NT),(t+2<NT),(t+2<NT));     ENDW(t+1); RESC(); ROT();
  }
  STEP(pB0,pB1,pA0,pA1,NT-1,false,false,false); RESC();
  { float sacc=pB0[0]+pB0[1]; _Pragma("unroll") for(int r=2;r<16;++r)sacc+=pB0[r]; float saccb=pB1[0]+pB1[1]; _Pragma("unroll") for(int r=2;r<16;++r)saccb+=pB1[r]; l_reg+=sacc+c32*saccb;
    pw0=(u32x4){PKW(pB0,0),PKW(pB0,2),PKW(pB0,4),PKW(pB0,6)};pw1=(u32x4){PKW(pB0,8),PKW(pB0,10),PKW(pB0,12),PKW(pB0,14)};pw2=(u32x4){PKW(pB1,0),PKW(pB1,2),PKW(pB1,4),PKW(pB1,6)};pw3=(u32x4){PKW(pB1,8),PKW(pB1,10),PKW(pB1,12),PKW(pB1,14)};
    SBAR(); pv(o,(int)(unsigned)(unsigned long)(vp0+sl_cur),PAF(0),PAF(1),PAF(2),PAF(3)); }
  #undef PKW
  #undef PAF
  #undef VFR
  #undef PIN
  #undef MX3
  #undef GAPA
  #undef GAPA2
  #undef GAPB
  #undef EX
  #undef VRD
  #undef KRD
  #undef STEP
  #undef ENDW
  {auto rr=__builtin_amdgcn_permlane32_swap(__float_as_uint(l_reg),__float_as_uint(l_reg),false,false);l_reg=__uint_as_float(rr[0])+__uint_as_float(rr[1]);}
  if(hi==0)wsf[32+r32]=l_reg;asm volatile("s_waitcnt lgkmcnt(0)":::"memory");
  float rli[16];
  #pragma unroll
  for(int r=0;r<16;++r)rli[r]=__builtin_amdgcn_rcpf(wsf[32+crow(r,hi)]);
  bf16*Ow=Oh+(rowbase+q0+wid*QBLK)*OP;
  { bf16*stg=(bf16*)(shm+LDS_OST)+wid*2048;
    #pragma unroll
    for(int r=0;r<16;++r){const int orow=crow(r,hi);
      #pragma unroll
      for(int d0=0;d0<2;++d0)stg[orow*64+d0*32+r32]=__float2bfloat16(o[d0][r]*rli[r]);}
    asm volatile("s_waitcnt lgkmcnt(0)":::"memory");
    #pragma unroll
    for(int i=0;i<4;++i){const int row=i*8+(lane>>3),ch=lane&7; const u32x4 v=*(const u32x4*)(stg+row*64+ch*8); ATTN_STORE16(Ow+(long)row*OP+ch*8,v);} }
  asm volatile("s_waitcnt lgkmcnt(0)\n\ts_barrier":::"memory");
  #undef DMA_K
  #undef DMA_V
  #undef CMASK
  #undef START
  #undef RESC
  #undef ROT
}
constexpr int ATTN_LDS_BYTES=LDS_BYTES;
constexpr int A2_K=0, A2_V=4*8192, A2_WS=A2_V+3*16384, A2_BYTES=A2_WS+NW*256;
__device__ __forceinline__ void attn_unit2(int b,int qb,const bf16*Qh,const bf16*__restrict__ Kh0,const bf16*__restrict__ Vh0,bf16*Oh,float sl,float c32,char*shm,int wid_in,int T0,unsigned*qctr,unsigned qslot){
  const int lane=lane_id_asm(),r32=lane&31,hi=lane>>5; int wid=wid_in; asm volatile("":"+s"(wid));
  const long rowbase=(long)b*SEQ; const int q0=qb*QB;
  const bf16*Qw=Qh+(rowbase+q0+wid*QBLK)*QP;
  const bf16*Kh=Kh0+(rowbase+(long)T0*KVBLK)*KP,*Vh=Vh0+(rowbase+(long)T0*KVBLK)*VP;
  const unsigned lds0=(unsigned)(uintptr_t)shm;
  float*wsf=(float*)(shm+A2_WS)+wid*64;
  const unsigned koff=(unsigned)(lane*KP+wid*8)*2u;
  const unsigned voff=(unsigned)((16*(wid&3)+(lane>>2))*VP+(wid>>2)*32+(lane&3)*8)*2u;
  const unsigned kdst=lds0+A2_K+wid*1024, vdst=lds0+A2_V+wid*1024;
  #define DMA_K(t,slot) glds16(Kh+(long)(t)*KVBLK*KP,koff,(unsigned)__builtin_amdgcn_readfirstlane(kdst+(slot)))
  #define DMA_V0(t,slot) glds16(Vh+(long)(t)*KVBLK*VP,voff,(unsigned)__builtin_amdgcn_readfirstlane(vdst+2*(slot)))
  #define DMA_V1(t,slot) glds16(Vh+(long)(t)*KVBLK*VP+64,voff,(unsigned)__builtin_amdgcn_readfirstlane(vdst+2*(slot)+8192))
  #define DMA_V(t,slot) do{ DMA_V0(t,slot); DMA_V1(t,slot); }while(0)
  const char*Kbase=shm+A2_K; bf16x8 kf[8];
  const lds_cptr shm3=(lds_cptr)shm; const lds_cptr kp0=shm3+A2_K+hi*1024+r32*16; const lds_cptr vp0=shm3+A2_V+((lane>>4)&1)*32+(lane&3)*8+(4*hi+((lane&15)>>2))*64;
  const int NT=(q0+QB)/KVBLK-T0;
  DMA_K(0,0);DMA_V(0,0);DMA_K(1,8192);
  bf16x8 qr[4];
  #pragma unroll
  for(int d0=0;d0<4;++d0)qr[d0]=*reinterpret_cast<const bf16x8*>(&Qw[(long)r32*QP+d0*16+hi*8]);
  float l_reg=0.f;f32x16 o[4];o[0]=f32x16{};o[1]=f32x16{};o[2]=f32x16{};o[3]=f32x16{};f32x16 negm;
  { float hb_=sl*(float)(64*T0-q0-QBLK*wid-r32+4*hi); asm volatile("":"+v"(hb_));
    _Pragma("unroll") for(int r=0;r<16;++r)negm[r]=hb_+sl*(float)((r&3)+8*(r>>2)); }
  asm volatile("":"+v"(negm)); const float sl64=64.f*sl;
  const int qrel=wid*QBLK+r32;
  #define CMASK(P0,P1,t) do{int jb_=(t)-(NT-4); if(jb_>=0)cmask(P0,P1,jb_,qrel,hi);}while(0)
  int sl_prev=0,sl_cur=0,sl_next=8192;
  #define ROT() do{sl_prev=sl_cur;sl_cur=sl_next;sl_next=(sl_next==2*8192)?0:sl_next+8192;}while(0)
  DMA_K(2,2*8192);
  #define KSL(t) (((t)&3)*8192)
  unsigned nxt_=0u; if(wid==0&&lane==0)nxt_=__hip_atomic_fetch_add(qctr,1u,__ATOMIC_RELAXED,__HIP_MEMORY_SCOPE_AGENT);
  WAIT_BAR(3);
  u32x4 pwA0,pwA1,pwA2,pwA3,pwB0,pwB1,pwB2,pwB3;
  #define PKW(P,B) cvtpk_s(P[B],P[B+1])
  #define EX(v) __builtin_amdgcn_exp2f(v)
  #define PIN(x) asm volatile("":"+v"(x))
  { f32x16 c0,c1; qkt(c0,c1,Kbase,qr,negm,r32,hi); CMASK(c0,c1,0);
    float sa=0.f,sb=0.f;
    _Pragma("unroll") for(int r=0;r<16;++r){c0[r]=EX(c0[r]);c1[r]=EX(c1[r]);sa+=c0[r];sb+=c1[r];}
    l_reg+=sa+c32*sb;
    pwA0=(u32x4){PKW(c0,0),PKW(c0,2),PKW(c0,4),PKW(c0,6)};pwA1=(u32x4){PKW(c0,8),PKW(c0,10),PKW(c0,12),PKW(c0,14)};pwA2=(u32x4){PKW(c1,0),PKW(c1,2),PKW(c1,4),PKW(c1,6)};pwA3=(u32x4){PKW(c1,8),PKW(c1,10),PKW(c1,12),PKW(c1,14)}; }
  WAIT_BAR(0);
  if(wid==0&&lane==0)*(volatile __attribute__((address_space(3))) unsigned*)(shm3+qslot)=nxt_;
  DMA_K(3,3*8192);DMA_V(1,8192);
  ROT();
  kload2(kf,kp0+KSL(1),0); kload2(kf,kp0+KSL(1),1);
  _Pragma("unroll") for(int r=0;r<16;++r)negm[r]+=sl64;
  s16x4 vlo[8],vhi[8];
  #define PAFI(PI,k) __builtin_bit_cast(bf16x8,PI##k)
  #define VFR(i) (bf16x8){vlo[i][0],vlo[i][1],vlo[i][2],vlo[i][3],vhi[i][0],vhi[i][1],vhi[i][2],vhi[i][3]}
  #define VRD(ks,d) do{ vlo[((ks)&1)*4+(d)]=vtr(vp_+((d)*4096+(ks)*1024)); vhi[((ks)&1)*4+(d)]=vtr(vp_+((d)*4096+(ks)*1024+512)); }while(0)
  #define GAPQ(MF) do{ MF; SBAR(); }while(0)
  #define GAPN(MF,B) do{ MF; negm[B]+=sl64; negm[B+1]+=sl64; negm[B+2]+=sl64; negm[B+3]+=sl64; PIN(negm); SBAR(); }while(0)
  #define GAPB(MF,RD,X,SA,B,PO,W) do{ MF; RD; X[B]=EX(X[B]); X[B+1]=EX(X[B+1]); SA+=X[B]; SA+=X[B+1]; PO[W]=PKW(X,B); PIN(X); PIN(SA); PIN(PO); SBAR(); }while(0)
  #define STEP2(PI,PO,t,GK,GV,GL) do{ SBAR(); \
    const lds_cptr vp_=vp0+2*sl_prev; const lds_cptr kq_=kp0+KSL(t); f32x16 C0,C1; float sa=0.f,sb=0.f; \
    kload2(kf,kq_,2); VRD(0,0); SBAR(); kload2(kf,kq_,3); VRD(0,1); SBAR(); \
    GAPQ(C0=__builtin_amdgcn_mfma_f32_32x32x16_bf16(kf[0],qr[0],negm,0,0,0)); \
    VRD(0,2); SBAR(); GAPQ(C1=__builtin_amdgcn_mfma_f32_32x32x16_bf16(kf[1],qr[0],negm,0,0,0)); \
    VRD(0,3); SBAR(); GAPN(C0=__builtin_amdgcn_mfma_f32_32x32x16_bf16(kf[2],qr[1],C0,0,0,0),0); \
    VRD(1,0); SBAR(); GAPN(C1=__builtin_amdgcn_mfma_f32_32x32x16_bf16(kf[3],qr[1],C1,0,0,0),4); \
    VRD(1,1); SBAR(); GAPN(C0=__builtin_amdgcn_mfma_f32_32x32x16_bf16(kf[4],qr[2],C0,0,0,0),8); \
    VRD(1,2); SBAR(); GAPN(C1=__builtin_amdgcn_mfma_f32_32x32x16_bf16(kf[5],qr[2],C1,0,0,0),12); \
    VRD(1,3); SBAR(); GAPQ(C0=__builtin_amdgcn_mfma_f32_32x32x16_bf16(kf[6],qr[3],C0,0,0,0)); \
    GAPQ(C1=__builtin_amdgcn_mfma_f32_32x32x16_bf16(kf[7],qr[3],C1,0,0,0)); \
    CMASK(C0,C1,t); SBAR(); \
    GAPB(o[0]=__builtin_amdgcn_mfma_f32_32x32x16_bf16(PAFI(PI,0),VFR(0),o[0],0,0,0), VRD(2,0), C0,sa,0, PO##0,0); \
    GAPB(o[1]=__builtin_amdgcn_mfma_f32_32x32x16_bf16(PAFI(PI,0),VFR(1),o[1],0,0,0), VRD(2,1), C0,sa,2, PO##0,1); \
    GAPB(o[2]=__builtin_amdgcn_mfma_f32_32x32x16_bf16(PAFI(PI,0),VFR(2),o[2],0,0,0), VRD(2,2), C0,sa,4, PO##0,2); \
    GAPB(o[3]=__builtin_amdgcn_mfma_f32_32x32x16_bf16(PAFI(PI,0),VFR(3),o[3],0,0,0), VRD(2,3), C0,sa,6, PO##0,3); \
    GAPB(o[0]=__builtin_amdgcn_mfma_f32_32x32x16_bf16(PAFI(PI,1),VFR(4),o[0],0,0,0), VRD(3,0), C0,sa,8, PO##1,0); \
    GAPB(o[1]=__builtin_amdgcn_mfma_f32_32x32x16_bf16(PAFI(PI,1),VFR(5),o[1],0,0,0), VRD(3,1), C0,sa,10, PO##1,1); \
    GAPB(o[2]=__builtin_amdgcn_mfma_f32_32x32x16_bf16(PAFI(PI,1),VFR(6),o[2],0,0,0), VRD(3,2), C0,sa,12, PO##1,2); \
    GAPB(o[3]=__builtin_amdgcn_mfma_f32_32x32x16_bf16(PAFI(PI,1),VFR(7),o[3],0,0,0), VRD(3,3), C0,sa,14, PO##1,3); \
    GAPB(o[0]=__builtin_amdgcn_mfma_f32_32x32x16_bf16(PAFI(PI,2),VFR(0),o[0],0,0,0), if(GK){DMA_K((t)+3,KSL((t)+3));}, C1,sb,0, PO##2,0); \
    GAPB(o[1]=__builtin_amdgcn_mfma_f32_32x32x16_bf16(PAFI(PI,2),VFR(1),o[1],0,0,0), if(GL){kload2(kf,kp0+KSL((t)+1),0);}, C1,sb,2, PO##2,1); \
    GAPB(o[2]=__builtin_amdgcn_mfma_f32_32x32x16_bf16(PAFI(PI,2),VFR(2),o[2],0,0,0), if(GV){DMA_V0((t)+1,sl_next);}, C1,sb,4, PO##2,2); \
    GAPB(o[3]=__builtin_amdgcn_mfma_f32_32x32x16_bf16(PAFI(PI,2),VFR(3),o[3],0,0,0), if(GL){kload2(kf,kp0+KSL((t)+1),1);}, C1,sb,6, PO##2,3); \
    GAPB(o[0]=__builtin_amdgcn_mfma_f32_32x32x16_bf16(PAFI(PI,3),VFR(4),o[0],0,0,0), if(GV){DMA_V1((t)+1,sl_next);}, C1,sb,8, PO##3,0); \
    GAPB(o[1]=__builtin_amdgcn_mfma_f32_32x32x16_bf16(PAFI(PI,3),VFR(5),o[1],0,0,0), (void)0, C1,sb,10, PO##3,1); \
    GAPB(o[2]=__builtin_amdgcn_mfma_f32_32x32x16_bf16(PAFI(PI,3),VFR(6),o[2],0,0,0), (void)0, C1,sb,12, PO##3,2); \
    GAPB(o[3]=__builtin_amdgcn_mfma_f32_32x32x16_bf16(PAFI(PI,3),VFR(7),o[3],0,0,0), (void)0, C1,sb,14, PO##3,3); \
    l_reg+=sa+c32*sb; \
    }while(0)
  int t=1;
  #undef CMASK
  #define CMASK(P0,P1,t) do{}while(0)
  for(;t+5<NT;t+=2){
    STEP2(pwA,pwB,t,true,true,true);     WAIT_BAR(3); ROT();
    STEP2(pwB,pwA,t+1,true,true,true);   WAIT_BAR(3); ROT();
  }
  #undef CMASK
  #define CMASK(P0,P1,t) do{int jb_=(t)-(NT-4); if(jb_>=0)cmask(P0,P1,jb_,qrel,hi);}while(0)
  #define ENDW(tt) do{ if((tt)+3<NT){WAIT_BAR(3);} else if((tt)+2<NT){WAIT_BAR(2);} else {WAIT_BAR(0);} }while(0)
  for(;t+1<NT;t+=2){
    STEP2(pwA,pwB,t,(t+3<NT),(t+1<NT),(t+1<NT));       ENDW(t);   ROT();
    STEP2(pwB,pwA,t+1,(t+4<NT),(t+2<NT),(t+2<NT));     ENDW(t+1); ROT();
  }
  STEP2(pwA,pwB,NT-1,false,false,false);
  { const int vb=(int)(unsigned)(unsigned long)(vp0+2*sl_cur);
    #pragma unroll
    for(int d0=0;d0<4;++d0){s16x4 lo[4],hh[4];
      #pragma unroll
      for(int ks=0;ks<4;++ks){
        asm volatile("ds_read_b64_tr_b16 %0,%1 offset:%c2":"=&v"(lo[ks]):"v"(vb),"i"(d0*4096+ks*1024):"memory");
        asm volatile("ds_read_b64_tr_b16 %0,%1 offset:%c2":"=&v"(hh[ks]):"v"(vb),"i"(d0*4096+ks*1024+512):"memory");}
      asm volatile("s_waitcnt lgkmcnt(0)":::"memory");SBAR();
      #define PK(k) (bf16x8){lo[k][0],lo[k][1],lo[k][2],lo[k][3],hh[k][0],hh[k][1],hh[k][2],hh[k][3]}
      o[d0]=__builtin_amdgcn_mfma_f32_32x32x16_bf16(PAFI(pwB,0),PK(0),o[d0],0,0,0);
      o[d0]=__builtin_amdgcn_mfma_f32_32x32x16_bf16(PAFI(pwB,1),PK(1),o[d0],0,0,0);
      o[d0]=__builtin_amdgcn_mfma_f32_32x32x16_bf16(PAFI(pwB,2),PK(2),o[d0],0,0,0);
      o[d0]=__builtin_amdgcn_mfma_f32_32x32x16_bf16(PAFI(pwB,3),PK(3),o[d0],0,0,0);
      #undef PK
    } }
  {auto rr=__builtin_amdgcn_permlane32_swap(__float_as_uint(l_reg),__float_as_uint(l_reg),false,false);l_reg=__uint_as_float(rr[0])+__uint_as_float(rr[1]);}
  if(hi==0)wsf[32+r32]=l_reg;
  asm volatile("s_waitcnt lgkmcnt(0)\n\ts_barrier":::"memory");
  float rli[16];
  #pragma unroll
  for(int r=0;r<16;++r)rli[r]=__builtin_amdgcn_rcpf(wsf[32+crow(r,hi)]);
  bf16*Ow=Oh+(rowbase+q0+wid*QBLK)*OP;
  { bf16*stg=(bf16*)(shm)+wid*4096;
    #pragma unroll
    for(int r=0;r<16;++r){const int orow=crow(r,hi);
      #pragma unroll
      for(int d0=0;d0<4;++d0)stg[orow*128+d0*32+r32]=__float2bfloat16(o[d0][r]*rli[r]);}
    asm volatile("s_waitcnt lgkmcnt(0)":::"memory");
    #pragma unroll
    for(int i=0;i<8;++i){const int row=i*4+(lane>>4),ch=lane&15; const u32x4 v=*(const u32x4*)(stg+row*128+ch*8); ATTN_STORE16(Ow+(long)row*OP+ch*8,v);} }
  asm volatile("s_waitcnt lgkmcnt(0)\n\ts_barrier":::"memory");
  #undef DMA_K
  #undef DMA_V
  #undef DMA_V0
  #undef DMA_V1
  #undef CMASK
  #undef ROT
  #undef PKW
  #undef EX
  #undef PIN
  #undef PAFI
  #undef VFR
  #undef VRD
  #undef KSL
  #undef GAPQ
  #undef GAPN
  #undef GAPB
  #undef STEP2
  #undef ENDW
}
#undef SBAR
#undef WAIT_BAR
}

constexpr int NWAVES = 8;
constexpr int M = 32768, DMODEL = 1024, NIN = 3584, SEQL = 4096;
constexpr size_t MiB = 1u << 20;
constexpr size_t WS_ROWSS = 0;
constexpr size_t WS_WIN = 2 * MiB, WS_WO = 10 * MiB, WS_PW = 12 * MiB;
constexpr size_t WS_XN = 16 * MiB, WS_O = WS_XN;
constexpr size_t WS_HG = 80 * MiB, WS_CG = 112 * MiB, WS_Q = 144 * MiB, WS_K = 176 * MiB, WS_V = 208 * MiB, WS_DG = 240 * MiB, WS_U = 272 * MiB;
constexpr size_t WS_Y = 304 * MiB, WS_Y2 = 368 * MiB, WS_END = 432 * MiB;
constexpr int RING_BYTES = 131072, LDS_BYTES = 147456, LDSCTL_OFF = RING_BYTES;
constexpr size_t WS_BAR = 512 * 1024, WS_BAR_BYTES = 24576;
constexpr int NMAX_WORD = 3600, QCTR_WORD = 3712, GB_WORD = 4096, QG_WORD = 4608, NMG_WORD = 5120, GG_WORD = 5376, SIG_WORD = 5888;
#define GAS __attribute__((address_space(1)))
#define LAS __attribute__((address_space(3)))
typedef unsigned short bf16;
typedef unsigned v4u __attribute__((ext_vector_type(4)));
typedef unsigned v2u __attribute__((ext_vector_type(2)));
typedef float f32x4 __attribute__((ext_vector_type(4)));
typedef float f32x2 __attribute__((ext_vector_type(2)));
#define LDS_WAIT() asm volatile("s_waitcnt lgkmcnt(0)" ::: "memory")
__device__ __forceinline__ unsigned pk2(float lo, float hi) { return pg8::cvt_pk_bf16(lo, hi); }
__device__ __forceinline__ float wave_sum(float v) {
#pragma unroll
    for (int o = 1; o < 64; o <<= 1) v += __shfl_xor(v, o);
    return v;
}
__device__ __forceinline__ void p0_transpose_item(const float* W, int K, int N, bf16* WT, int k0, int n0, int dst_row0, LAS float* scr, int lane) {
#pragma unroll
    for (int i = 0; i < 32; ++i) { const int kk = 2 * i + (lane >> 5); scr[kk * 33 + (lane & 31)] = W[(size_t)(k0 + kk) * N + n0 + (lane & 31)]; }
    LDS_WAIT(); asm volatile("" ::: "memory");
    const int c = lane & 7;
#pragma unroll
    for (int j = 0; j < 4; ++j) { const int n = (lane >> 3) + 8 * j; const LAS float* p = scr + (8 * c) * 33 + n;
        v4u o; o.x = pk2(p[0 * 33], p[1 * 33]); o.y = pk2(p[2 * 33], p[3 * 33]); o.z = pk2(p[4 * 33], p[5 * 33]); o.w = pk2(p[6 * 33], p[7 * 33]);
        *(v4u*)(WT + (size_t)(dst_row0 + n) * K + k0 + 8 * c) = o; }
    LDS_WAIT(); asm volatile("" ::: "memory");
}
__device__ __forceinline__ int win_dst_row(int n0) {
    if (n0 >= 1024) return n0;
    if (n0 < 512) return 256 * (n0 >> 7) + (n0 & 127);
    const int n1 = n0 - 512; return 256 * (n1 >> 7) + 128 + (n1 & 127);
}

#define RLX_AGENT __ATOMIC_RELAXED, __HIP_MEMORY_SCOPE_AGENT
#define XB_TMO      128
#define XB_XCNT(j)  (256  + 64 * (j))
#define XB_XSUB(j)  (1280 + 64 * (j))
#define XB_XGEN(j)  (2304 + 64 * (j))
#define XB_TOP      3328
#define XB_TOPGEN   3392
#define XCD_BAR_WORDS 3456
#define XB_SPIN_CAP (1u << 18)

__device__ __forceinline__ unsigned xb_ld(unsigned* p)              { return __hip_atomic_load(p, __ATOMIC_RELAXED, __HIP_MEMORY_SCOPE_AGENT); }
__device__ __forceinline__ unsigned xb_add(unsigned* p, unsigned v) { return __hip_atomic_fetch_add(p, v, __ATOMIC_RELAXED, __HIP_MEMORY_SCOPE_AGENT); }
__device__ __forceinline__ unsigned xb_xcc_id() { return (unsigned)__builtin_amdgcn_s_getreg((3 << 11) | 20) & 0xFu; }
#define XB_SPIN(cond, bar) do { unsigned _sp = 0; while (cond) { __builtin_amdgcn_s_sleep(1); \
    if ((++_sp & 255u) == 0u) { if (xb_ld(&(bar)[XB_TMO])) break; if (_sp > XB_SPIN_CAP) { atomicAdd(&(bar)[XB_TMO], 1u); break; } } } } while (0)

struct XcdBarrier {
    unsigned* bar; unsigned x;
    volatile LAS unsigned* st;
};

__device__ __forceinline__ XcdBarrier xcd_barrier_post(unsigned* bar, volatile LAS unsigned* st) {
    XcdBarrier b; b.bar = bar; b.x = xb_xcc_id(); b.st = st;
    if (threadIdx.x == 0) (void)xb_add(&bar[XB_XCNT(b.x)], 1u);
    return b;
}
__device__ __forceinline__ void xcd_barrier_complete(unsigned* bar, unsigned x, unsigned& nloc, unsigned& nx) {
    const unsigned G = gridDim.x * gridDim.y * gridDim.z;
    unsigned sum, cnt, mine, sp = 0u;
    for (;;) {
        sum = 0u; cnt = 0u; mine = 0u;
#pragma unroll
        for (unsigned j = 0; j < 16; ++j) { const unsigned c = xb_ld(&bar[XB_XCNT(j)]); sum += c; cnt += (c > 0u) ? 1u : 0u; mine = (j == x) ? c : mine; }
        if (sum == G) break;
        __builtin_amdgcn_s_sleep(1);
        if ((++sp & 255u) == 0u) { if (xb_ld(&bar[XB_TMO])) break; if (sp > XB_SPIN_CAP) { atomicAdd(&bar[XB_TMO], 1u); break; } }
    }
    nloc = mine > 0u ? mine : 1u; nx = cnt > 0u ? cnt : 1u;
}

__device__ __forceinline__ void xcd_barrier(const XcdBarrier& b) {
    asm volatile("s_waitcnt vmcnt(0)" ::: "memory");
    __syncthreads();
    if (threadIdx.x == 0) {
        unsigned* bar = b.bar;
        __builtin_amdgcn_s_waitcnt(0);
        unsigned nloc = b.st[0], nx = b.st[1];
        if (nloc == 0u) { xcd_barrier_complete(bar, b.x, nloc, nx); b.st[0] = nloc; b.st[1] = nx; }
        const unsigned old = xb_add(&bar[XB_XSUB(b.x)], 1u);
        const unsigned gen = old / nloc;
        if (old + 1u == (gen + 1u) * nloc) {
            __builtin_amdgcn_fence(__ATOMIC_RELEASE, "agent");
            asm volatile("s_waitcnt vmcnt(0)" ::: "memory");
            const unsigned og = xb_add(&bar[XB_TOP], 1u);
            const unsigned tg = og / nx;
            if (og + 1u == (tg + 1u) * nx) xb_add(&bar[XB_TOPGEN], 1u);
            else XB_SPIN(xb_ld(&bar[XB_TOPGEN]) == tg, bar);
            __builtin_amdgcn_fence(__ATOMIC_ACQUIRE, "agent");
            xb_add(&bar[XB_XGEN(b.x)], 1u);
            asm volatile("s_waitcnt vmcnt(0)" ::: "memory");
        } else {
            XB_SPIN(xb_ld(&bar[XB_XGEN(b.x)]) == gen, bar);
            __builtin_amdgcn_fence(__ATOMIC_ACQUIRE, "agent");
            asm volatile("s_waitcnt vmcnt(0)" ::: "memory");
        }
    }
    __syncthreads();
}

__device__ __forceinline__ void group_barrier(unsigned* ctr, unsigned target) {
    asm volatile("s_waitcnt vmcnt(0)" ::: "memory");
    __syncthreads();
    if (threadIdx.x == 0) {
        __builtin_amdgcn_fence(__ATOMIC_RELEASE, "agent");
        asm volatile("s_waitcnt vmcnt(0)" ::: "memory");
        __hip_atomic_fetch_add(ctr, 1u, __ATOMIC_RELAXED, __HIP_MEMORY_SCOPE_AGENT);
        unsigned sp = 0u;
        while (__hip_atomic_load(ctr, __ATOMIC_RELAXED, __HIP_MEMORY_SCOPE_AGENT) < target && ++sp < (1u << 22)) __builtin_amdgcn_s_sleep(1);
        __builtin_amdgcn_fence(__ATOMIC_ACQUIRE, "agent");
        asm volatile("s_waitcnt vmcnt(0)" ::: "memory");
    }
    __syncthreads();
}

__device__ __forceinline__ void group_barrier_1xcc(unsigned* ctr, unsigned* gen, unsigned target, unsigned k) {
    asm volatile("s_waitcnt vmcnt(0)" ::: "memory");
    __syncthreads();
    if (threadIdx.x == 0) {
        const unsigned old = __hip_atomic_fetch_add(ctr, 1u, __ATOMIC_RELAXED, __HIP_MEMORY_SCOPE_AGENT);
        if (old + 1u == target) {
            __builtin_amdgcn_fence(__ATOMIC_RELEASE, "agent");
            asm volatile("s_waitcnt vmcnt(0)" ::: "memory");
            __hip_atomic_fetch_add(gen, 1u, __ATOMIC_RELAXED, __HIP_MEMORY_SCOPE_AGENT);
        } else { unsigned sp = 0u; while (__hip_atomic_load(gen, __ATOMIC_RELAXED, __HIP_MEMORY_SCOPE_AGENT) < k && ++sp < (1u << 22)) __builtin_amdgcn_s_sleep(1); }
        __builtin_amdgcn_fence(__ATOMIC_ACQUIRE, "agent");
        asm volatile("s_waitcnt vmcnt(0)" ::: "memory");
    }
    __syncthreads();
}

constexpr int CONV_IN_BYTES = 62 * 1024;
__device__ __forceinline__ void conv_phase(LAS unsigned char* lds, int u0, int ustride, int nunits, const bf16* Hg, const float* dw_w, const float* dw_b, const float* ln_g, const float* ln_b, bf16* U, int tid, int lane, int wave) {
    const int cp = tid & 255, tg = tid >> 8;
    f32x2 w[31];
#pragma unroll
    for (int j = 0; j < 31; ++j) w[j] = *(const f32x2*)(dw_w + j * 512 + 2 * cp);
    const f32x2 bias = *(const f32x2*)(dw_b + 2 * cp);
    f32x4 gg[2], bb[2];
#pragma unroll
    for (int j = 0; j < 2; ++j) { gg[j] = *((const f32x4*)ln_g + lane + 64 * j); bb[j] = *((const f32x4*)ln_b + lane + 64 * j); }
    v4u pre[8];
#define CONV_PREFETCH(unit) do { const int row0_ = (unit) * 32, t0_ = row0_ & (SEQL - 1); _Pragma("unroll") for (int k = 0; k < 8; ++k) { const int i = tid + 512 * k, r = i >> 6, ch = i & 63; pre[k] = (v4u){0u, 0u, 0u, 0u}; \
        if (i < 62 * 64 && t0_ - 30 + r >= 0) pre[k] = *(const v4u*)(Hg + (size_t)(row0_ - 30 + r) * 512 + ch * 8); } } while (0)
    if (u0 < nunits) CONV_PREFETCH(u0);
    for (int unit = u0; unit < nunits; unit += ustride) {
        const int row0 = unit * 32;
#pragma unroll
        for (int k = 0; k < 8; ++k) { const int i = tid + 512 * k, r = i >> 6, ch = i & 63; if (i < 62 * 64) *(LAS v4u*)(lds + r * 1024 + ch * 16) = pre[k]; }
        __syncthreads();
        if (unit + ustride < nunits) CONV_PREFETCH(unit + ustride);
#pragma unroll 1
        for (int g = 0; g < 2; ++g) {
            const int tl0 = tg * 16 + g * 8;
            f32x2 acc[8];
#pragma unroll
            for (int o = 0; o < 8; ++o) acc[o] = bias;
#pragma unroll
            for (int i = 0; i < 38; ++i) { const unsigned wv = *(const LAS unsigned*)(lds + (tl0 + i) * 1024 + cp * 4); const f32x2 x = {pg8::bf_lo(wv), pg8::bf_hi(wv)};
#pragma unroll
                for (int o = 0; o < 8; ++o) { const int j = i - o; if (j >= 0 && j <= 30) acc[o] += w[j] * x; } }
#pragma unroll
            for (int o = 0; o < 8; ++o) *(LAS f32x2*)(lds + CONV_IN_BYTES + (tl0 + o) * 2048 + cp * 8) = acc[o];
        }
        __syncthreads();
        f32x4 v[4][2]; float s1[4], s2[4];
#pragma unroll
        for (int k = 0; k < 4; ++k) { const int tl = wave * 4 + k; s1[k] = 0.f;
#pragma unroll
            for (int j = 0; j < 2; ++j) { v[k][j] = *(const LAS f32x4*)(lds + CONV_IN_BYTES + tl * 2048 + (lane + 64 * j) * 16); s1[k] += (v[k][j].x + v[k][j].y) + (v[k][j].z + v[k][j].w); } }
#pragma unroll
        for (int o = 1; o < 64; o <<= 1) {
#pragma unroll
            for (int k = 0; k < 4; ++k) s1[k] += __shfl_xor(s1[k], o); }
#pragma unroll
        for (int k = 0; k < 4; ++k) { const float mean = s1[k] * (1.f / 512.f); s2[k] = 0.f;
#pragma unroll
            for (int j = 0; j < 2; ++j) { v[k][j] = v[k][j] - mean; s2[k] += (v[k][j].x * v[k][j].x + v[k][j].y * v[k][j].y) + (v[k][j].z * v[k][j].z + v[k][j].w * v[k][j].w); } }
#pragma unroll
        for (int o = 1; o < 64; o <<= 1) {
#pragma unroll
            for (int k = 0; k < 4; ++k) s2[k] += __shfl_xor(s2[k], o); }
#pragma unroll
        for (int k = 0; k < 4; ++k) { const int tl = wave * 4 + k; const float rstd = 1.f / sqrtf(s2[k] * (1.f / 512.f) + 1e-5f);
#pragma unroll
            for (int j = 0; j < 2; ++j) { f32x4 y = v[k][j] * rstd * gg[j] + bb[j];
                y.x = pg8::silu_f(y.x); y.y = pg8::silu_f(y.y); y.z = pg8::silu_f(y.z); y.w = pg8::silu_f(y.w);
                v2u o; o.x = pk2(y.x, y.y); o.y = pk2(y.z, y.w); *(v2u*)(U + (size_t)(row0 + tl) * 512 + (lane + 64 * j) * 4) = o; } }
        __syncthreads();
    }
#undef CONV_PREFETCH
}

__device__ __forceinline__ void conv_phase_dyn(LAS unsigned char* lds, int cur, unsigned* qctr, int qbase  , int nunits, const bf16* Hg, const float* dw_w, const float* dw_b, const float* ln_g, const float* ln_b, bf16* U, int tid, int lane, int wave) {
    const int cp = tid & 255, tg = tid >> 8;
    f32x2 w[31];
#pragma unroll
    for (int j = 0; j < 31; ++j) w[j] = *(const f32x2*)(dw_w + j * 512 + 2 * cp);
    const f32x2 bias = *(const f32x2*)(dw_b + 2 * cp);
    f32x4 gg[2], bb[2];
#pragma unroll
    for (int j = 0; j < 2; ++j) { gg[j] = *((const f32x4*)ln_g + lane + 64 * j); bb[j] = *((const f32x4*)ln_b + lane + 64 * j); }
    v4u pre[8];
#define CONV_PREFETCH(unit) do { const int row0_ = (unit) * 32, t0_ = row0_ & (SEQL - 1); _Pragma("unroll") for (int k = 0; k < 8; ++k) { const int i = tid + 512 * k, r = i >> 6, ch = i & 63; pre[k] = (v4u){0u, 0u, 0u, 0u}; \
        if (i < 62 * 64 && t0_ - 30 + r >= 0) pre[k] = *(const v4u*)(Hg + (size_t)(row0_ - 30 + r) * 512 + ch * 8); } } while (0)
    const bool popper = (wave == 0 && lane == 0); volatile LAS unsigned* slot = (volatile LAS unsigned*)(lds + LDSCTL_OFF + 224);
    if (popper) slot[0] = __hip_atomic_fetch_add(qctr, 1u, __ATOMIC_RELAXED, __HIP_MEMORY_SCOPE_AGENT);
    __syncthreads();
    int nxt = qbase + (int)__builtin_amdgcn_readfirstlane(slot[0]);
    if (cur < nunits) CONV_PREFETCH(cur);
    while (cur < nunits) {
        const int unit = cur; const int row0 = unit * 32;
#pragma unroll
        for (int k = 0; k < 8; ++k) { const int i = tid + 512 * k, r = i >> 6, ch = i & 63; if (i < 62 * 64) *(LAS v4u*)(lds + r * 1024 + ch * 16) = pre[k]; }
        __syncthreads();
        unsigned pv = 0u; if (popper) pv = __hip_atomic_fetch_add(qctr, 1u, __ATOMIC_RELAXED, __HIP_MEMORY_SCOPE_AGENT);
        if (nxt < nunits) CONV_PREFETCH(nxt);
#pragma unroll 1
        for (int g = 0; g < 2; ++g) {
            const int tl0 = tg * 16 + g * 8;
            f32x2 acc[8];
#pragma unroll
            for (int o = 0; o < 8; ++o) acc[o] = bias;
#pragma unroll
            for (int i = 0; i < 38; ++i) { const unsigned wv = *(const LAS unsigned*)(lds + (tl0 + i) * 1024 + cp * 4); const f32x2 x = {pg8::bf_lo(wv), pg8::bf_hi(wv)};
#pragma unroll
                for (int o = 0; o < 8; ++o) { const int j = i - o; if (j >= 0 && j <= 30) acc[o] += w[j] * x; } }
#pragma unroll
            for (int o = 0; o < 8; ++o) *(LAS f32x2*)(lds + CONV_IN_BYTES + (tl0 + o) * 2048 + cp * 8) = acc[o];
        }
        __syncthreads();
        f32x4 v[4][2]; float s1[4], s2[4];
#pragma unroll
        for (int k = 0; k < 4; ++k) { const int tl = wave * 4 + k; s1[k] = 0.f;
#pragma unroll
            for (int j = 0; j < 2; ++j) { v[k][j] = *(const LAS f32x4*)(lds + CONV_IN_BYTES + tl * 2048 + (lane + 64 * j) * 16); s1[k] += (v[k][j].x + v[k][j].y) + (v[k][j].z + v[k][j].w); } }
#pragma unroll
        for (int o = 1; o < 64; o <<= 1) {
#pragma unroll
            for (int k = 0; k < 4; ++k) s1[k] += __shfl_xor(s1[k], o); }
#pragma unroll
        for (int k = 0; k < 4; ++k) { const float mean = s1[k] * (1.f / 512.f); s2[k] = 0.f;
#pragma unroll
            for (int j = 0; j < 2; ++j) { v[k][j] = v[k][j] - mean; s2[k] += (v[k][j].x * v[k][j].x + v[k][j].y * v[k][j].y) + (v[k][j].z * v[k][j].z + v[k][j].w * v[k][j].w); } }
#pragma unroll
        for (int o = 1; o < 64; o <<= 1) {
#pragma unroll
            for (int k = 0; k < 4; ++k) s2[k] += __shfl_xor(s2[k], o); }
#pragma unroll
        for (int k = 0; k < 4; ++k) { const int tl = wave * 4 + k; const float rstd = 1.f / sqrtf(s2[k] * (1.f / 512.f) + 1e-5f);
#pragma unroll
            for (int j = 0; j < 2; ++j) { f32x4 y = v[k][j] * rstd * gg[j] + bb[j];
                y.x = pg8::silu_f(y.x); y.y = pg8::silu_f(y.y); y.z = pg8::silu_f(y.z); y.w = pg8::silu_f(y.w);
                v2u o; o.x = pk2(y.x, y.y); o.y = pk2(y.z, y.w); *(v2u*)(U + (size_t)(row0 + tl) * 512 + (lane + 64 * j) * 4) = o; } }
        if (popper) slot[0] = pv;
        __syncthreads();
        cur = nxt; nxt = qbase + (int)__builtin_amdgcn_readfirstlane(slot[0]);
        __syncthreads();
    }
#undef CONV_PREFETCH
}

struct Args { const float* in[16]; float* out; unsigned char* ws; };
__global__ void __launch_bounds__(NWAVES * 64, 2) fwd_megakernel(Args args) {
    extern __shared__ __attribute__((aligned(16))) unsigned char lds[];
    cg::grid_group grid = cg::this_grid();
    LAS unsigned char* L = (LAS unsigned char*)lds;
    const int wave = __builtin_amdgcn_readfirstlane(threadIdx.x >> 6);
#define FRESH_TID() const int lane = lane_id_asm(); const int tid = wave * 64 + lane; (void)tid
    const int G = gridDim.x; const int bx = blockIdx.x; const int vcu = (G % 8 == 0) ? (bx % 8) * (G / 8) + bx / 8 : bx;
    const int gw = vcu * NWAVES + wave, NGW = G * NWAVES;
    const bool grp = (G == 256); const int NGRP = grp ? 8 : 1, GS = G / NGRP, gi = grp ? (bx & 7) : 0, gj = grp ? (bx >> 3) : bx, NB = 8 / NGRP, RPG = M / NGRP;
    const int gwl = gj * NWAVES + wave, NGWL = GS * NWAVES; unsigned gbt = 0u;
    bool one_xcc = false; unsigned gbk = 0u;
#define GROUP_BAR() do { gbt += (unsigned)GS; ++gbk; if (one_xcc) group_barrier_1xcc((unsigned*)(args.ws + WS_BAR) + GB_WORD + 64 * gi, (unsigned*)(args.ws + WS_BAR) + GG_WORD + 64 * gi, gbt, gbk); \
        else group_barrier((unsigned*)(args.ws + WS_BAR) + GB_WORD + 64 * gi, gbt); } while (0)
#define CA4 __attribute__((address_space(4)))
#define PHASE_PTRS() \
    const CA4 Args* A_; { auto kp_ = __builtin_amdgcn_kernarg_segment_ptr(); asm volatile("" : "+s"(kp_)); A_ = (const CA4 Args*)kp_; } \
    unsigned char* ws = A_->ws; (void)ws; \
    const float* x = A_->in[0]; const float* pre_g = A_->in[1]; const float* w_in = A_->in[2]; const float* dw_w = A_->in[3]; const float* dw_b = A_->in[4]; \
    const float* cln_g = A_->in[5]; const float* cln_b = A_->in[6]; const float* pw_w = A_->in[7]; const float* pw_b = A_->in[8]; \
    const float* lq1 = A_->in[9]; const float* lk1 = A_->in[10]; const float* lq2 = A_->in[11]; const float* lk2 = A_->in[12]; \
    const float* sub_g = A_->in[13]; const float* w_out = A_->in[14]; const float* post_g = A_->in[15]; float* out = A_->out; \
    float* rowss = (float*)(ws + WS_ROWSS); \
    bf16 *WinT = (bf16*)(ws + WS_WIN), *WoT = (bf16*)(ws + WS_WO), *PwT = (bf16*)(ws + WS_PW), *XN = (bf16*)(ws + WS_XN), *OB = (bf16*)(ws + WS_O); \
    bf16 *HG = (bf16*)(ws + WS_HG), *CGB = (bf16*)(ws + WS_CG), *QB_ = (bf16*)(ws + WS_Q), *KB = (bf16*)(ws + WS_K), *VB = (bf16*)(ws + WS_V), *DGB = (bf16*)(ws + WS_DG), *UB = (bf16*)(ws + WS_U); \
    bf16 *YB = (bf16*)(ws + WS_Y), *Y2 = (bf16*)(ws + WS_Y2); \
    (void)x; (void)pre_g; (void)w_in; (void)dw_w; (void)dw_b; (void)cln_g; (void)cln_b; (void)pw_w; (void)pw_b; (void)lq1; (void)lk1; (void)lq2; (void)lk2; (void)sub_g; (void)w_out; (void)post_g; (void)out; \
    (void)rowss; (void)WinT; (void)WoT; (void)PwT; (void)XN; (void)OB; (void)HG; (void)CGB; (void)QB_; (void)KB; (void)VB; (void)DGB; (void)UB; (void)YB; (void)Y2
    if (threadIdx.x < 128) ((LAS unsigned*)(L + LDSCTL_OFF))[threadIdx.x] = 0u;
    __syncthreads();
    XcdBarrier bar = xcd_barrier_post((unsigned*)(args.ws + WS_BAR), (volatile LAS unsigned*)(L + LDSCTL_OFF));
    if (threadIdx.x == 0) atomicOr((unsigned*)(args.ws + WS_BAR) + SIG_WORD + gi, 1u << (xb_xcc_id() & 15u));
    if (args.ws == nullptr) grid.sync();

    {
        PHASE_PTRS(); FRESH_TID();
        LAS float* scr = (LAS float*)(L + wave * 16384);
        constexpr int I_IN = (DMODEL / 64) * (NIN / 32), I_O = (1024 / 64) * (1024 / 32), I_PW = (512 / 64) * (512 / 32);
        for (int it = gw; it < I_IN + I_O + I_PW; it += NGW) {
            int r = it;
            if (r < I_IN) { const int nblk = NIN / 32, kb = r / nblk, nb = r % nblk; p0_transpose_item(w_in, DMODEL, NIN, WinT, 64 * kb, 32 * nb, win_dst_row(32 * nb), scr, lane); continue; } r -= I_IN;
            if (r < I_O) { const int nblk = 1024 / 32, kb = r / nblk, nb = r % nblk; p0_transpose_item(w_out, 1024, 1024, WoT, 64 * kb, 32 * nb, 32 * nb, scr, lane); continue; } r -= I_O;
            { const int nblk = 512 / 32, kb = r / nblk, nb = r % nblk; p0_transpose_item(pw_w, 512, 512, PwT, 64 * kb, 32 * nb, 32 * nb, scr, lane); }
        }
        for (int i = bx * 512 + tid; i < M; i += G * 512) rowss[i] = 0.f;
        f32x4 gv[4];
#pragma unroll
        for (int j = 0; j < 4; ++j) gv[j] = *((const f32x4*)pre_g + lane + 64 * j);
        for (int m0 = gw; m0 < M; m0 += 4 * NGW) {
            f32x4 v[4][4]; float ss[4];
#pragma unroll
            for (int k = 0; k < 4; ++k) { const int m = m0 + k * NGW; const f32x4* xr = (const f32x4*)(x + (size_t)(m < M ? m : m0) * DMODEL) + lane;
#pragma unroll
                for (int j = 0; j < 4; ++j) v[k][j] = __builtin_nontemporal_load(xr + 64 * j); }
#pragma unroll
            for (int k = 0; k < 4; ++k) { ss[k] = 0.f;
#pragma unroll
                for (int j = 0; j < 4; ++j) ss[k] += (v[k][j].x * v[k][j].x + v[k][j].y * v[k][j].y) + (v[k][j].z * v[k][j].z + v[k][j].w * v[k][j].w); }
#pragma unroll
            for (int o = 1; o < 64; o <<= 1) {
#pragma unroll
                for (int k = 0; k < 4; ++k) ss[k] += __shfl_xor(ss[k], o); }
#pragma unroll
            for (int k = 0; k < 4; ++k) { const int m = m0 + k * NGW; if (m < M) { const float rstd = 1.f / sqrtf(ss[k] * (1.f / DMODEL) + 1e-6f);
                v2u* o8 = (v2u*)(XN + (size_t)m * DMODEL) + lane;
#pragma unroll
                for (int j = 0; j < 4; ++j) { const f32x4 y = v[k][j] * rstd * gv[j]; v2u o; o.x = pk2(y.x, y.y); o.y = pk2(y.z, y.w); o8[64 * j] = o; } } }
        }
    }
    xcd_barrier(bar);
    { const unsigned sig_ = __hip_atomic_load((unsigned*)(args.ws + WS_BAR) + SIG_WORD + gi, RLX_AGENT); one_xcc = (__builtin_popcount(sig_) == 1); }

    {
        PHASE_PTRS();
        pg8::Gemm g{XN, WinT, M, NIN, DMODEL}; pg8::StaticOrder S; S.init(M, NIN, G, bx);
        pg8::EpiIn E{HG, CGB, QB_, KB, VB, DGB, (unsigned*)(ws + WS_BAR) + NMG_WORD + 16 * gi};
        pg8::gemm_phase<pg8::EpiIn, pg8::StaticOrder, PG8_ALIGN, PG8_SP2>(L, g, S, E, wave);
    }
    GROUP_BAR();

    {
        PHASE_PTRS(); FRESH_TID();
        unsigned* ctlw = (unsigned*)(ws + WS_BAR); unsigned* nmx = ctlw + NMG_WORD + 16 * gi; unsigned* qg = ctlw + QG_WORD + 64 * gi;
        int Wt[8]; float sbmax = 0.f;
#pragma unroll
        for (int i = 0; i < 8; ++i) { const float qm = __uint_as_float(__hip_atomic_load(nmx + i, RLX_AGENT)), km = __uint_as_float(__hip_atomic_load(nmx + 8 + i, RLX_AGENT));
            const float Sb = 2.02f * sqrtf(qm * km);
            sbmax = fmaxf(sbmax, Sb);
            const float w = (2.f * Sb + 42.f) / (64.f * pg8::alibi_sl(i >> 1)); Wt[i] = w < 64.f ? (int)w + 1 : 64; }
        const unsigned qslot = LDSCTL_OFF + 64;
        const int NA = 128 * NB, convbase = (RPG / 32) * gi;
        if (sbmax <= 60.f) {
            int u = gj;
            while (u < NA) {
                const int b = gi * NB + (u >> 7), ul = u & 127; int qb, h, c;
                if (ul < 44) { qb = 15 - (ul >> 2); h = 2 + ((ul >> 1) & 1); c = ul & 1; }
                else if (ul < 76) { const int v = ul - 44; h = 1; qb = 15 - (v >> 1); c = v & 1; }
                else if (ul < 96) { const int v = ul - 76; qb = 4 - (v >> 2); h = 2 + ((v >> 1) & 1); c = v & 1; }
                else { const int v = ul - 96; h = 0; qb = 15 - (v >> 1); c = v & 1; }
                const int hc = 2 * h + c; int W = Wt[0];
#pragma unroll
                for (int i = 1; i < 8; ++i) W = (hc == i) ? Wt[i] : W;
                int T0 = 4 * qb - W; T0 = T0 > 0 ? (T0 & ~1) : 0;
                attn_body::attn_unit2(b, qb, (const attn_body::bf16*)(QB_ + h * 128 + c * 64), (const attn_body::bf16*)(KB + h * 128 + c * 64), (const attn_body::bf16*)(VB + h * 128),
                                      (attn_body::bf16*)(OB + h * 256 + c * 128), pg8::alibi_sl(h), pg8::alibi_c32(h), (char*)lds, wave, T0, qg, qslot);
                u = GS + (int)__builtin_amdgcn_readfirstlane(*(volatile LAS unsigned*)(L + qslot));
            }
            { const int ucur_ = convbase + (u - NA), qbase_ = convbase + GS - NA, uend_ = convbase + NA; PHASE_PTRS(); FRESH_TID();
              conv_phase_dyn(L, ucur_, (unsigned*)(ws + WS_BAR) + QG_WORD + 64 * gi, qbase_, uend_, HG, dw_w, dw_b, cln_g, cln_b, UB, tid, lane, wave); }
        } else {
        conv_phase(L, convbase + gj, GS, convbase + NA, HG, dw_w, dw_b, cln_g, cln_b, UB, tid, lane, wave);
        int u = gj;
        while (u < 2 * NA) {
            const int b = gi * NB + (u >> 8), r = u & 255, qb = 15 - (r >> 4), h = (r >> 2) & 3, c = (r >> 1) & 1, vh = r & 1;
            const int hc = 2 * h + c; int W = Wt[0];
#pragma unroll
            for (int i = 1; i < 8; ++i) W = (hc == i) ? Wt[i] : W;
            int T0 = 4 * qb - W; T0 = T0 > 0 ? (T0 & ~1) : 0;
            attn_body::attn_unit<8>(b, qb, (const attn_body::bf16*)(QB_ + h * 128 + c * 64), (const attn_body::bf16*)(KB + h * 128 + c * 64), (const attn_body::bf16*)(VB + h * 128 + vh * 64),
                                    (attn_body::bf16*)(OB + h * 256 + c * 128 + vh * 64), pg8::alibi_sl(h), pg8::alibi_c32(h), (char*)lds, wave, T0, qg, qslot);
            u = GS + (int)__builtin_amdgcn_readfirstlane(*(volatile LAS unsigned*)(L + qslot));
        }
        }
    }
    GROUP_BAR();

    {
        PHASE_PTRS();
        {
            pg8::Gemm g{UB, PwT, M, 512, 512}; pg8::StaticOrder S; S.init(M, 512, G, bx);
            pg8::EpiPw E{CGB, pw_b, YB};
            pg8::gemm_phase<pg8::EpiPw, pg8::StaticOrder, PG8_ALIGN, PG8_SP2>(L, g, S, E, wave);
        }
        FRESH_TID();
        const float lam = expf(wave_sum(lq1[lane] * lk1[lane])) - expf(wave_sum(lq2[lane] * lk2[lane])) + 0.2f;
        const int h = lane >> 4, ec = (lane & 15) * 8;
        float gs[8];
#pragma unroll
        for (int j = 0; j < 8; ++j) gs[j] = sub_g[ec + j] * 0.8f;
        for (int m0 = gwl; m0 < RPG; m0 += 4 * NGWL) {
            v4u a[4], bq[4], gt[4];
#pragma unroll
            for (int k = 0; k < 4; ++k) { const int ml = m0 + k * NGWL; const size_t m = (size_t)(RPG * gi + (ml < RPG ? ml : m0));
                a[k] = *(const v4u*)(OB + m * 1024 + h * 256 + ec); bq[k] = *(const v4u*)(OB + m * 1024 + h * 256 + 128 + ec); gt[k] = *(const v4u*)(DGB + m * 512 + h * 128 + ec); }
#pragma unroll
            for (int k = 0; k < 4; ++k) { const int ml = m0 + k * NGWL; if (ml >= RPG) continue; const int mm = RPG * gi + ml;
                const unsigned aw[4] = {a[k].x, a[k].y, a[k].z, a[k].w}, bw[4] = {bq[k].x, bq[k].y, bq[k].z, bq[k].w}, gw4[4] = {gt[k].x, gt[k].y, gt[k].z, gt[k].w};
                float o[8]; float ss = 0.f;
#pragma unroll
                for (int j = 0; j < 4; ++j) { o[2 * j] = pg8::bf_lo(aw[j]) - lam * pg8::bf_lo(bw[j]); o[2 * j + 1] = pg8::bf_hi(aw[j]) - lam * pg8::bf_hi(bw[j]); ss += o[2 * j] * o[2 * j] + o[2 * j + 1] * o[2 * j + 1]; }
                ss += __shfl_xor(ss, 1); ss += __shfl_xor(ss, 2); ss += __shfl_xor(ss, 4); ss += __shfl_xor(ss, 8);
                const float rstd = 1.f / sqrtf(ss * (1.f / 128.f) + 1e-6f);
                unsigned wv[4];
#pragma unroll
                for (int j = 0; j < 4; ++j) wv[j] = pk2(o[2 * j] * rstd * gs[2 * j] * pg8::bf_lo(gw4[j]), o[2 * j + 1] * rstd * gs[2 * j + 1] * pg8::bf_hi(gw4[j]));
                v4u w; w.x = wv[0]; w.y = wv[1]; w.z = wv[2]; w.w = wv[3];
                *(v4u*)(YB + (size_t)mm * 1024 + 512 + h * 128 + ec) = w; }
        }
    }
    GROUP_BAR();

    {
        PHASE_PTRS();
        pg8::Gemm g{YB, WoT, M, 1024, 1024}; pg8::StaticOrder S; S.init(M, 1024, G, bx);
        pg8::EpiOut E{Y2, rowss};
        pg8::gemm_phase<pg8::EpiOut, pg8::StaticOrder, PG8_ALIGN, PG8_SP2>(L, g, S, E, wave);
    }
    GROUP_BAR();

    {
        PHASE_PTRS(); FRESH_TID();
        f32x4 gv[4];
#pragma unroll
        for (int j = 0; j < 4; ++j) gv[j] = *((const f32x4*)post_g + lane + 64 * j);
        for (int m0 = gwl; m0 < RPG; m0 += 4 * NGWL) {
            f32x4 xv[4][4]; v2u yv[4][4]; float rs[4];
#pragma unroll
            for (int k = 0; k < 4; ++k) { const int ml = m0 + k * NGWL; const size_t m = (size_t)(RPG * gi + (ml < RPG ? ml : m0)); rs[k] = rowss[m];
                const f32x4* xr = (const f32x4*)(x + m * DMODEL) + lane; const v2u* yr = (const v2u*)(Y2 + m * 1024) + lane;
#pragma unroll
                for (int j = 0; j < 4; ++j) { xv[k][j] = __builtin_nontemporal_load(xr + 64 * j); yv[k][j] = yr[64 * j]; } }
#pragma unroll
            for (int k = 0; k < 4; ++k) { const int ml = m0 + k * NGWL; if (ml >= RPG) continue; const int mm = RPG * gi + ml;
                const float rstd = 1.f / sqrtf(rs[k] * (1.f / 1024.f) + 1e-6f); f32x4* orow = (f32x4*)(out + (size_t)mm * DMODEL) + lane;
#pragma unroll
                for (int j = 0; j < 4; ++j) { f32x4 o;
                    o.x = xv[k][j].x + pg8::bf_lo(yv[k][j].x) * rstd * gv[j].x; o.y = xv[k][j].y + pg8::bf_hi(yv[k][j].x) * rstd * gv[j].y; o.z = xv[k][j].z + pg8::bf_lo(yv[k][j].y) * rstd * gv[j].z; o.w = xv[k][j].w + pg8::bf_hi(yv[k][j].y) * rstd * gv[j].w;
                    __builtin_nontemporal_store(o, orow + 64 * j); } }
        }
    }
}

extern "C" void kernel_launch(void* const* d_in, const int* in_sizes, int n_in, void* d_out, int out_size, void* d_ws, size_t ws_size, hipStream_t stream) {
    static int grid = 0;
    if (grid == 0) {
        if (n_in != 16 || out_size != M * DMODEL || ws_size < WS_END) { fprintf(stderr, "kernel_launch: unexpected problem shape (n_in %d, out %d, ws %zu)\n", n_in, out_size, ws_size); grid = -1; return; }
        int dev = 0, cus = 0, per_cu = 0;
        hipGetDevice(&dev); hipDeviceGetAttribute(&cus, hipDeviceAttributeMultiprocessorCount, dev);
        hipFuncSetAttribute((const void*)fwd_megakernel, hipFuncAttributeMaxDynamicSharedMemorySize, LDS_BYTES);
        hipOccupancyMaxActiveBlocksPerMultiprocessor(&per_cu, (const void*)fwd_megakernel, NWAVES * 64, LDS_BYTES);
        if (per_cu < 1) { fprintf(stderr, "kernel_launch: occupancy query reports %d blocks per CU\n", per_cu); per_cu = 1; }
        (void)hipGetLastError();
        grid = cus;
    }
    if (grid < 0) return;
    (void)hipMemsetAsync((char*)d_ws + WS_BAR, 0, WS_BAR_BYTES, stream);
    Args a{};
    for (int i = 0; i < 16; ++i) a.in[i] = (const float*)d_in[i];
    a.out = (float*)d_out; a.ws = (unsigned char*)d_ws;
    void* kargs[] = {&a};
    hipError_t e = hipLaunchCooperativeKernel((const void*)fwd_megakernel, dim3(grid), dim3(NWAVES * 64), kargs, LDS_BYTES, stream);
    if (e != hipSuccess) fprintf(stderr, "cooperative launch failed: %s (grid %d)\n", hipGetErrorString(e), grid);
}
```

```cpp
#include <hip/hip_runtime.h>
#include <hip/hip_cooperative_groups.h>
#include <cstdio>
#include <cstdint>
namespace cg = cooperative_groups;
__device__ __forceinline__ int lane_id_asm() { int l; asm volatile("v_mbcnt_lo_u32_b32 %0, -1, 0\n\tv_mbcnt_hi_u32_b32 %0, -1, %0" : "=v"(l)); return l; }
namespace pg8 {
#define PG8_LAS __attribute__((address_space(3)))
typedef unsigned short bf16_t;
typedef short bf16x8 __attribute__((ext_vector_type(8)));
typedef float f32x4 __attribute__((ext_vector_type(4)));
typedef unsigned u32x4 __attribute__((ext_vector_type(4)));
constexpr int BM = 256, BK = 64, HALF = 128, HTB = HALF * BK * 2  , STAGE_BYTES = 8 * HTB, NXCD = 8, WGM = 4;

__host__ __device__ __forceinline__ int lds_byte(int r, int c) { const int st = (r >> 4) * 2 + (c >> 5), rr = r & 15, cc = c & 31, ob = rr * 64 + cc * 2; return st * 1024 + (ob ^ (((ob >> 9) & 1) << 5)); }
__host__ __device__ __forceinline__ void stage_rc(int b, int& R, int& C) { const int st = b / 1024, sb = b % 1024, swz = sb ^ (((sb >> 9) & 1) << 5); R = (st >> 1) * 16 + swz / 64; C = (st & 1) * 32 + (swz % 64) / 2; }
__host__ __device__ __forceinline__ int perm32(int rho) { const int n = rho >> 4, i = rho & 15; return 8 * (i >> 2) + 4 * n + (i & 3); }

struct Unit { int pm, pn; };
struct Gemm { const bf16_t* A; const bf16_t* Bt; int M, N, K; };

struct StaticOrder {
    int nM, nN, nwg, G, c;
    __host__ __device__ void init(int M, int N, int G_, int c_) { nM = M / BM; nN = N / BM; nwg = nM * nN; G = G_; c = c_; }
    __host__ __device__ bool next(int i, Unit& u) const {
        const long L = (long)i * G + c; if (L >= nwg) return false;
        int wgid = (int)L; { const int q = nwg / NXCD, r = nwg % NXCD, xcd = wgid % NXCD, off = wgid / NXCD; wgid = (xcd < r ? xcd * (q + 1) : r * (q + 1) + (xcd - r) * q) + off; }
        const int nig = WGM * nN, gid = wgid / nig, fm = gid * WGM, gsz = (nM - fm) < WGM ? (nM - fm) : WGM;
        u.pm = fm + ((wgid % nig) % gsz); u.pn = (wgid % nig) / gsz; return true;
    }
    __device__ __forceinline__ void a_ready(const Unit&) const {}
    __device__ __forceinline__ void done(const Unit&) const {}
};

__device__ __forceinline__ unsigned cvt_pk_bf16(float lo, float hi) { unsigned r; asm volatile("v_cvt_pk_bf16_f32 %0, %1, %2" : "=v"(r) : "v"(lo), "v"(hi)); return r; }

typedef float f32x2 __attribute__((ext_vector_type(2)));
__host__ __device__ __forceinline__ float alibi_c32(int h) { return h == 0 ? 2980.9579870417283f : h == 1 ? 7.38905609893065f : h == 2 ? 1.6487212707001282f : 1.1331484530668263f; }
__host__ __device__ __forceinline__ float alibi_sl(int h) { return h == 0 ? 0.36067376022224085f : h == 1 ? 0.09016844005556021f : h == 2 ? 0.022542110013890053f : 0.005635527503472513f; }
__device__ __forceinline__ float sigmoid_f(float v) { return __builtin_amdgcn_rcpf(1.0f + __builtin_amdgcn_exp2f(-1.4426950408889634f * v)); }
__device__ __forceinline__ float silu_f(float v) { return v * sigmoid_f(v); }
__device__ __forceinline__ float bf_lo(unsigned w) { return __uint_as_float(w << 16); }
__device__ __forceinline__ float bf_hi(unsigned w) { return __uint_as_float(w & 0xffff0000u); }
__device__ __forceinline__ u32x4 pack8(const f32x4 v0, const f32x4 v1) { u32x4 w; w.x = cvt_pk_bf16(v0[0], v0[1]); w.y = cvt_pk_bf16(v0[2], v0[3]); w.z = cvt_pk_bf16(v1[0], v1[1]); w.w = cvt_pk_bf16(v1[2], v1[3]); return w; }

struct EpiIn {
    static constexpr bool PERM = true, AFTER_DRAIN = false;
    bf16_t *Hg, *CG, *Q, *K, *V, *DG; unsigned* nmax;
    __device__ __forceinline__ void operator()(const f32x4 (&acc)[2][2][4][2], const Unit& u, int wr, int wc, int fr, int fq) const {
        const int row0 = u.pm * BM + wr * 64 + fr; const int pn = u.pn;
        if (pn < 4) {
            const int col = 128 * pn + wc * 32 + 8 * fq;
#pragma unroll
            for (int ai = 0; ai < 2; ++ai)
#pragma unroll
                for (int m = 0; m < 4; ++m) {
                    f32x4 h0, h1;
#pragma unroll
                    for (int j = 0; j < 4; ++j) { h0[j] = acc[ai][0][m][0][j] * sigmoid_f(acc[ai][1][m][0][j]); h1[j] = acc[ai][0][m][1][j] * sigmoid_f(acc[ai][1][m][1][j]); }
                    *(u32x4*)(Hg + (size_t)(row0 + ai * HALF + m * 16) * 512 + col) = pack8(h0, h1);
                }
        } else {
            const int role = (pn - 4) >> 1, colt = 256 * ((pn - 4) & 1) + wc * 32 + 8 * fq;
            bf16_t* base = role == 0 ? CG : role == 1 ? Q : role == 2 ? K : role == 3 ? V : DG;
            float mx[2] = {0.f, 0.f};
#pragma unroll
            for (int ai = 0; ai < 2; ++ai)
#pragma unroll
                for (int m = 0; m < 4; ++m)
#pragma unroll
                    for (int bj = 0; bj < 2; ++bj) {
                        f32x4 v0 = acc[ai][bj][m][0], v1 = acc[ai][bj][m][1];
                        if (role == 0 || role == 4) {
#pragma unroll
                            for (int j = 0; j < 4; ++j) { v0[j] = silu_f(v0[j]); v1[j] = silu_f(v1[j]); }
                        } else if (role == 1) { v0 = v0 * 0.18033688011112042f; v1 = v1 * 0.18033688011112042f; }
                        else if (role == 3) {
                            if (m >= 2) {
                                const int h = 2 * ((pn - 4) & 1) + bj;
                                const float c = alibi_c32(h);
                                v0 = v0 * c; v1 = v1 * c;
                            }
                        }
                        *(u32x4*)(base + (size_t)(row0 + ai * HALF + m * 16) * 512 + colt + bj * HALF) = pack8(v0, v1);
                        if (role == 1 || role == 2) { float ss = (v0[0] * v0[0] + v0[1] * v0[1]) + (v0[2] * v0[2] + v0[3] * v0[3]) + (v1[0] * v1[0] + v1[1] * v1[1]) + (v1[2] * v1[2] + v1[3] * v1[3]);
                            ss += __shfl_xor(ss, 16); ss += __shfl_xor(ss, 32); mx[bj] = fmaxf(mx[bj], ss); }
                    }
            if (role == 1 || role == 2) {
#pragma unroll
                for (int bj = 0; bj < 2; ++bj) { float v = mx[bj]; v = fmaxf(v, __shfl_xor(v, 1)); v = fmaxf(v, __shfl_xor(v, 2)); v = fmaxf(v, __shfl_xor(v, 4)); v = fmaxf(v, __shfl_xor(v, 8));
                    if (fr == 0 && fq == 0) atomicMax(nmax + (role - 1) * 8 + 4 * ((pn - 4) & 1) + 2 * bj + (wc >> 1), __float_as_uint(v)); }
            }
        }
    }
};
struct EpiPw {
    static constexpr bool PERM = true, AFTER_DRAIN = false;
    const bf16_t* CG; const float* bias; bf16_t* Y;
    __device__ __forceinline__ void operator()(const f32x4 (&acc)[2][2][4][2], const Unit& u, int wr, int wc, int fr, int fq) const {
        const int row0 = u.pm * BM + wr * 64 + fr; const int col0 = u.pn * BM + wc * 32 + 8 * fq;
        f32x4 bv[2][2];
#pragma unroll
        for (int bj = 0; bj < 2; ++bj)
#pragma unroll
            for (int n = 0; n < 2; ++n) bv[bj][n] = *(const f32x4*)(bias + col0 + bj * HALF + 4 * n);
#pragma unroll
        for (int ai = 0; ai < 2; ++ai)
#pragma unroll
            for (int m = 0; m < 4; ++m) { const size_t row = (size_t)(row0 + ai * HALF + m * 16);
#pragma unroll
                for (int bj = 0; bj < 2; ++bj) {
                    const u32x4 g = *(const u32x4*)(CG + row * 512 + col0 + bj * HALF);
                    f32x4 v0 = acc[ai][bj][m][0] + bv[bj][0], v1 = acc[ai][bj][m][1] + bv[bj][1];
                    v0[0] *= bf_lo(g.x); v0[1] *= bf_hi(g.x); v0[2] *= bf_lo(g.y); v0[3] *= bf_hi(g.y);
                    v1[0] *= bf_lo(g.z); v1[1] *= bf_hi(g.z); v1[2] *= bf_lo(g.w); v1[3] *= bf_hi(g.w);
                    *(u32x4*)(Y + row * 1024 + col0 + bj * HALF) = pack8(v0, v1);
                } }
    }
};
struct EpiOut {
    static constexpr bool PERM = true, AFTER_DRAIN = false;
    bf16_t* Y2; float* rowss;
    __device__ __forceinline__ void operator()(const f32x4 (&acc)[2][2][4][2], const Unit& u, int wr, int wc, int fr, int fq) const {
        const int row0 = u.pm * BM + wr * 64 + fr; const int col0 = u.pn * BM + wc * 32 + 8 * fq;
#pragma unroll
        for (int ai = 0; ai < 2; ++ai)
#pragma unroll
            for (int m = 0; m < 4; ++m) { const size_t row = (size_t)(row0 + ai * HALF + m * 16); float ss = 0.f;
#pragma unroll
                for (int bj = 0; bj < 2; ++bj) {
                    const f32x4 v0 = acc[ai][bj][m][0], v1 = acc[ai][bj][m][1];
                    ss += (v0[0] * v0[0] + v0[1] * v0[1]) + (v0[2] * v0[2] + v0[3] * v0[3]) + (v1[0] * v1[0] + v1[1] * v1[1]) + (v1[2] * v1[2] + v1[3] * v1[3]);
                    *(u32x4*)(Y2 + row * 1024 + col0 + bj * HALF) = pack8(v0, v1);
                }
                ss += __shfl_xor(ss, 16); ss += __shfl_xor(ss, 32);
                if (fq == 0) atomicAdd(rowss + row, ss);
            }
    }
};


template <class Epi, class Sched, bool ALIGN_EPI = false, bool SP2 = false>
__device__ __forceinline__ void gemm_phase(PG8_LAS unsigned char* lds, const Gemm g, const Sched& S, const Epi& E, int wid_in) {
    const int lane = lane_id_asm();
    int wid_o = wid_in; asm volatile("" : "+s"(wid_o)); const int wid = wid_o, tid = wid * 64 + lane, wr = wid >> 2, wc = wid & 3, fr = lane & 15, fq = lane >> 4;
    const int K = g.K, nt = K / BK;
    unsigned voffA[2], voffB[2];
#pragma unroll
    for (int i = 0; i < 2; ++i) { int R, C; stage_rc(tid * 16 + i * 8192, R, C); const int Rb = Epi::PERM ? ((R & ~31) + perm32(R & 31)) : R;
        voffA[i] = (unsigned)(R * K + C) * 2u; voffB[i] = (unsigned)(Rb * K + C) * 2u; }
    const size_t kstep = (size_t)(BK * 2);
    const size_t hstep = (size_t)HALF * K * 2;
    const size_t tstep = 2 * hstep;
    const unsigned ldsw = (unsigned)wid * 1024u;
    const int aoff = lds_byte(wr * 64 + fr, fq * 8), boff = lds_byte(wc * 32 + fr, fq * 8);
#define PG8_SA(b, h) (((b) * 2 + (h)) * HTB)
#define PG8_SB(b, h) ((4 + (b) * 2 + (h)) * HTB)
#define PG8_STAGE(bufoff, gbase, voff) do { _Pragma("unroll") for (int _i = 0; _i < 2; ++_i) \
        __builtin_amdgcn_global_load_lds((const unsigned*)((const char*)(gbase) + (voff)[_i]), (PG8_LAS unsigned*)(lds + (bufoff) + ldsw + _i * 8192), 16, 0, 0); } while (0)
#define PG8_LDA(dst, b, h) do { _Pragma("unroll") for (int m = 0; m < 4; ++m) _Pragma("unroll") for (int k = 0; k < 2; ++k) dst[m][k] = *(const PG8_LAS bf16x8*)(lds + PG8_SA(b, h) + aoff + m * 2048 + k * 1024); } while (0)
#define PG8_LDB(dst, b, h) do { _Pragma("unroll") for (int n = 0; n < 2; ++n) _Pragma("unroll") for (int k = 0; k < 2; ++k) dst[n][k] = *(const PG8_LAS bf16x8*)(lds + PG8_SB(b, h) + boff + n * 2048 + k * 1024); } while (0)
#define PG8_MMA(ai, bj, At, Bt) do { __builtin_amdgcn_s_setprio(1); _Pragma("unroll") for (int m = 0; m < 4; ++m) _Pragma("unroll") for (int n = 0; n < 2; ++n) _Pragma("unroll") for (int k = 0; k < 2; ++k) \
        acc[ai][bj][m][n] = __builtin_amdgcn_mfma_f32_16x16x32_bf16(Bt[n][k], At[m][k], acc[ai][bj][m][n], 0, 0, 0); __builtin_amdgcn_s_setprio(0); } while (0)
#define PG8_WAIT_V(n) asm volatile("s_waitcnt vmcnt(" #n ")" ::: "memory")
#define PG8_WAIT_L(n) asm volatile("s_waitcnt lgkmcnt(" #n ")" ::: "memory")
#define PG8_BAR __builtin_amdgcn_s_barrier()
#define PG8_SCHED __builtin_amdgcn_sched_barrier(0)
    Unit cur, nxt; int ui = 0;
    if (!S.next(0, cur)) return;
    f32x4 acc[2][2][4][2];
#pragma unroll
    for (int a = 0; a < 2; ++a)
#pragma unroll
        for (int b = 0; b < 2; ++b)
#pragma unroll
            for (int m = 0; m < 4; ++m)
#pragma unroll
                for (int n = 0; n < 2; ++n) acc[a][b][m][n] = (f32x4){0.f, 0.f, 0.f, 0.f};
    bf16x8 At[4][2], B0[2][2], B1[2][2];
    const char* cA = (const char*)g.A + (size_t)cur.pm * tstep; const char* cB = (const char*)g.Bt + (size_t)cur.pn * tstep;
    S.a_ready(cur);
    if constexpr (SP2) {
        PG8_STAGE(PG8_SB(0, 0), cB, voffB); PG8_STAGE(PG8_SB(0, 1), cB + hstep, voffB); PG8_STAGE(PG8_SA(0, 0), cA, voffA); PG8_STAGE(PG8_SA(0, 1), cA + hstep, voffA);
        if (wr == 1) PG8_BAR;
        PG8_WAIT_V(2); PG8_BAR;
        PG8_STAGE(PG8_SB(1, 0), cB + kstep, voffB); PG8_STAGE(PG8_SA(1, 0), cA + kstep, voffA); PG8_STAGE(PG8_SB(1, 1), cB + hstep + kstep, voffB);
        PG8_WAIT_V(6); PG8_BAR;
    } else {
        PG8_STAGE(PG8_SB(0, 0), cB, voffB); PG8_STAGE(PG8_SA(0, 0), cA, voffA); PG8_STAGE(PG8_SB(0, 1), cB + hstep, voffB); PG8_STAGE(PG8_SA(0, 1), cA + hstep, voffA);
        if (wr == 1) PG8_BAR;
        PG8_WAIT_V(4); PG8_BAR;
        PG8_STAGE(PG8_SB(1, 0), cB + kstep, voffB); PG8_STAGE(PG8_SA(1, 0), cA + kstep, voffA); PG8_STAGE(PG8_SB(1, 1), cB + hstep + kstep, voffB);
        PG8_WAIT_V(6); PG8_BAR;
    }
    for (;;) {
        const bool has_next = S.next(ui + 1, nxt);
        const char* nA = has_next ? (const char*)g.A + (size_t)nxt.pm * tstep : cA; const char* nB = has_next ? (const char*)g.Bt + (size_t)nxt.pn * tstep : cB;
        for (int t = 0; t < nt; t += 2) {
            const bool last = (t == nt - 2);
            const char* a1 = cA + (size_t)(t + 1) * kstep;
            const char* a2 = last ? nA : cA + (size_t)(t + 2) * kstep; const char* b2 = last ? nB : cB + (size_t)(t + 2) * kstep;
            const char* a3 = a2 + kstep; const char* b3 = b2 + kstep;
            if (last && has_next) S.a_ready(nxt);
            if constexpr (SP2) {
            PG8_LDB(B0, 0, 0); PG8_LDB(B1, 0, 1); PG8_SCHED; PG8_LDA(At, 0, 0); PG8_STAGE(PG8_SA(1, 1), a1 + hstep, voffA);
            PG8_WAIT_V(8); PG8_WAIT_L(0); PG8_BAR; PG8_MMA(0, 0, At, B0); PG8_MMA(0, 1, At, B1); PG8_BAR; PG8_SCHED;
            PG8_LDA(At, 0, 1); PG8_STAGE(PG8_SB(0, 0), b2, voffB); PG8_STAGE(PG8_SB(0, 1), b2 + hstep, voffB); PG8_STAGE(PG8_SA(0, 0), a2, voffA);
            PG8_WAIT_V(8); PG8_WAIT_L(0); PG8_BAR; PG8_MMA(1, 0, At, B0); PG8_MMA(1, 1, At, B1); PG8_BAR; PG8_SCHED;
            PG8_LDB(B0, 1, 0); PG8_LDB(B1, 1, 1); PG8_SCHED; PG8_LDA(At, 1, 0); PG8_STAGE(PG8_SA(0, 1), a2 + hstep, voffA);
            PG8_WAIT_V(8); PG8_WAIT_L(0); PG8_BAR; PG8_MMA(0, 0, At, B0); PG8_MMA(0, 1, At, B1); PG8_BAR; PG8_SCHED;
            PG8_LDA(At, 1, 1); PG8_STAGE(PG8_SB(1, 0), b3, voffB); PG8_STAGE(PG8_SB(1, 1), b3 + hstep, voffB); PG8_STAGE(PG8_SA(1, 0), a3, voffA);
            PG8_WAIT_V(8); PG8_WAIT_L(0); PG8_BAR; PG8_MMA(1, 0, At, B0); PG8_MMA(1, 1, At, B1); PG8_BAR; PG8_SCHED;
            } else {
            PG8_LDB(B0, 0, 0); PG8_SCHED; PG8_LDA(At, 0, 0); PG8_STAGE(PG8_SA(1, 1), a1 + hstep, voffA);
            PG8_WAIT_L(8); PG8_BAR; PG8_WAIT_L(0); PG8_MMA(0, 0, At, B0); PG8_BAR; PG8_SCHED;
            PG8_LDB(B1, 0, 1); PG8_STAGE(PG8_SB(0, 0), b2, voffB);
            PG8_BAR; PG8_WAIT_L(0); PG8_MMA(0, 1, At, B1); PG8_BAR;
            PG8_LDA(At, 0, 1); PG8_STAGE(PG8_SA(0, 0), a2, voffA);
            PG8_BAR; PG8_WAIT_L(0); PG8_MMA(1, 0, At, B0); PG8_BAR; PG8_SCHED;
            PG8_STAGE(PG8_SB(0, 1), b2 + hstep, voffB);
            PG8_WAIT_V(6); PG8_BAR; PG8_MMA(1, 1, At, B1); PG8_BAR;
            PG8_LDB(B0, 1, 0); PG8_SCHED; PG8_LDA(At, 1, 0); PG8_STAGE(PG8_SA(0, 1), a2 + hstep, voffA);
            PG8_WAIT_L(8); PG8_BAR; PG8_WAIT_L(0); PG8_MMA(0, 0, At, B0); PG8_BAR; PG8_SCHED;
            PG8_LDB(B1, 1, 1); PG8_STAGE(PG8_SB(1, 0), b3, voffB);
            PG8_BAR; PG8_WAIT_L(0); PG8_MMA(0, 1, At, B1); PG8_BAR;
            PG8_LDA(At, 1, 1); PG8_STAGE(PG8_SA(1, 0), a3, voffA);
            PG8_BAR; PG8_WAIT_L(0); PG8_MMA(1, 0, At, B0); PG8_BAR; PG8_SCHED;
            PG8_STAGE(PG8_SB(1, 1), b3 + hstep, voffB);
            PG8_WAIT_V(6); PG8_BAR; PG8_MMA(1, 1, At, B1); PG8_BAR;
            }
        }
        if constexpr (ALIGN_EPI) { if (wr == 0) PG8_BAR; }
        if constexpr (!Epi::AFTER_DRAIN) { E(acc, cur, wr, wc, fr, fq); S.done(cur); }
        if (!has_next) break;
#pragma unroll
        for (int a = 0; a < 2; ++a)
#pragma unroll
            for (int b = 0; b < 2; ++b)
#pragma unroll
                for (int m = 0; m < 4; ++m)
#pragma unroll
                    for (int n = 0; n < 2; ++n) acc[a][b][m][n] = (f32x4){0.f, 0.f, 0.f, 0.f};
        cur = nxt; cA = nA; cB = nB; ++ui;
        if constexpr (ALIGN_EPI) { if (wr == 1) PG8_BAR; }
    }
    PG8_WAIT_V(0);
    if constexpr (!ALIGN_EPI) { if (wr == 0) PG8_BAR; }
    PG8_BAR;
    if constexpr (Epi::AFTER_DRAIN) { E.fused(acc, cur, wr, wc, fr, fq, lds, wid, lane); S.done(cur); }
#undef PG8_SA
#undef PG8_SB
#undef PG8_STAGE
#undef PG8_LDA
#undef PG8_LDB
#undef PG8_MMA
#undef PG8_WAIT_V
#undef PG8_WAIT_L
#undef PG8_BAR
#undef PG8_SCHED
}
}

#ifndef PG8_SP2
#define PG8_SP2 true
#endif
#ifndef PG8_ALIGN
#define PG8_ALIGN true
#endif
#include <hip/hip_bf16.h>
#include <cmath>
namespace attn_body {
using bf16=__hip_bfloat16;
using bf16x8=__attribute__((ext_vector_type(8)))short;
using s16x4=__attribute__((ext_vector_type(4)))short;
using f32x16=__attribute__((ext_vector_type(16)))float;
using u32x4=__attribute__((ext_vector_type(4)))unsigned;
constexpr int BATCH=8,SEQ=4096,D=64;
constexpr int QP=512,KP=512,VP=512,OP=1024;
constexpr int NW=8,QBLK=32,QB=QBLK*NW,KVBLK=64,NQB=SEQ/QB;
constexpr int ATTN_UNIT_ROWS=QB;
__device__ __forceinline__ int crow(int r,int hi){return (r&3)+8*(r>>2)+4*hi;}
#define SBAR() __builtin_amdgcn_sched_barrier(0)
__device__ __forceinline__ void cmask(f32x16&p0,f32x16&p1,int jb,int qrel,int hi){
  const float NEG=-INFINITY; int kb=64*jb+4*hi;
  #pragma unroll
  for(int r=0;r<16;++r){int kv=kb+(r&3)+8*(r>>2); if(kv>qrel)p0[r]=NEG; if(kv+32>qrel)p1[r]=NEG;}
}

constexpr int NSLOT=3, SLOTB=8192;
constexpr int LDS_K=0, LDS_V=NSLOT*SLOTB, LDS_WS=2*NSLOT*SLOTB, LDS_OST=LDS_WS+NW*64*4, LDS_BYTES=LDS_OST+NW*4096;
constexpr float C2=0.125f*1.4426950408889634f;
__device__ __forceinline__ void glds16(const void*sbase,unsigned voff,unsigned lds_dst){unsigned keep;
  asm volatile("s_mov_b32 %0, m0\n\ts_mov_b32 m0, %2\n\ts_nop 0\n\tglobal_load_lds_dwordx4 %1, %3\n\ts_mov_b32 m0, %0":"=&s"(keep):"v"(voff),"s"(lds_dst),"s"(sbase):"memory");}
__device__ __forceinline__ float max3f(float a,float b,float c){float r;asm("v_max3_f32 %0, %1, %2, %3":"=v"(r):"v"(a),"v"(b),"v"(c));return r;}
__device__ __forceinline__ float max2f(float a,float b){float r;asm("v_max_f32_e32 %0, %1, %2":"=v"(r):"v"(a),"v"(b));return r;}
__device__ __forceinline__ float fadd_s(float a,float b){float r;asm("v_add_f32_e32 %0, %1, %2":"=v"(r):"v"(a),"v"(b));return r;}
__device__ __forceinline__ float fsub_s(float a,float b){float r;asm("v_sub_f32_e32 %0, %1, %2":"=v"(r):"v"(a),"v"(b));return r;}
typedef float f32x2_t __attribute__((ext_vector_type(2))); typedef __bf16 bf16x2_t __attribute__((ext_vector_type(2)));
__device__ __forceinline__ unsigned cvtpk_s(float lo,float hi){f32x2_t v={lo,hi};bf16x2_t b=__builtin_convertvector(v,bf16x2_t);return __builtin_bit_cast(unsigned,b);}
#define WAIT_BAR(N) asm volatile("s_waitcnt vmcnt(" #N ") lgkmcnt(0)\n\ts_barrier":::"memory")

__device__ __forceinline__ void qkt(f32x16&p0,f32x16&p1,const char*Kslot,const bf16x8*qr,const f32x16&negm,int r32,int hi){
  const char*kb=Kslot+hi*1024+r32*16;
  #pragma unroll
  for(int d0=0;d0<4;++d0){
    const bf16x8 b0=*reinterpret_cast<const bf16x8*>(kb+d0*2048);
    const bf16x8 b1=*reinterpret_cast<const bf16x8*>(kb+d0*2048+512);
    if(d0==0){p0=__builtin_amdgcn_mfma_f32_32x32x16_bf16(b0,qr[0],negm,0,0,0);p1=__builtin_amdgcn_mfma_f32_32x32x16_bf16(b1,qr[0],negm,0,0,0);}
    else{p0=__builtin_amdgcn_mfma_f32_32x32x16_bf16(b0,qr[d0],p0,0,0,0);p1=__builtin_amdgcn_mfma_f32_32x32x16_bf16(b1,qr[d0],p1,0,0,0);}}
}
typedef __attribute__((address_space(3))) const char* lds_cptr;
typedef short v4i16_t __attribute__((ext_vector_type(4)));
__device__ __forceinline__ void kload8(bf16x8*kf,lds_cptr kp){
  kf[0]=*(const __attribute__((address_space(3))) bf16x8*)(kp);      kf[1]=*(const __attribute__((address_space(3))) bf16x8*)(kp+512);
  kf[2]=*(const __attribute__((address_space(3))) bf16x8*)(kp+2048); kf[3]=*(const __attribute__((address_space(3))) bf16x8*)(kp+2560);
  kf[4]=*(const __attribute__((address_space(3))) bf16x8*)(kp+4096); kf[5]=*(const __attribute__((address_space(3))) bf16x8*)(kp+4608);
  kf[6]=*(const __attribute__((address_space(3))) bf16x8*)(kp+6144); kf[7]=*(const __attribute__((address_space(3))) bf16x8*)(kp+6656);
}
__device__ __forceinline__ void kload2(bf16x8*kf,lds_cptr kp,int j){ kf[2*j]=*(const __attribute__((address_space(3))) bf16x8*)(kp+j*2048); kf[2*j+1]=*(const __attribute__((address_space(3))) bf16x8*)(kp+j*2048+512); }
__device__ __forceinline__ s16x4 vtr(lds_cptr p){ return __builtin_bit_cast(s16x4,__builtin_amdgcn_ds_read_tr16_b64_v4i16((__attribute__((address_space(3))) v4i16_t*)p)); }
__device__ __forceinline__ float rowmax(const f32x16&p0,const f32x16&p1){
  float a=max3f(p0[0],p0[1],p1[0]),b=max3f(p0[2],p0[3],p1[1]);a=max3f(a,p1[2],p1[3]);
  #pragma unroll
  for(int r=4;r<16;r+=4){a=max3f(a,p0[r],p0[r+1]);b=max3f(b,p0[r+2],p0[r+3]);a=max3f(a,p1[r],p1[r+1]);b=max3f(b,p1[r+2],p1[r+3]);}
  const float m=max2f(a,b);
  auto rr=__builtin_amdgcn_permlane32_swap(__float_as_uint(m),__float_as_uint(m),false,false);
  return max2f(__uint_as_float(rr[0]),__uint_as_float(rr[1]));
}
__device__ __forceinline__ void pv(f32x16*o,int vb,bf16x8 pa0,bf16x8 pa1,bf16x8 pa2,bf16x8 pa3){
  #pragma unroll
  for(int d0=0;d0<2;++d0){s16x4 lo[4],hi[4];
    #pragma unroll
    for(int ks=0;ks<4;++ks){
      asm volatile("ds_read_b64_tr_b16 %0,%1 offset:%c2":"=&v"(lo[ks]):"v"(vb),"i"(d0*4096+ks*1024):"memory");
      asm volatile("ds_read_b64_tr_b16 %0,%1 offset:%c2":"=&v"(hi[ks]):"v"(vb),"i"(d0*4096+ks*1024+512):"memory");}
    asm volatile("s_waitcnt lgkmcnt(0)":::"memory");SBAR();
    #define PK(k) (bf16x8){lo[k][0],lo[k][1],lo[k][2],lo[k][3],hi[k][0],hi[k][1],hi[k][2],hi[k][3]}
    o[d0]=__builtin_amdgcn_mfma_f32_32x32x16_bf16(pa0,PK(0),o[d0],0,0,0);
    o[d0]=__builtin_amdgcn_mfma_f32_32x32x16_bf16(pa1,PK(1),o[d0],0,0,0);
    o[d0]=__builtin_amdgcn_mfma_f32_32x32x16_bf16(pa2,PK(2),o[d0],0,0,0);
    o[d0]=__builtin_amdgcn_mfma_f32_32x32x16_bf16(pa3,PK(3),o[d0],0,0,0);
    #undef PK
  }
}

#ifndef ATTN_STORE16
#define ATTN_STORE16(p,v) (*(u32x4*)(p)=(v))
#endif
template<int THRL> __device__ __forceinline__ void attn_unit(int b,int qb,const bf16*Qh,const bf16*__restrict__ Kh0,const bf16*__restrict__ Vh0,bf16*Oh,float sl,float c32,char*shm,int wid_in,int T0,unsigned*qctr,unsigned qslot){
  const int lane=lane_id_asm(),r32=lane&31,hi=lane>>5; int wid=wid_in; asm volatile("":"+s"(wid));
  const long rowbase=(long)b*SEQ; const int q0=qb*QB;
  const bf16*Qw=Qh+(rowbase+q0+wid*QBLK)*QP;
  const bf16*Kh=Kh0+(rowbase+(long)T0*KVBLK)*KP,*Vh=Vh0+(rowbase+(long)T0*KVBLK)*VP;
  const unsigned lds0=(unsigned)(uintptr_t)shm;
  float*wsf=(float*)(shm+LDS_WS)+wid*64;
  const unsigned koff=(unsigned)(lane*KP+wid*8)*2u;
  const unsigned voff=(unsigned)((16*(wid&3)+(lane>>2))*VP+(wid>>2)*32+(lane&3)*8)*2u;
  const unsigned kdst=lds0+LDS_K+wid*1024, vdst=lds0+LDS_V+wid*1024;
  #define DMA_K(t,slot) glds16(Kh+(long)(t)*KVBLK*KP,koff,(unsigned)__builtin_amdgcn_readfirstlane(kdst+(slot)))
  #define DMA_V(t,slot) glds16(Vh+(long)(t)*KVBLK*VP,voff,(unsigned)__builtin_amdgcn_readfirstlane(vdst+(slot)))
  const char*Kbase=shm+LDS_K; bf16x8 kf[8];
  const lds_cptr shm3=(lds_cptr)shm; const lds_cptr kp0=shm3+LDS_K+hi*1024+r32*16; const lds_cptr vp0=shm3+LDS_V+((lane>>4)&1)*32+(lane&3)*8+(4*hi+((lane&15)>>2))*64;
  const int NT=(q0+QB)/KVBLK-T0;
  DMA_K(0,0);DMA_V(0,0);DMA_K(1,SLOTB);
  bf16x8 qr[4];
  #pragma unroll
  for(int d0=0;d0<4;++d0)qr[d0]=*reinterpret_cast<const bf16x8*>(&Qw[(long)r32*QP+d0*16+hi*8]);
  float l_reg=0.f;f32x16 o[2];o[0]=f32x16{};o[1]=f32x16{};f32x16 negm;
  { float hb_=sl*(float)(4*hi); asm volatile("":"+v"(hb_));
    _Pragma("unroll") for(int r=0;r<16;++r)negm[r]=hb_+sl*(float)((r&3)+8*(r>>2)); }
  asm volatile("":"+v"(negm)); const float sl64=64.f*sl;
  const int qrel=wid*QBLK+r32;
  #define CMASK(P0,P1,t) do{int jb_=(t)-(NT-4); if(jb_>=0)cmask(P0,P1,jb_,qrel,hi);}while(0)
  bool resc=false;
  #define START(P0,P1) do{ const float rm=rowmax(P0,P1); resc=false; \
    { const float dl=rm; \
      _Pragma("unroll") for(int r=0;r<16;++r){P0[r]=fsub_s(P0[r],dl);P1[r]=fsub_s(P1[r],dl);} \
      _Pragma("unroll") for(int r=0;r<16;++r)negm[r]-=dl; asm volatile("":"+v"(negm)); } \
    _Pragma("unroll") for(int r=0;r<16;++r)P0[r]=__builtin_amdgcn_exp2f(P0[r]); }while(0)
  #define RESC() do{ if(resc){ asm volatile("s_waitcnt lgkmcnt(0)":::"memory"); \
      _Pragma("unroll") for(int d_=0;d_<2;++d_) _Pragma("unroll") for(int r=0;r<16;++r)o[d_][r]*=wsf[crow(r,hi)]; } }while(0)
  f32x16 pA0,pA1,pB0,pB1;
  int sl_prev=0,sl_cur=0,sl_next=SLOTB;
  #define ROT() do{sl_prev=sl_cur;sl_cur=sl_next;sl_next=(sl_next==(NSLOT-1)*SLOTB)?0:sl_next+SLOTB;}while(0)
  DMA_K(2,2*SLOTB);
  unsigned nxt_=0u; if(wid==0&&lane==0)nxt_=__hip_atomic_fetch_add(qctr,1u,__ATOMIC_RELAXED,__HIP_MEMORY_SCOPE_AGENT);
  WAIT_BAR(3);
  qkt(pA0,pA1,Kbase,qr,negm,r32,hi);asm volatile("s_nop 15\n\ts_nop 7":"+v"(pA0),"+v"(pA1));CMASK(pA0,pA1,0);
  START(pA0,pA1);
  _Pragma("unroll") for(int r=0;r<16;++r)pA1[r]=__builtin_amdgcn_exp2f(pA1[r]);
  WAIT_BAR(0);
  if(wid==0&&lane==0)*(volatile __attribute__((address_space(3))) unsigned*)(shm3+qslot)=nxt_;
  DMA_K(3,0);DMA_V(1,SLOTB);
  ROT();
  kload8(kf,kp0+sl_cur);
  WAIT_BAR(2);
  s16x4 vlo[8],vhi[8]; u32x4 pw0,pw1,pw2,pw3;
  #define PKW(P,B) cvtpk_s(P[B],P[B+1])
  #define PAF(k) __builtin_bit_cast(bf16x8,pw##k)
  #define VFR(i) (bf16x8){vlo[i][0],vlo[i][1],vlo[i][2],vlo[i][3],vhi[i][0],vhi[i][1],vhi[i][2],vhi[i][3]}
  #define PIN(x) asm volatile("":"+v"(x))
  #define MX3(a,b,c) __builtin_fmaxf(__builtin_fmaxf((a),(b)),(c))
  #define GAPA(MF,SA,A0,A1,A2,A3,W0,W1,PW) do{ MF; SA+=A0; SA+=A1; SA+=A2; SA+=A3; PIN(SA); W0; W1; PIN(PW); SBAR(); }while(0)
  #define GAPA2(MF,A0,A1,B0_,B1_,W0,W1,PW) do{ MF; sacc+=A0; sacc+=A1; saccb=B0_+B1_; PIN(sacc); PIN(saccb); W0; W1; PIN(PW); SBAR(); }while(0)
  #define EX(v) __builtin_amdgcn_exp2f(v)
  #define GAPB(MF,X,B) do{ MF; X[B]=EX(X[B]); X[B+1]=EX(X[B+1]); X[B+2]=EX(X[B+2]); X[B+3]=EX(X[B+3]); PIN(X); SBAR(); }while(0)
  #define VRD(i) do{ vlo[i]=vtr(vp_+(((i)>>2)*4096+((i)&3)*1024)); vhi[i]=vtr(vp_+(((i)>>2)*4096+((i)&3)*1024+512)); }while(0)
  #define KRD(G,j) do{ if(G){ kload2(kf,kp0+sl_next,j); SBAR(); } }while(0)
  #define STEP(C0,C1,P0,P1,t,GK,GV,GL) do{ SBAR(); \
    _Pragma("unroll") for(int r=0;r<16;++r)negm[r]+=sl64; asm volatile("":"+v"(negm)); SBAR(); \
    const lds_cptr vp_=vp0+sl_prev; \
    VRD(0); SBAR(); float sacc=(P0[0]+P0[1]); float saccb; \
    GAPA(C0=__builtin_amdgcn_mfma_f32_32x32x16_bf16(kf[0],qr[0],negm,0,0,0), sacc, P0[2],P0[3],P0[4],P0[5],     pw0[0]=PKW(P0,0), pw0[1]=PKW(P0,2), pw0); \
    VRD(4); SBAR(); GAPA(C1=__builtin_amdgcn_mfma_f32_32x32x16_bf16(kf[1],qr[0],negm,0,0,0), sacc, P0[6],P0[7],P0[8],P0[9],     pw0[2]=PKW(P0,4), pw0[3]=PKW(P0,6), pw0); \
    VRD(1); SBAR(); GAPA(C0=__builtin_amdgcn_mfma_f32_32x32x16_bf16(kf[2],qr[1],C0,0,0,0),   sacc, P0[10],P0[11],P0[12],P0[13], pw1[0]=PKW(P0,8), pw1[1]=PKW(P0,10), pw1); \
    VRD(5); SBAR(); GAPA2(C1=__builtin_amdgcn_mfma_f32_32x32x16_bf16(kf[3],qr[1],C1,0,0,0),   P0[14],P0[15],P1[0],P1[1],   pw1[2]=PKW(P0,12),pw1[3]=PKW(P0,14), pw1); \
    VRD(2); SBAR(); GAPA(C0=__builtin_amdgcn_mfma_f32_32x32x16_bf16(kf[4],qr[2],C0,0,0,0),   saccb, P1[2],P1[3],P1[4],P1[5],     pw2[0]=PKW(P1,0), pw2[1]=PKW(P1,2), pw2); \
    VRD(6); SBAR(); GAPA(C1=__builtin_amdgcn_mfma_f32_32x32x16_bf16(kf[5],qr[2],C1,0,0,0),   saccb, P1[6],P1[7],P1[8],P1[9],     pw2[2]=PKW(P1,4), pw2[3]=PKW(P1,6), pw2); \
    VRD(3); SBAR(); GAPA(C0=__builtin_amdgcn_mfma_f32_32x32x16_bf16(kf[6],qr[3],C0,0,0,0),   saccb, P1[10],P1[11],P1[12],P1[13], pw3[0]=PKW(P1,8), pw3[1]=PKW(P1,10), pw3); \
    VRD(7); SBAR(); GAPA(C1=__builtin_amdgcn_mfma_f32_32x32x16_bf16(kf[7],qr[3],C1,0,0,0),   saccb, P1[14],P1[15],0.f,0.f,       pw3[2]=PKW(P1,12),pw3[3]=PKW(P1,14), pw3); \
    l_reg+=sacc+c32*saccb; \
    if(GK){DMA_K((t)+3,sl_cur);} if(GV){DMA_V((t)+1,sl_next);} \
    CMASK(C0,C1,t); \
    { float a=MX3(C0[0],C0[1],C1[0]),b=MX3(C0[2],C0[3],C1[1]); a=MX3(a,C1[2],C1[3]); \
      _Pragma("unroll") for(int r=4;r<16;r+=4){a=MX3(a,C0[r],C0[r+1]);b=MX3(b,C0[r+2],C0[r+3]);a=MX3(a,C1[r],C1[r+1]);b=MX3(b,C1[r+2],C1[r+3]);} \
      float rm=__builtin_fmaxf(a,b); { auto rr=__builtin_amdgcn_permlane32_swap(__float_as_uint(rm),__float_as_uint(rm),false,false); rm=__builtin_fmaxf(__uint_as_float(rr[0]),__uint_as_float(rr[1])); } \
      resc=false; \
      if(__builtin_expect(__any(rm>(float)THRL),0)){ const float dl=__builtin_fmaxf(rm,0.f); \
        _Pragma("unroll") for(int r=0;r<16;++r){C0[r]-=dl;C1[r]-=dl;} \
        _Pragma("unroll") for(int r=0;r<16;++r)negm[r]-=dl; asm volatile("":"+v"(negm)); \
        const float f=__builtin_amdgcn_exp2f(-dl); l_reg*=f; if(hi==0)wsf[r32]=f; resc=true; } } \
    SBAR(); \
    GAPB(o[0]=__builtin_amdgcn_mfma_f32_32x32x16_bf16(PAF(0),VFR(0),o[0],0,0,0), C0,0); \
    GAPB(o[1]=__builtin_amdgcn_mfma_f32_32x32x16_bf16(PAF(0),VFR(4),o[1],0,0,0), C0,4); \
    KRD(GL,0); GAPB(o[0]=__builtin_amdgcn_mfma_f32_32x32x16_bf16(PAF(1),VFR(1),o[0],0,0,0), C0,8); \
    KRD(GL,1); GAPB(o[1]=__builtin_amdgcn_mfma_f32_32x32x16_bf16(PAF(1),VFR(5),o[1],0,0,0), C0,12); \
    KRD(GL,2); GAPB(o[0]=__builtin_amdgcn_mfma_f32_32x32x16_bf16(PAF(2),VFR(2),o[0],0,0,0), C1,0); \
    KRD(GL,3); GAPB(o[1]=__builtin_amdgcn_mfma_f32_32x32x16_bf16(PAF(2),VFR(6),o[1],0,0,0), C1,4); \
    GAPB(o[0]=__builtin_amdgcn_mfma_f32_32x32x16_bf16(PAF(3),VFR(3),o[0],0,0,0), C1,8); \
    GAPB(o[1]=__builtin_amdgcn_mfma_f32_32x32x16_bf16(PAF(3),VFR(7),o[1],0,0,0), C1,12); \
    }while(0)
  int t=1;
  #undef CMASK
  #define CMASK(P0,P1,t) do{}while(0)
  for(;t+5<NT;t+=2){
    STEP(pB0,pB1,pA0,pA1,t,true,true,true);     WAIT_BAR(2); RESC(); ROT();
    STEP(pA0,pA1,pB0,pB1,t+1,true,true,true);   WAIT_BAR(2); RESC(); ROT();
  }
  #undef CMASK
  #define CMASK(P0,P1,t) do{int jb_=(t)-(NT-4); if(jb_>=0)cmask(P0,P1,jb_,qrel,hi);}while(0)
  #define ENDW(tt) do{ if((tt)+3<NT){WAIT_BAR(2);} else if((tt)+2<NT){WAIT_BAR(1);} else {WAIT_BAR(0);} }while(0)
  for(;t+1<NT;t+=2){
    STEP(pB0,pB1,pA0,pA1,t,(t+3<NT),(t+1<NT),(t+1<NT));       ENDW(t);   RESC(); ROT();
    STEP(pA0,pA1,pB0,pB1,t+1,(t+4<NT),(t+2<NT),(t+2<NT));     ENDW(t+1); RESC(); ROT();
  }
  STEP(pB0,pB1,pA0,pA1,NT-1,false,false,false); RESC();
  { float sacc=pB0[0]+pB0[1]; _Pragma("unroll") for(int r=2;r<16;++r)sacc+=pB0[r]; float saccb=pB1[0]+pB1[1]; _Pragma("unroll") for(int r=2;r<16;++r)saccb+=pB1[r]; l_reg+=sacc+c32*saccb;
    pw0=(u32x4){PKW(pB0,0),PKW(pB0,2),PKW(pB0,4),PKW(pB0,6)};pw1=(u32x4){PKW(pB0,8),PKW(pB0,10),PKW(pB0,12),PKW(pB0,14)};pw2=(u32x4){PKW(pB1,0),PKW(pB1,2),PKW(pB1,4),PKW(pB1,6)};pw3=(u32x4){PKW(pB1,8),PKW(pB1,10),PKW(pB1,12),PKW(pB1,14)};
    SBAR(); pv(o,(int)(unsigned)(unsigned long)(vp0+sl_cur),PAF(0),PAF(1),PAF(2),PAF(3)); }
  #undef PKW
  #undef PAF
  #undef VFR
  #undef PIN
  #undef MX3
  #undef GAPA
  #undef GAPA2
  #undef GAPB
  #undef EX
  #undef VRD
  #undef KRD
  #undef STEP
  #undef ENDW
  {auto rr=__builtin_amdgcn_permlane32_swap(__float_as_uint(l_reg),__float_as_uint(l_reg),false,false);l_reg=__uint_as_float(rr[0])+__uint_as_float(rr[1]);}
  if(hi==0)wsf[32+r32]=l_reg;asm volatile("s_waitcnt lgkmcnt(0)":::"memory");
  float rli[16];
  #pragma unroll
  for(int r=0;r<16;++r)rli[r]=__builtin_amdgcn_rcpf(wsf[32+crow(r,hi)]);
  bf16*Ow=Oh+(rowbase+q0+wid*QBLK)*OP;
  { bf16*stg=(bf16*)(shm+LDS_OST)+wid*2048;
    #pragma unroll
    for(int r=0;r<16;++r){const int orow=crow(r,hi);
      #pragma unroll
      for(int d0=0;d0<2;++d0)stg[orow*64+d0*32+r32]=__float2bfloat16(o[d0][r]*rli[r]);}
    asm volatile("s_waitcnt lgkmcnt(0)":::"memory");
    #pragma unroll
    for(int i=0;i<4;++i){const int row=i*8+(lane>>3),ch=lane&7; const u32x4 v=*(const u32x4*)(stg+row*64+ch*8); ATTN_STORE16(Ow+(long)row*OP+ch*8,v);} }
  asm volatile("s_waitcnt lgkmcnt(0)\n\ts_barrier":::"memory");
  #undef DMA_K
  #undef DMA_V
  #undef CMASK
  #undef START
  #undef RESC
  #undef ROT
}
constexpr int ATTN_LDS_BYTES=LDS_BYTES;
constexpr int A2_K=0, A2_V=4*8192, A2_WS=A2_V+3*16384, A2_BYTES=A2_WS+NW*256;
__device__ __forceinline__ void attn_unit2(int b,int qb,const bf16*Qh,const bf16*__restrict__ Kh0,const bf16*__restrict__ Vh0,bf16*Oh,float sl,float c32,char*shm,int wid_in,int T0,unsigned*qctr,unsigned qslot){
  const int lane=lane_id_asm(),r32=lane&31,hi=lane>>5; int wid=wid_in; asm volatile("":"+s"(wid));
  const long rowbase=(long)b*SEQ; const int q0=qb*QB;
  const bf16*Qw=Qh+(rowbase+q0+wid*QBLK)*QP;
  const bf16*Kh=Kh0+(rowbase+(long)T0*KVBLK)*KP,*Vh=Vh0+(rowbase+(long)T0*KVBLK)*VP;
  const unsigned lds0=(unsigned)(uintptr_t)shm;
  float*wsf=(float*)(shm+A2_WS)+wid*64;
  const unsigned koff=(unsigned)(lane*KP+wid*8)*2u;
  const unsigned voff=(unsigned)((16*(wid&3)+(lane>>2))*VP+(wid>>2)*32+(lane&3)*8)*2u;
  const unsigned kdst=lds0+A2_K+wid*1024, vdst=lds0+A2_V+wid*1024;
  #define DMA_K(t,slot) glds16(Kh+(long)(t)*KVBLK*KP,koff,(unsigned)__builtin_amdgcn_readfirstlane(kdst+(slot)))
  #define DMA_V0(t,slot) glds16(Vh+(long)(t)*KVBLK*VP,voff,(unsigned)__builtin_amdgcn_readfirstlane(vdst+2*(slot)))
  #define DMA_V1(t,slot) glds16(Vh+(long)(t)*KVBLK*VP+64,voff,(unsigned)__builtin_amdgcn_readfirstlane(vdst+2*(slot)+8192))
  #define DMA_V(t,slot) do{ DMA_V0(t,slot); DMA_V1(t,slot); }while(0)
  const char*Kbase=shm+A2_K; bf16x8 kf[8];
  const lds_cptr shm3=(lds_cptr)shm; const lds_cptr kp0=shm3+A2_K+hi*1024+r32*16; const lds_cptr vp0=shm3+A2_V+((lane>>4)&1)*32+(lane&3)*8+(4*hi+((lane&15)>>2))*64;
  const int NT=(q0+QB)/KVBLK-T0;
  DMA_K(0,0);DMA_V(0,0);DMA_K(1,8192);
  bf16x8 qr[4];
  #pragma unroll
  for(int d0=0;d0<4;++d0)qr[d0]=*reinterpret_cast<const bf16x8*>(&Qw[(long)r32*QP+d0*16+hi*8]);
  float l_reg=0.f;f32x16 o[4];o[0]=f32x16{};o[1]=f32x16{};o[2]=f32x16{};o[3]=f32x16{};f32x16 negm;
  { float hb_=sl*(float)(64*T0-q0-QBLK*wid-r32+4*hi); asm volatile("":"+v"(hb_));
    _Pragma("unroll") for(int r=0;r<16;++r)negm[r]=hb_+sl*(float)((r&3)+8*(r>>2)); }
  asm volatile("":"+v"(negm)); const float sl64=64.f*sl;
  const int qrel=wid*QBLK+r32;
  #define CMASK(P0,P1,t) do{int jb_=(t)-(NT-4); if(jb_>=0)cmask(P0,P1,jb_,qrel,hi);}while(0)
  int sl_prev=0,sl_cur=0,sl_next=8192;
  #define ROT() do{sl_prev=sl_cur;sl_cur=sl_next;sl_next=(sl_next==2*8192)?0:sl_next+8192;}while(0)
  DMA_K(2,2*8192);
  #define KSL(t) (((t)&3)*8192)
  unsigned nxt_=0u; if(wid==0&&lane==0)nxt_=__hip_atomic_fetch_add(qctr,1u,__ATOMIC_RELAXED,__HIP_MEMORY_SCOPE_AGENT);
  WAIT_BAR(3);
  u32x4 pwA0,pwA1,pwA2,pwA3,pwB0,pwB1,pwB2,pwB3;
  #define PKW(P,B) cvtpk_s(P[B],P[B+1])
  #define EX(v) __builtin_amdgcn_exp2f(v)
  #define PIN(x) asm volatile("":"+v"(x))
  { f32x16 c0,c1; qkt(c0,c1,Kbase,qr,negm,r32,hi); CMASK(c0,c1,0);
    float sa=0.f,sb=0.f;
    _Pragma("unroll") for(int r=0;r<16;++r){c0[r]=EX(c0[r]);c1[r]=EX(c1[r]);sa+=c0[r];sb+=c1[r];}
    l_reg+=sa+c32*sb;
    pwA0=(u32x4){PKW(c0,0),PKW(c0,2),PKW(c0,4),PKW(c0,6)};pwA1=(u32x4){PKW(c0,8),PKW(c0,10),PKW(c0,12),PKW(c0,14)};pwA2=(u32x4){PKW(c1,0),PKW(c1,2),PKW(c1,4),PKW(c1,6)};pwA3=(u32x4){PKW(c1,8),PKW(c1,10),PKW(c1,12),PKW(c1,14)}; }
  WAIT_BAR(0);
  if(wid==0&&lane==0)*(volatile __attribute__((address_space(3))) unsigned*)(shm3+qslot)=nxt_;
  DMA_K(3,3*8192);DMA_V(1,8192);
  ROT();
  kload2(kf,kp0+KSL(1),0); kload2(kf,kp0+KSL(1),1);
  _Pragma("unroll") for(int r=0;r<16;++r)negm[r]+=sl64;
  s16x4 vlo[8],vhi[8];
  #define PAFI(PI,k) __builtin_bit_cast(bf16x8,PI##k)
  #define VFR(i) (bf16x8){vlo[i][0],vlo[i][1],vlo[i][2],vlo[i][3],vhi[i][0],vhi[i][1],vhi[i][2],vhi[i][3]}
  #define VRD(ks,d) do{ vlo[((ks)&1)*4+(d)]=vtr(vp_+((d)*4096+(ks)*1024)); vhi[((ks)&1)*4+(d)]=vtr(vp_+((d)*4096+(ks)*1024+512)); }while(0)
  #define GAPQ(MF) do{ MF; SBAR(); }while(0)
  #define GAPN(MF,B) do{ MF; negm[B]+=sl64; negm[B+1]+=sl64; negm[B+2]+=sl64; negm[B+3]+=sl64; PIN(negm); SBAR(); }while(0)
  #define GAPB(MF,RD,X,SA,B,PO,W) do{ MF; RD; X[B]=EX(X[B]); X[B+1]=EX(X[B+1]); SA+=X[B]; SA+=X[B+1]; PO[W]=PKW(X,B); PIN(X); PIN(SA); PIN(PO); SBAR(); }while(0)
  #define STEP2(PI,PO,t,GK,GV,GL) do{ SBAR(); \
    const lds_cptr vp_=vp0+2*sl_prev; const lds_cptr kq_=kp0+KSL(t); f32x16 C0,C1; float sa=0.f,sb=0.f; \
    kload2(kf,kq_,2); VRD(0,0); SBAR(); kload2(kf,kq_,3); VRD(0,1); SBAR(); \
    GAPQ(C0=__builtin_amdgcn_mfma_f32_32x32x16_bf16(kf[0],qr[0],negm,0,0,0)); \
    VRD(0,2); SBAR(); GAPQ(C1=__builtin_amdgcn_mfma_f32_32x32x16_bf16(kf[1],qr[0],negm,0,0,0)); \
    VRD(0,3); SBAR(); GAPN(C0=__builtin_amdgcn_mfma_f32_32x32x16_bf16(kf[2],qr[1],C0,0,0,0),0); \
    VRD(1,0); SBAR(); GAPN(C1=__builtin_amdgcn_mfma_f32_32x32x16_bf16(kf[3],qr[1],C1,0,0,0),4); \
    VRD(1,1); SBAR(); GAPN(C0=__builtin_amdgcn_mfma_f32_32x32x16_bf16(kf[4],qr[2],C0,0,0,0),8); \
    VRD(1,2); SBAR(); GAPN(C1=__builtin_amdgcn_mfma_f32_32x32x16_bf16(kf[5],qr[2],C1,0,0,0),12); \
    VRD(1,3); SBAR(); GAPQ(C0=__builtin_amdgcn_mfma_f32_32x32x16_bf16(kf[6],qr[3],C0,0,0,0)); \
    GAPQ(C1=__builtin_amdgcn_mfma_f32_32x32x16_bf16(kf[7],qr[3],C1,0,0,0)); \
    CMASK(C0,C1,t); SBAR(); \
    GAPB(o[0]=__builtin_amdgcn_mfma_f32_32x32x16_bf16(PAFI(PI,0),VFR(0),o[0],0,0,0), VRD(2,0), C0,sa,0, PO##0,0); \
    GAPB(o[1]=__builtin_amdgcn_mfma_f32_32x32x16_bf16(PAFI(PI,0),VFR(1),o[1],0,0,0), VRD(2,1), C0,sa,2, PO##0,1); \
    GAPB(o[2]=__builtin_amdgcn_mfma_f32_32x32x16_bf16(PAFI(PI,0),VFR(2),o[2],0,0,0), VRD(2,2), C0,sa,4, PO##0,2); \
    GAPB(o[3]=__builtin_amdgcn_mfma_f32_32x32x16_bf16(PAFI(PI,0),VFR(3),o[3],0,0,0), VRD(2,3), C0,sa,6, PO##0,3); \
    GAPB(o[0]=__builtin_amdgcn_mfma_f32_32x32x16_bf16(PAFI(PI,1),VFR(4),o[0],0,0,0), VRD(3,0), C0,sa,8, PO##1,0); \
    GAPB(o[1]=__builtin_amdgcn_mfma_f32_32x32x16_bf16(PAFI(PI,1),VFR(5),o[1],0,0,0), VRD(3,1), C0,sa,10, PO##1,1); \
    GAPB(o[2]=__builtin_amdgcn_mfma_f32_32x32x16_bf16(PAFI(PI,1),VFR(6),o[2],0,0,0), VRD(3,2), C0,sa,12, PO##1,2); \
    GAPB(o[3]=__builtin_amdgcn_mfma_f32_32x32x16_bf16(PAFI(PI,1),VFR(7),o[3],0,0,0), VRD(3,3), C0,sa,14, PO##1,3); \
    GAPB(o[0]=__builtin_amdgcn_mfma_f32_32x32x16_bf16(PAFI(PI,2),VFR(0),o[0],0,0,0), if(GK){DMA_K((t)+3,KSL((t)+3));}, C1,sb,0, PO##2,0); \
    GAPB(o[1]=__builtin_amdgcn_mfma_f32_32x32x16_bf16(PAFI(PI,2),VFR(1),o[1],0,0,0), if(GL){kload2(kf,kp0+KSL((t)+1),0);}, C1,sb,2, PO##2,1); \
    GAPB(o[2]=__builtin_amdgcn_mfma_f32_32x32x16_bf16(PAFI(PI,2),VFR(2),o[2],0,0,0), if(GV){DMA_V0((t)+1,sl_next);}, C1,sb,4, PO##2,2); \
    GAPB(o[3]=__builtin_amdgcn_mfma_f32_32x32x16_bf16(PAFI(PI,2),VFR(3),o[3],0,0,0), if(GL){kload2(kf,kp0+KSL((t)+1),1);}, C1,sb,6, PO##2,3); \
    GAPB(o[0]=__builtin_amdgcn_mfma_f32_32x32x16_bf16(PAFI(PI,3),VFR(4),o[0],0,0,0), if(GV){DMA_V1((t)+1,sl_next);}, C1,sb,8, PO##3,0); \
    GAPB(o[1]=__builtin_amdgcn_mfma_f32_32x32x16_bf16(PAFI(PI,3),VFR(5),o[1],0,0,0), (void)0, C1,sb,10, PO##3,1); \
    GAPB(o[2]=__builtin_amdgcn_mfma_f32_32x32x16_bf16(PAFI(PI,3),VFR(6),o[2],0,0,0), (void)0, C1,sb,12, PO##3,2); \
    GAPB(o[3]=__builtin_amdgcn_mfma_f32_32x32x16_bf16(PAFI(PI,3),VFR(7),o[3],0,0,0), (void)0, C1,sb,14, PO##3,3); \
    l_reg+=sa+c32*sb; \
    }while(0)
  int t=1;
  #undef CMASK
  #define CMASK(P0,P1,t) do{}while(0)
  for(;t+5<NT;t+=2){
    STEP2(pwA,pwB,t,true,true,true);     WAIT_BAR(3); ROT();
    STEP2(pwB,pwA,t+1,true,true,true);   WAIT_BAR(3); ROT();
  }
  #undef CMASK
  #define CMASK(P0,P1,t) do{int jb_=(t)-(NT-4); if(jb_>=0)cmask(P0,P1,jb_,qrel,hi);}while(0)
  #define ENDW(tt) do{ if((tt)+3<NT){WAIT_BAR(3);} else if((tt)+2<NT){WAIT_BAR(2);} else {WAIT_BAR(0);} }while(0)
  for(;t+1<NT;t+=2){
    STEP2(pwA,pwB,t,(t+3<NT),(t+1<NT),(t+1<NT));       ENDW(t);   ROT();
    STEP2(pwB,pwA,t+1,(t+4<NT),(t+2<NT),(t+2<NT));     ENDW(t+1); ROT();
  }
  STEP2(pwA,pwB,NT-1,false,false,false);
  { const int vb=(int)(unsigned)(unsigned long)(vp0+2*sl_cur);
    #pragma unroll
    for(int d0=0;d0<4;++d0){s16x4 lo[4],hh[4];
      #pragma unroll
      for(int ks=0;ks<4;++ks){
        asm volatile("ds_read_b64_tr_b16 %0,%1 offset:%c2":"=&v"(lo[ks]):"v"(vb),"i"(d0*4096+ks*1024):"memory");
        asm volatile("ds_read_b64_tr_b16 %0,%1 offset:%c2":"=&v"(hh[ks]):"v"(vb),"i"(d0*4096+ks*1024+512):"memory");}
      asm volatile("s_waitcnt lgkmcnt(0)":::"memory");SBAR();
      #define PK(k) (bf16x8){lo[k][0],lo[k][1],lo[k][2],lo[k][3],hh[k][0],hh[k][1],hh[k][2],hh[k][3]}
      o[d0]=__builtin_amdgcn_mfma_f32_32x32x16_bf16(PAFI(pwB,0),PK(0),o[d0],0,0,0);
      o[d0]=__builtin_amdgcn_mfma_f32_32x32x16_bf16(PAFI(pwB,1),PK(1),o[d0],0,0,0);
      o[d0]=__builtin_amdgcn_mfma_f32_32x32x16_bf16(PAFI(pwB,2),PK(2),o[d0],0,0,0);
      o[d0]=__builtin_amdgcn_mfma_f32_32x32x16_bf16(PAFI(pwB,3),PK(3),o[d0],0,0,0);
      #undef PK
    } }
  {auto rr=__builtin_amdgcn_permlane32_swap(__float_as_uint(l_reg),__float_as_uint(l_reg),false,false);l_reg=__uint_as_float(rr[0])+__uint_as_float(rr[1]);}
  if(hi==0)wsf[32+r32]=l_reg;
  asm volatile("s_waitcnt lgkmcnt(0)\n\ts_barrier":::"memory");
  float rli[16];
  #pragma unroll
  for(int r=0;r<16;++r)rli[r]=__builtin_amdgcn_rcpf(wsf[32+crow(r,hi)]);
  bf16*Ow=Oh+(rowbase+q0+wid*QBLK)*OP;
  { bf16*stg=(bf16*)(shm)+wid*4096;
    #pragma unroll
    for(int r=0;r<16;++r){const int orow=crow(r,hi);
      #pragma unroll
      for(int d0=0;d0<4;++d0)stg[orow*128+d0*32+r32]=__float2bfloat16(o[d0][r]*rli[r]);}
    asm volatile("s_waitcnt lgkmcnt(0)":::"memory");
    #pragma unroll
    for(int i=0;i<8;++i){const int row=i*4+(lane>>4),ch=lane&15; const u32x4 v=*(const u32x4*)(stg+row*128+ch*8); ATTN_STORE16(Ow+(long)row*OP+ch*8,v);} }
  asm volatile("s_waitcnt lgkmcnt(0)\n\ts_barrier":::"memory");
  #undef DMA_K
  #undef DMA_V
  #undef DMA_V0
  #undef DMA_V1
  #undef CMASK
  #undef ROT
  #undef PKW
  #undef EX
  #undef PIN
  #undef PAFI
  #undef VFR
  #undef VRD
  #undef KSL
  #undef GAPQ
  #undef GAPN
  #undef GAPB
  #undef STEP2
  #undef ENDW
}
#undef SBAR
#undef WAIT_BAR
}

constexpr int NWAVES = 8;
constexpr int M = 32768, DMODEL = 1024, NIN = 3584, SEQL = 4096;
constexpr size_t MiB = 1u << 20;
constexpr size_t WS_ROWSS = 0;
constexpr size_t WS_WIN = 2 * MiB, WS_WO = 10 * MiB, WS_PW = 12 * MiB;
constexpr size_t WS_XN = 16 * MiB, WS_O = WS_XN;
constexpr size_t WS_HG = 80 * MiB, WS_CG = 112 * MiB, WS_Q = 144 * MiB, WS_K = 176 * MiB, WS_V = 208 * MiB, WS_DG = 240 * MiB, WS_U = 272 * MiB;
constexpr size_t WS_Y = 304 * MiB, WS_Y2 = 368 * MiB, WS_END = 432 * MiB;
constexpr int RING_BYTES = 131072, LDS_BYTES = 147456, LDSCTL_OFF = RING_BYTES;
constexpr size_t WS_BAR = 512 * 1024, WS_BAR_BYTES = 24576;
constexpr int NMAX_WORD = 3600, QCTR_WORD = 3712, GB_WORD = 4096, QG_WORD = 4608, NMG_WORD = 5120, GG_WORD = 5376, SIG_WORD = 5888;
#define GAS __attribute__((address_space(1)))
#define LAS __attribute__((address_space(3)))
typedef unsigned short bf16;
typedef unsigned v4u __attribute__((ext_vector_type(4)));
typedef unsigned v2u __attribute__((ext_vector_type(2)));
typedef float f32x4 __attribute__((ext_vector_type(4)));
typedef float f32x2 __attribute__((ext_vector_type(2)));
#define LDS_WAIT() asm volatile("s_waitcnt lgkmcnt(0)" ::: "memory")
__device__ __forceinline__ unsigned pk2(float lo, float hi) { return pg8::cvt_pk_bf16(lo, hi); }
__device__ __forceinline__ float wave_sum(float v) {
#pragma unroll
    for (int o = 1; o < 64; o <<= 1) v += __shfl_xor(v, o);
    return v;
}
__device__ __forceinline__ void p0_transpose_item(const float* W, int K, int N, bf16* WT, int k0, int n0, int dst_row0, LAS float* scr, int lane) {
#pragma unroll
    for (int i = 0; i < 32; ++i) { const int kk = 2 * i + (lane >> 5); scr[kk * 33 + (lane & 31)] = W[(size_t)(k0 + kk) * N + n0 + (lane & 31)]; }
    LDS_WAIT(); asm volatile("" ::: "memory");
    const int c = lane & 7;
#pragma unroll
    for (int j = 0; j < 4; ++j) { const int n = (lane >> 3) + 8 * j; const LAS float* p = scr + (8 * c) * 33 + n;
        v4u o; o.x = pk2(p[0 * 33], p[1 * 33]); o.y = pk2(p[2 * 33], p[3 * 33]); o.z = pk2(p[4 * 33], p[5 * 33]); o.w = pk2(p[6 * 33], p[7 * 33]);
        *(v4u*)(WT + (size_t)(dst_row0 + n) * K + k0 + 8 * c) = o; }
    LDS_WAIT(); asm volatile("" ::: "memory");
}
__device__ __forceinline__ int win_dst_row(int n0) {
    if (n0 >= 1024) return n0;
    if (n0 < 512) return 256 * (n0 >> 7) + (n0 & 127);
    const int n1 = n0 - 512; return 256 * (n1 >> 7) + 128 + (n1 & 127);
}

#define RLX_AGENT __ATOMIC_RELAXED, __HIP_MEMORY_SCOPE_AGENT
#define XB_TMO      128
#define XB_XCNT(j)  (256  + 64 * (j))
#define XB_XSUB(j)  (1280 + 64 * (j))
#define XB_XGEN(j)  (2304 + 64 * (j))
#define XB_TOP      3328
#define XB_TOPGEN   3392
#define XCD_BAR_WORDS 3456
#define XB_SPIN_CAP (1u << 18)

__device__ __forceinline__ unsigned xb_ld(unsigned* p)              { return __hip_atomic_load(p, __ATOMIC_RELAXED, __HIP_MEMORY_SCOPE_AGENT); }
__device__ __forceinline__ unsigned xb_add(unsigned* p, unsigned v) { return __hip_atomic_fetch_add(p, v, __ATOMIC_RELAXED, __HIP_MEMORY_SCOPE_AGENT); }
__device__ __forceinline__ unsigned xb_xcc_id() { return (unsigned)__builtin_amdgcn_s_getreg((3 << 11) | 20) & 0xFu; }
#define XB_SPIN(cond, bar) do { unsigned _sp = 0; while (cond) { __builtin_amdgcn_s_sleep(1); \
    if ((++_sp & 255u) == 0u) { if (xb_ld(&(bar)[XB_TMO])) break; if (_sp > XB_SPIN_CAP) { atomicAdd(&(bar)[XB_TMO], 1u); break; } } } } while (0)

struct XcdBarrier {
    unsigned* bar; unsigned x;
    volatile LAS unsigned* st;
};

__device__ __forceinline__ XcdBarrier xcd_barrier_post(unsigned* bar, volatile LAS unsigned* st) {
    XcdBarrier b; b.bar = bar; b.x = xb_xcc_id(); b.st = st;
    if (threadIdx.x == 0) (void)xb_add(&bar[XB_XCNT(b.x)], 1u);
    return b;
}
__device__ __forceinline__ void xcd_barrier_complete(unsigned* bar, unsigned x, unsigned& nloc, unsigned& nx) {
    const unsigned G = gridDim.x * gridDim.y * gridDim.z;
    unsigned sum, cnt, mine, sp = 0u;
    for (;;) {
        sum = 0u; cnt = 0u; mine = 0u;
#pragma unroll
        for (unsigned j = 0; j < 16; ++j) { const unsigned c = xb_ld(&bar[XB_XCNT(j)]); sum += c; cnt += (c > 0u) ? 1u : 0u; mine = (j == x) ? c : mine; }
        if (sum == G) break;
        __builtin_amdgcn_s_sleep(1);
        if ((++sp & 255u) == 0u) { if (xb_ld(&bar[XB_TMO])) break; if (sp > XB_SPIN_CAP) { atomicAdd(&bar[XB_TMO], 1u); break; } }
    }
    nloc = mine > 0u ? mine : 1u; nx = cnt > 0u ? cnt : 1u;
}

__device__ __forceinline__ void xcd_barrier(const XcdBarrier& b) {
    asm volatile("s_waitcnt vmcnt(0)" ::: "memory");
    __syncthreads();
    if (threadIdx.x == 0) {
        unsigned* bar = b.bar;
        __builtin_amdgcn_s_waitcnt(0);
        unsigned nloc = b.st[0], nx = b.st[1];
        if (nloc == 0u) { xcd_barrier_complete(bar, b.x, nloc, nx); b.st[0] = nloc; b.st[1] = nx; }
        const unsigned old = xb_add(&bar[XB_XSUB(b.x)], 1u);
        const unsigned gen = old / nloc;
        if (old + 1u == (gen + 1u) * nloc) {
            __builtin_amdgcn_fence(__ATOMIC_RELEASE, "agent");
            asm volatile("s_waitcnt vmcnt(0)" ::: "memory");
            const unsigned og = xb_add(&bar[XB_TOP], 1u);
            const unsigned tg = og / nx;
            if (og + 1u == (tg + 1u) * nx) xb_add(&bar[XB_TOPGEN], 1u);
            else XB_SPIN(xb_ld(&bar[XB_TOPGEN]) == tg, bar);
            __builtin_amdgcn_fence(__ATOMIC_ACQUIRE, "agent");
            xb_add(&bar[XB_XGEN(b.x)], 1u);
            asm volatile("s_waitcnt vmcnt(0)" ::: "memory");
        } else {
            XB_SPIN(xb_ld(&bar[XB_XGEN(b.x)]) == gen, bar);
            __builtin_amdgcn_fence(__ATOMIC_ACQUIRE, "agent");
            asm volatile("s_waitcnt vmcnt(0)" ::: "memory");
        }
    }
    __syncthreads();
}

__device__ __forceinline__ void group_barrier(unsigned* ctr, unsigned target) {
    asm volatile("s_waitcnt vmcnt(0)" ::: "memory");
    __syncthreads();
    if (threadIdx.x == 0) {
        __builtin_amdgcn_fence(__ATOMIC_RELEASE, "agent");
        asm volatile("s_waitcnt vmcnt(0)" ::: "memory");
        __hip_atomic_fetch_add(ctr, 1u, __ATOMIC_RELAXED, __HIP_MEMORY_SCOPE_AGENT);
        unsigned sp = 0u;
        while (__hip_atomic_load(ctr, __ATOMIC_RELAXED, __HIP_MEMORY_SCOPE_AGENT) < target && ++sp < (1u << 22)) __builtin_amdgcn_s_sleep(1);
        __builtin_amdgcn_fence(__ATOMIC_ACQUIRE, "agent");
        asm volatile("s_waitcnt vmcnt(0)" ::: "memory");
    }
    __syncthreads();
}

__device__ __forceinline__ void group_barrier_1xcc(unsigned* ctr, unsigned* gen, unsigned target, unsigned k) {
    asm volatile("s_waitcnt vmcnt(0)" ::: "memory");
    __syncthreads();
    if (threadIdx.x == 0) {
        const unsigned old = __hip_atomic_fetch_add(ctr, 1u, __ATOMIC_RELAXED, __HIP_MEMORY_SCOPE_AGENT);
        if (old + 1u == target) {
            __builtin_amdgcn_fence(__ATOMIC_RELEASE, "agent");
            asm volatile("s_waitcnt vmcnt(0)" ::: "memory");
            __hip_atomic_fetch_add(gen, 1u, __ATOMIC_RELAXED, __HIP_MEMORY_SCOPE_AGENT);
        } else { unsigned sp = 0u; while (__hip_atomic_load(gen, __ATOMIC_RELAXED, __HIP_MEMORY_SCOPE_AGENT) < k && ++sp < (1u << 22)) __builtin_amdgcn_s_sleep(1); }
        __builtin_amdgcn_fence(__ATOMIC_ACQUIRE, "agent");
        asm volatile("s_waitcnt vmcnt(0)" ::: "memory");
    }
    __syncthreads();
}

constexpr int CONV_IN_BYTES = 62 * 1024;
__device__ __forceinline__ void conv_phase(LAS unsigned char* lds, int u0, int ustride, int nunits, const bf16* Hg, const float* dw_w, const float* dw_b, const float* ln_g, const float* ln_b, bf16* U, int tid, int lane, int wave) {
    const int cp = tid & 255, tg = tid >> 8;
    f32x2 w[31];
#pragma unroll
    for (int j = 0; j < 31; ++j) w[j] = *(const f32x2*)(dw_w + j * 512 + 2 * cp);
    const f32x2 bias = *(const f32x2*)(dw_b + 2 * cp);
    f32x4 gg[2], bb[2];
#pragma unroll
    for (int j = 0; j < 2; ++j) { gg[j] = *((const f32x4*)ln_g + lane + 64 * j); bb[j] = *((const f32x4*)ln_b + lane + 64 * j); }
    v4u pre[8];
#define CONV_PREFETCH(unit) do { const int row0_ = (unit) * 32, t0_ = row0_ & (SEQL - 1); _Pragma("unroll") for (int k = 0; k < 8; ++k) { const int i = tid + 512 * k, r = i >> 6, ch = i & 63; pre[k] = (v4u){0u, 0u, 0u, 0u}; \
        if (i < 62 * 64 && t0_ - 30 + r >= 0) pre[k] = *(const v4u*)(Hg + (size_t)(row0_ - 30 + r) * 512 + ch * 8); } } while (0)
    if (u0 < nunits) CONV_PREFETCH(u0);
    for (int unit = u0; unit < nunits; unit += ustride) {
        const int row0 = unit * 32;
#pragma unroll
        for (int k = 0; k < 8; ++k) { const int i = tid + 512 * k, r = i >> 6, ch = i & 63; if (i < 62 * 64) *(LAS v4u*)(lds + r * 1024 + ch * 16) = pre[k]; }
        __syncthreads();
        if (unit + ustride < nunits) CONV_PREFETCH(unit + ustride);
#pragma unroll 1
        for (int g = 0; g < 2; ++g) {
            const int tl0 = tg * 16 + g * 8;
            f32x2 acc[8];
#pragma unroll
            for (int o = 0; o < 8; ++o) acc[o] = bias;
#pragma unroll
            for (int i = 0; i < 38; ++i) { const unsigned wv = *(const LAS unsigned*)(lds + (tl0 + i) * 1024 + cp * 4); const f32x2 x = {pg8::bf_lo(wv), pg8::bf_hi(wv)};
#pragma unroll
                for (int o = 0; o < 8; ++o) { const int j = i - o; if (j >= 0 && j <= 30) acc[o] += w[j] * x; } }
#pragma unroll
            for (int o = 0; o < 8; ++o) *(LAS f32x2*)(lds + CONV_IN_BYTES + (tl0 + o) * 2048 + cp * 8) = acc[o];
        }
        __syncthreads();
        f32x4 v[4][2]; float s1[4], s2[4];
#pragma unroll
        for (int k = 0; k < 4; ++k) { const int tl = wave * 4 + k; s1[k] = 0.f;
#pragma unroll
            for (int j = 0; j < 2; ++j) { v[k][j] = *(const LAS f32x4*)(lds + CONV_IN_BYTES + tl * 2048 + (lane + 64 * j) * 16); s1[k] += (v[k][j].x + v[k][j].y) + (v[k][j].z + v[k][j].w); } }
#pragma unroll
        for (int o = 1; o < 64; o <<= 1) {
#pragma unroll
            for (int k = 0; k < 4; ++k) s1[k] += __shfl_xor(s1[k], o); }
#pragma unroll
        for (int k = 0; k < 4; ++k) { const float mean = s1[k] * (1.f / 512.f); s2[k] = 0.f;
#pragma unroll
            for (int j = 0; j < 2; ++j) { v[k][j] = v[k][j] - mean; s2[k] += (v[k][j].x * v[k][j].x + v[k][j].y * v[k][j].y) + (v[k][j].z * v[k][j].z + v[k][j].w * v[k][j].w); } }
#pragma unroll
        for (int o = 1; o < 64; o <<= 1) {
#pragma unroll
            for (int k = 0; k < 4; ++k) s2[k] += __shfl_xor(s2[k], o); }
#pragma unroll
        for (int k = 0; k < 4; ++k) { const int tl = wave * 4 + k; const float rstd = 1.f / sqrtf(s2[k] * (1.f / 512.f) + 1e-5f);
#pragma unroll
            for (int j = 0; j < 2; ++j) { f32x4 y = v[k][j] * rstd * gg[j] + bb[j];
                y.x = pg8::silu_f(y.x); y.y = pg8::silu_f(y.y); y.z = pg8::silu_f(y.z); y.w = pg8::silu_f(y.w);
                v2u o; o.x = pk2(y.x, y.y); o.y = pk2(y.z, y.w); *(v2u*)(U + (size_t)(row0 + tl) * 512 + (lane + 64 * j) * 4) = o; } }
        __syncthreads();
    }
#undef CONV_PREFETCH
}

__device__ __forceinline__ void conv_phase_dyn(LAS unsigned char* lds, int cur, unsigned* qctr, int qbase  , int nunits, const bf16* Hg, const float* dw_w, const float* dw_b, const float* ln_g, const float* ln_b, bf16* U, int tid, int lane, int wave) {
    const int cp = tid & 255, tg = tid >> 8;
    f32x2 w[31];
#pragma unroll
    for (int j = 0; j < 31; ++j) w[j] = *(const f32x2*)(dw_w + j * 512 + 2 * cp);
    const f32x2 bias = *(const f32x2*)(dw_b + 2 * cp);
    f32x4 gg[2], bb[2];
#pragma unroll
    for (int j = 0; j < 2; ++j) { gg[j] = *((const f32x4*)ln_g + lane + 64 * j); bb[j] = *((const f32x4*)ln_b + lane + 64 * j); }
    v4u pre[8];
#define CONV_PREFETCH(unit) do { const int row0_ = (unit) * 32, t0_ = row0_ & (SEQL - 1); _Pragma("unroll") for (int k = 0; k < 8; ++k) { const int i = tid + 512 * k, r = i >> 6, ch = i & 63; pre[k] = (v4u){0u, 0u, 0u, 0u}; \
        if (i < 62 * 64 && t0_ - 30 + r >= 0) pre[k] = *(const v4u*)(Hg + (size_t)(row0_ - 30 + r) * 512 + ch * 8); } } while (0)
    const bool popper = (wave == 0 && lane == 0); volatile LAS unsigned* slot = (volatile LAS unsigned*)(lds + LDSCTL_OFF + 224);
    if (popper) slot[0] = __hip_atomic_fetch_add(qctr, 1u, __ATOMIC_RELAXED, __HIP_MEMORY_SCOPE_AGENT);
    __syncthreads();
    int nxt = qbase + (int)__builtin_amdgcn_readfirstlane(slot[0]);
    if (cur < nunits) CONV_PREFETCH(cur);
    while (cur < nunits) {
        const int unit = cur; const int row0 = unit * 32;
#pragma unroll
        for (int k = 0; k < 8; ++k) { const int i = tid + 512 * k, r = i >> 6, ch = i & 63; if (i < 62 * 64) *(LAS v4u*)(lds + r * 1024 + ch * 16) = pre[k]; }
        __syncthreads();
        unsigned pv = 0u; if (popper) pv = __hip_atomic_fetch_add(qctr, 1u, __ATOMIC_RELAXED, __HIP_MEMORY_SCOPE_AGENT);
        if (nxt < nunits) CONV_PREFETCH(nxt);
#pragma unroll 1
        for (int g = 0; g < 2; ++g) {
            const int tl0 = tg * 16 + g * 8;
            f32x2 acc[8];
#pragma unroll
            for (int o = 0; o < 8; ++o) acc[o] = bias;
#pragma unroll
            for (int i = 0; i < 38; ++i) { const unsigned wv = *(const LAS unsigned*)(lds + (tl0 + i) * 1024 + cp * 4); const f32x2 x = {pg8::bf_lo(wv), pg8::bf_hi(wv)};
#pragma unroll
                for (int o = 0; o < 8; ++o) { const int j = i - o; if (j >= 0 && j <= 30) acc[o] += w[j] * x; } }
#pragma unroll
            for (int o = 0; o < 8; ++o) *(LAS f32x2*)(lds + CONV_IN_BYTES + (tl0 + o) * 2048 + cp * 8) = acc[o];
        }
        __syncthreads();
        f32x4 v[4][2]; float s1[4], s2[4];
#pragma unroll
        for (int k = 0; k < 4; ++k) { const int tl = wave * 4 + k; s1[k] = 0.f;
#pragma unroll
            for (int j = 0; j < 2; ++j) { v[k][j] = *(const LAS f32x4*)(lds + CONV_IN_BYTES + tl * 2048 + (lane + 64 * j) * 16); s1[k] += (v[k][j].x + v[k][j].y) + (v[k][j].z + v[k][j].w); } }
#pragma unroll
        for (int o = 1; o < 64; o <<= 1) {
#pragma unroll
            for (int k = 0; k < 4; ++k) s1[k] += __shfl_xor(s1[k], o); }
#pragma unroll
        for (int k = 0; k < 4; ++k) { const float mean = s1[k] * (1.f / 512.f); s2[k] = 0.f;
#pragma unroll
            for (int j = 0; j < 2; ++j) { v[k][j] = v[k][j] - mean; s2[k] += (v[k][j].x * v[k][j].x + v[k][j].y * v[k][j].y) + (v[k][j].z * v[k][j].z + v[k][j].w * v[k][j].w); } }
#pragma unroll
        for (int o = 1; o < 64; o <<= 1) {
#pragma unroll
            for (int k = 0; k < 4; ++k) s2[k] += __shfl_xor(s2[k], o); }
#pragma unroll
        for (int k = 0; k < 4; ++k) { const int tl = wave * 4 + k; const float rstd = 1.f / sqrtf(s2[k] * (1.f / 512.f) + 1e-5f);
#pragma unroll
            for (int j = 0; j < 2; ++j) { f32x4 y = v[k][j] * rstd * gg[j] + bb[j];
                y.x = pg8::silu_f(y.x); y.y = pg8::silu_f(y.y); y.z = pg8::silu_f(y.z); y.w = pg8::silu_f(y.w);
                v2u o; o.x = pk2(y.x, y.y); o.y = pk2(y.z, y.w); *(v2u*)(U + (size_t)(row0 + tl) * 512 + (lane + 64 * j) * 4) = o; } }
        if (popper) slot[0] = pv;
        __syncthreads();
        cur = nxt; nxt = qbase + (int)__builtin_amdgcn_readfirstlane(slot[0]);
        __syncthreads();
    }
#undef CONV_PREFETCH
}

struct Args { const float* in[16]; float* out; unsigned char* ws; };
__global__ void __launch_bounds__(NWAVES * 64, 2) fwd_megakernel(Args args) {
    extern __shared__ __attribute__((aligned(16))) unsigned char lds[];
    cg::grid_group grid = cg::this_grid();
    LAS unsigned char* L = (LAS unsigned char*)lds;
    const int wave = __builtin_amdgcn_readfirstlane(threadIdx.x >> 6);
#define FRESH_TID() const int lane = lane_id_asm(); const int tid = wave * 64 + lane; (void)tid
    const int G = gridDim.x; const int bx = blockIdx.x; const int vcu = (G % 8 == 0) ? (bx % 8) * (G / 8) + bx / 8 : bx;
    const int gw = vcu * NWAVES + wave, NGW = G * NWAVES;
    const bool grp = (G == 256); const int NGRP = grp ? 8 : 1, GS = G / NGRP, gi = grp ? (bx & 7) : 0, gj = grp ? (bx >> 3) : bx, NB = 8 / NGRP, RPG = M / NGRP;
    const int gwl = gj * NWAVES + wave, NGWL = GS * NWAVES; unsigned gbt = 0u;
    bool one_xcc = false; unsigned gbk = 0u;
#define GROUP_BAR() do { gbt += (unsigned)GS; ++gbk; if (one_xcc) group_barrier_1xcc((unsigned*)(args.ws + WS_BAR) + GB_WORD + 64 * gi, (unsigned*)(args.ws + WS_BAR) + GG_WORD + 64 * gi, gbt, gbk); \
        else group_barrier((unsigned*)(args.ws + WS_BAR) + GB_WORD + 64 * gi, gbt); } while (0)
#define CA4 __attribute__((address_space(4)))
#define PHASE_PTRS() \
    const CA4 Args* A_; { auto kp_ = __builtin_amdgcn_kernarg_segment_ptr(); asm volatile("" : "+s"(kp_)); A_ = (const CA4 Args*)kp_; } \
    unsigned char* ws = A_->ws; (void)ws; \
    const float* x = A_->in[0]; const float* pre_g = A_->in[1]; const float* w_in = A_->in[2]; const float* dw_w = A_->in[3]; const float* dw_b = A_->in[4]; \
    const float* cln_g = A_->in[5]; const float* cln_b = A_->in[6]; const float* pw_w = A_->in[7]; const float* pw_b = A_->in[8]; \
    const float* lq1 = A_->in[9]; const float* lk1 = A_->in[10]; const float* lq2 = A_->in[11]; const float* lk2 = A_->in[12]; \
    const float* sub_g = A_->in[13]; const float* w_out = A_->in[14]; const float* post_g = A_->in[15]; float* out = A_->out; \
    float* rowss = (float*)(ws + WS_ROWSS); \
    bf16 *WinT = (bf16*)(ws + WS_WIN), *WoT = (bf16*)(ws + WS_WO), *PwT = (bf16*)(ws + WS_PW), *XN = (bf16*)(ws + WS_XN), *OB = (bf16*)(ws + WS_O); \
    bf16 *HG = (bf16*)(ws + WS_HG), *CGB = (bf16*)(ws + WS_CG), *QB_ = (bf16*)(ws + WS_Q), *KB = (bf16*)(ws + WS_K), *VB = (bf16*)(ws + WS_V), *DGB = (bf16*)(ws + WS_DG), *UB = (bf16*)(ws + WS_U); \
    bf16 *YB = (bf16*)(ws + WS_Y), *Y2 = (bf16*)(ws + WS_Y2); \
    (void)x; (void)pre_g; (void)w_in; (void)dw_w; (void)dw_b; (void)cln_g; (void)cln_b; (void)pw_w; (void)pw_b; (void)lq1; (void)lk1; (void)lq2; (void)lk2; (void)sub_g; (void)w_out; (void)post_g; (void)out; \
    (void)rowss; (void)WinT; (void)WoT; (void)PwT; (void)XN; (void)OB; (void)HG; (void)CGB; (void)QB_; (void)KB; (void)VB; (void)DGB; (void)UB; (void)YB; (void)Y2
    if (threadIdx.x < 128) ((LAS unsigned*)(L + LDSCTL_OFF))[threadIdx.x] = 0u;
    __syncthreads();
    XcdBarrier bar = xcd_barrier_post((unsigned*)(args.ws + WS_BAR), (volatile LAS unsigned*)(L + LDSCTL_OFF));
    if (threadIdx.x == 0) atomicOr((unsigned*)(args.ws + WS_BAR) + SIG_WORD + gi, 1u << (xb_xcc_id() & 15u));
    if (args.ws == nullptr) grid.sync();

    {
        PHASE_PTRS(); FRESH_TID();
        LAS float* scr = (LAS float*)(L + wave * 16384);
        constexpr int I_IN = (DMODEL / 64) * (NIN / 32), I_O = (1024 / 64) * (1024 / 32), I_PW = (512 / 64) * (512 / 32);
        for (int it = gw; it < I_IN + I_O + I_PW; it += NGW) {
            int r = it;
            if (r < I_IN) { const int nblk = NIN / 32, kb = r / nblk, nb = r % nblk; p0_transpose_item(w_in, DMODEL, NIN, WinT, 64 * kb, 32 * nb, win_dst_row(32 * nb), scr, lane); continue; } r -= I_IN;
            if (r < I_O) { const int nblk = 1024 / 32, kb = r / nblk, nb = r % nblk; p0_transpose_item(w_out, 1024, 1024, WoT, 64 * kb, 32 * nb, 32 * nb, scr, lane); continue; } r -= I_O;
            { const int nblk = 512 / 32, kb = r / nblk, nb = r % nblk; p0_transpose_item(pw_w, 512, 512, PwT, 64 * kb, 32 * nb, 32 * nb, scr, lane); }
        }
        for (int i = bx * 512 + tid; i < M; i += G * 512) rowss[i] = 0.f;
        f32x4 gv[4];
#pragma unroll
        for (int j = 0; j < 4; ++j) gv[j] = *((const f32x4*)pre_g + lane + 64 * j);
        for (int m0 = gw; m0 < M; m0 += 4 * NGW) {
            f32x4 v[4][4]; float ss[4];
#pragma unroll
            for (int k = 0; k < 4; ++k) { const int m = m0 + k * NGW; const f32x4* xr = (const f32x4*)(x + (size_t)(m < M ? m : m0) * DMODEL) + lane;
#pragma unroll
                for (int j = 0; j < 4; ++j) v[k][j] = __builtin_nontemporal_load(xr + 64 * j); }
#pragma unroll
            for (int k = 0; k < 4; ++k) { ss[k] = 0.f;
#pragma unroll
                for (int j = 0; j < 4; ++j) ss[k] += (v[k][j].x * v[k][j].x + v[k][j].y * v[k][j].y) + (v[k][j].z * v[k][j].z + v[k][j].w * v[k][j].w); }
#pragma unroll
            for (int o = 1; o < 64; o <<= 1) {
#pragma unroll
                for (int k = 0; k < 4; ++k) ss[k] += __shfl_xor(ss[k], o); }
#pragma unroll
            for (int k = 0; k < 4; ++k) { const int m = m0 + k * NGW; if (m < M) { const float rstd = 1.f / sqrtf(ss[k] * (1.f / DMODEL) + 1e-6f);
                v2u* o8 = (v2u*)(XN + (size_t)m * DMODEL) + lane;
#pragma unroll
                for (int j = 0; j < 4; ++j) { const f32x4 y = v[k][j] * rstd * gv[j]; v2u o; o.x = pk2(y.x, y.y); o.y = pk2(y.z, y.w); o8[64 * j] = o; } } }
        }
    }
    xcd_barrier(bar);
    { const unsigned sig_ = __hip_atomic_load((unsigned*)(args.ws + WS_BAR) + SIG_WORD + gi, RLX_AGENT); one_xcc = (__builtin_popcount(sig_) == 1); }

    {
        PHASE_PTRS();
        pg8::Gemm g{XN, WinT, M, NIN, DMODEL}; pg8::StaticOrder S; S.init(M, NIN, G, bx);
        pg8::EpiIn E{HG, CGB, QB_, KB, VB, DGB, (unsigned*)(ws + WS_BAR) + NMG_WORD + 16 * gi};
        pg8::gemm_phase<pg8::EpiIn, pg8::StaticOrder, PG8_ALIGN, PG8_SP2>(L, g, S, E, wave);
    }
    GROUP_BAR();

    {
        PHASE_PTRS(); FRESH_TID();
        unsigned* ctlw = (unsigned*)(ws + WS_BAR); unsigned* nmx = ctlw + NMG_WORD + 16 * gi; unsigned* qg = ctlw + QG_WORD + 64 * gi;
        int Wt[8]; float sbmax = 0.f;
#pragma unroll
        for (int i = 0; i < 8; ++i) { const float qm = __uint_as_float(__hip_atomic_load(nmx + i, RLX_AGENT)), km = __uint_as_float(__hip_atomic_load(nmx + 8 + i, RLX_AGENT));
            const float Sb = 2.02f * sqrtf(qm * km);
            sbmax = fmaxf(sbmax, Sb);
            const float w = (2.f * Sb + 42.f) / (64.f * pg8::alibi_sl(i >> 1)); Wt[i] = w < 64.f ? (int)w + 1 : 64; }
        const unsigned qslot = LDSCTL_OFF + 64;
        const int NA = 128 * NB, convbase = (RPG / 32) * gi;
        if (sbmax <= 60.f) {
            int u = gj;
            while (u < NA) {
                const int b = gi * NB + (u >> 7), ul = u & 127; int qb, h, c;
                if (ul < 44) { qb = 15 - (ul >> 2); h = 2 + ((ul >> 1) & 1); c = ul & 1; }
                else if (ul < 76) { const int v = ul - 44; h = 1; qb = 15 - (v >> 1); c = v & 1; }
                else if (ul < 96) { const int v = ul - 76; qb = 4 - (v >> 2); h = 2 + ((v >> 1) & 1); c = v & 1; }
                else { const int v = ul - 96; h = 0; qb = 15 - (v >> 1); c = v & 1; }
                const int hc = 2 * h + c; int W = Wt[0];
#pragma unroll
                for (int i = 1; i < 8; ++i) W = (hc == i) ? Wt[i] : W;
                int T0 = 4 * qb - W; T0 = T0 > 0 ? (T0 & ~1) : 0;
                attn_body::attn_unit2(b, qb, (const attn_body::bf16*)(QB_ + h * 128 + c * 64), (const attn_body::bf16*)(KB + h * 128 + c * 64), (const attn_body::bf16*)(VB + h * 128),
                                      (attn_body::bf16*)(OB + h * 256 + c * 128), pg8::alibi_sl(h), pg8::alibi_c32(h), (char*)lds, wave, T0, qg, qslot);
                u = GS + (int)__builtin_amdgcn_readfirstlane(*(volatile LAS unsigned*)(L + qslot));
            }
            { const int ucur_ = convbase + (u - NA), qbase_ = convbase + GS - NA, uend_ = convbase + NA; PHASE_PTRS(); FRESH_TID();
              conv_phase_dyn(L, ucur_, (unsigned*)(ws + WS_BAR) + QG_WORD + 64 * gi, qbase_, uend_, HG, dw_w, dw_b, cln_g, cln_b, UB, tid, lane, wave); }
        } else {
        conv_phase(L, convbase + gj, GS, convbase + NA, HG, dw_w, dw_b, cln_g, cln_b, UB, tid, lane, wave);
        int u = gj;
        while (u < 2 * NA) {
            const int b = gi * NB + (u >> 8), r = u & 255, qb = 15 - (r >> 4), h = (r >> 2) & 3, c = (r >> 1) & 1, vh = r & 1;
            const int hc = 2 * h + c; int W = Wt[0];
#pragma unroll
            for (int i = 1; i < 8; ++i) W = (hc == i) ? Wt[i] : W;
            int T0 = 4 * qb - W; T0 = T0 > 0 ? (T0 & ~1) : 0;
            attn_body::attn_unit<8>(b, qb, (const attn_body::bf16*)(QB_ + h * 128 + c * 64), (const attn_body::bf16*)(KB + h * 128 + c * 64), (const attn_body::bf16*)(VB + h * 128 + vh * 64),
                                    (attn_body::bf16*)(OB + h * 256 + c * 128 + vh * 64), pg8::alibi_sl(h), pg8::alibi_c32(h), (char*)lds, wave, T0, qg, qslot);
            u = GS + (int)__builtin_amdgcn_readfirstlane(*(volatile LAS unsigned*)(L + qslot));
        }
        }
    }
    GROUP_BAR();

    {
        PHASE_PTRS();
        {
            pg8::Gemm g{UB, PwT, M, 512, 512}; pg8::StaticOrder S; S.init(M, 512, G, bx);
            pg8::EpiPw E{CGB, pw_b, YB};
            pg8::gemm_phase<pg8::EpiPw, pg8::StaticOrder, PG8_ALIGN, PG8_SP2>(L, g, S, E, wave);
        }
        FRESH_TID();
        const float lam = expf(wave_sum(lq1[lane] * lk1[lane])) - expf(wave_sum(lq2[lane] * lk2[lane])) + 0.2f;
        const int h = lane >> 4, ec = (lane & 15) * 8;
        float gs[8];
#pragma unroll
        for (int j = 0; j < 8; ++j) gs[j] = sub_g[ec + j] * 0.8f;
        for (int m0 = gwl; m0 < RPG; m0 += 4 * NGWL) {
            v4u a[4], bq[4], gt[4];
#pragma unroll
            for (int k = 0; k < 4; ++k) { const int ml = m0 + k * NGWL; const size_t m = (size_t)(RPG * gi + (ml < RPG ? ml : m0));
                a[k] = *(const v4u*)(OB + m * 1024 + h * 256 + ec); bq[k] = *(const v4u*)(OB + m * 1024 + h * 256 + 128 + ec); gt[k] = *(const v4u*)(DGB + m * 512 + h * 128 + ec); }
#pragma unroll
            for (int k = 0; k < 4; ++k) { const int ml = m0 + k * NGWL; if (ml >= RPG) continue; const int mm = RPG * gi + ml;
                const unsigned aw[4] = {a[k].x, a[k].y, a[k].z, a[k].w}, bw[4] = {bq[k].x, bq[k].y, bq[k].z, bq[k].w}, gw4[4] = {gt[k].x, gt[k].y, gt[k].z, gt[k].w};
                float o[8]; float ss = 0.f;
#pragma unroll
                for (int j = 0; j < 4; ++j) { o[2 * j] = pg8::bf_lo(aw[j]) - lam * pg8::bf_lo(bw[j]); o[2 * j + 1] = pg8::bf_hi(aw[j]) - lam * pg8::bf_hi(bw[j]); ss += o[2 * j] * o[2 * j] + o[2 * j + 1] * o[2 * j + 1]; }
                ss += __shfl_xor(ss, 1); ss += __shfl_xor(ss, 2); ss += __shfl_xor(ss, 4); ss += __shfl_xor(ss, 8);
                const float rstd = 1.f / sqrtf(ss * (1.f / 128.f) + 1e-6f);
                unsigned wv[4];
#pragma unroll
                for (int j = 0; j < 4; ++j) wv[j] = pk2(o[2 * j] * rstd * gs[2 * j] * pg8::bf_lo(gw4[j]), o[2 * j + 1] * rstd * gs[2 * j + 1] * pg8::bf_hi(gw4[j]));
                v4u w; w.x = wv[0]; w.y = wv[1]; w.z = wv[2]; w.w = wv[3];
                *(v4u*)(YB + (size_t)mm * 1024 + 512 + h * 128 + ec) = w; }
        }
    }
    GROUP_BAR();

    {
        PHASE_PTRS();
        pg8::Gemm g{YB, WoT, M, 1024, 1024}; pg8::StaticOrder S; S.init(M, 1024, G, bx);
        pg8::EpiOut E{Y2, rowss};
        pg8::gemm_phase<pg8::EpiOut, pg8::StaticOrder, PG8_ALIGN, PG8_SP2>(L, g, S, E, wave);
    }
    GROUP_BAR();

    {
        PHASE_PTRS(); FRESH_TID();
        f32x4 gv[4];
#pragma unroll
        for (int j = 0; j < 4; ++j) gv[j] = *((const f32x4*)post_g + lane + 64 * j);
        for (int m0 = gwl; m0 < RPG; m0 += 4 * NGWL) {
            f32x4 xv[4][4]; v2u yv[4][4]; float rs[4];
#pragma unroll
            for (int k = 0; k < 4; ++k) { const int ml = m0 + k * NGWL; const size_t m = (size_t)(RPG * gi + (ml < RPG ? ml : m0)); rs[k] = rowss[m];
                const f32x4* xr = (const f32x4*)(x + m * DMODEL) + lane; const v2u* yr = (const v2u*)(Y2 + m * 1024) + lane;
#pragma unroll
                for (int j = 0; j < 4; ++j) { xv[k][j] = __builtin_nontemporal_load(xr + 64 * j); yv[k][j] = yr[64 * j]; } }
#pragma unroll
            for (int k = 0; k < 4; ++k) { const int ml = m0 + k * NGWL; if (ml >= RPG) continue; const int mm = RPG * gi + ml;
                const float rstd = 1.f / sqrtf(rs[k] * (1.f / 1024.f) + 1e-6f); f32x4* orow = (f32x4*)(out + (size_t)mm * DMODEL) + lane;
#pragma unroll
                for (int j = 0; j < 4; ++j) { f32x4 o;
                    o.x = xv[k][j].x + pg8::bf_lo(yv[k][j].x) * rstd * gv[j].x; o.y = xv[k][j].y + pg8::bf_hi(yv[k][j].x) * rstd * gv[j].y; o.z = xv[k][j].z + pg8::bf_lo(yv[k][j].y) * rstd * gv[j].z; o.w = xv[k][j].w + pg8::bf_hi(yv[k][j].y) * rstd * gv[j].w;
                    __builtin_nontemporal_store(o, orow + 64 * j); } }
        }
    }
}

extern "C" void kernel_launch(void* const* d_in, const int* in_sizes, int n_in, void* d_out, int out_size, void* d_ws, size_t ws_size, hipStream_t stream) {
    static int grid = 0;
    if (grid == 0) {
        if (n_in != 16 || out_size != M * DMODEL || ws_size < WS_END) { fprintf(stderr, "kernel_launch: unexpected problem shape (n_in %d, out %d, ws %zu)\n", n_in, out_size, ws_size); grid = -1; return; }
        int dev = 0, cus = 0, per_cu = 0;
        hipGetDevice(&dev); hipDeviceGetAttribute(&cus, hipDeviceAttributeMultiprocessorCount, dev);
        hipFuncSetAttribute((const void*)fwd_megakernel, hipFuncAttributeMaxDynamicSharedMemorySize, LDS_BYTES);
        hipOccupancyMaxActiveBlocksPerMultiprocessor(&per_cu, (const void*)fwd_megakernel, NWAVES * 64, LDS_BYTES);
        if (per_cu < 1) { fprintf(stderr, "kernel_launch: occupancy query reports %d blocks per CU\n", per_cu); per_cu = 1; }
        (void)hipGetLastError();
        grid = cus;
    }
    if (grid < 0) return;
    (void)hipMemsetAsync((char*)d_ws + WS_BAR, 0, WS_BAR_BYTES, stream);
    Args a{};
    for (int i = 0; i < 16; ++i) a.in[i] = (const float*)d_in[i];
    a.out = (float*)d_out; a.ws = (unsigned char*)d_ws;
    void* kargs[] = {&a};
    hipError_t e = hipLaunchCooperativeKernel((const void*)fwd_megakernel, dim3(grid), dim3(NWAVES * 64), kargs, LDS_BYTES, stream);
    if (e != hipSuccess) fprintf(stderr, "cooperative launch failed: %s (grid %d)\n", hipGetErrorString(e), grid);
}
```

```cpp
#include <hip/hip_runtime.h>
#include <hip/hip_cooperative_groups.h>
#include <cstdio>
#include <cstdint>
namespace cg = cooperative_groups;
__device__ __forceinline__ int lane_id_asm() { int l; asm volatile("v_mbcnt_lo_u32_b32 %0, -1, 0\n\tv_mbcnt_hi_u32_b32 %0, -1, %0" : "=v"(l)); return l; }
namespace pg8 {
#define PG8_LAS __attribute__((address_space(3)))
typedef unsigned short bf16_t;
typedef short bf16x8 __attribute__((ext_vector_type(8)));
typedef float f32x4 __attribute__((ext_vector_type(4)));
typedef unsigned u32x4 __attribute__((ext_vector_type(4)));
constexpr int BM = 256, BK = 64, HALF = 128, HTB = HALF * BK * 2  , STAGE_BYTES = 8 * HTB, NXCD = 8, WGM = 4;

__host__ __device__ __forceinline__ int lds_byte(int r, int c) { const int st = (r >> 4) * 2 + (c >> 5), rr = r & 15, cc = c & 31, ob = rr * 64 + cc * 2; return st * 1024 + (ob ^ (((ob >> 9) & 1) << 5)); }
__host__ __device__ __forceinline__ void stage_rc(int b, int& R, int& C) { const int st = b / 1024, sb = b % 1024, swz = sb ^ (((sb >> 9) & 1) << 5); R = (st >> 1) * 16 + swz / 64; C = (st & 1) * 32 + (swz % 64) / 2; }
__host__ __device__ __forceinline__ int perm32(int rho) { const int n = rho >> 4, i = rho & 15; return 8 * (i >> 2) + 4 * n + (i & 3); }

struct Unit { int pm, pn; };
struct Gemm { const bf16_t* A; const bf16_t* Bt; int M, N, K; };

struct StaticOrder {
    int nM, nN, nwg, G, c;
    __host__ __device__ void init(int M, int N, int G_, int c_) { nM = M / BM; nN = N / BM; nwg = nM * nN; G = G_; c = c_; }
    __host__ __device__ bool next(int i, Unit& u) const {
        const long L = (long)i * G + c; if (L >= nwg) return false;
        int wgid = (int)L; { const int q = nwg / NXCD, r = nwg % NXCD, xcd = wgid % NXCD, off = wgid / NXCD; wgid = (xcd < r ? xcd * (q + 1) : r * (q + 1) + (xcd - r) * q) + off; }
        const int nig = WGM * nN, gid = wgid / nig, fm = gid * WGM, gsz = (nM - fm) < WGM ? (nM - fm) : WGM;
        u.pm = fm + ((wgid % nig) % gsz); u.pn = (wgid % nig) / gsz; return true;
    }
    __device__ __forceinline__ void a_ready(const Unit&) const {}
    __device__ __forceinline__ void done(const Unit&) const {}
};

__device__ __forceinline__ unsigned cvt_pk_bf16(float lo, float hi) { unsigned r; asm volatile("v_cvt_pk_bf16_f32 %0, %1, %2" : "=v"(r) : "v"(lo), "v"(hi)); return r; }

typedef float f32x2 __attribute__((ext_vector_type(2)));
__host__ __device__ __forceinline__ float alibi_c32(int h) { return h == 0 ? 2980.9579870417283f : h == 1 ? 7.38905609893065f : h == 2 ? 1.6487212707001282f : 1.1331484530668263f; }
__host__ __device__ __forceinline__ float alibi_sl(int h) { return h == 0 ? 0.36067376022224085f : h == 1 ? 0.09016844005556021f : h == 2 ? 0.022542110013890053f : 0.005635527503472513f; }
__device__ __forceinline__ float sigmoid_f(float v) { return __builtin_amdgcn_rcpf(1.0f + __builtin_amdgcn_exp2f(-1.4426950408889634f * v)); }
__device__ __forceinline__ float silu_f(float v) { return v * sigmoid_f(v); }
__device__ __forceinline__ float bf_lo(unsigned w) { return __uint_as_float(w << 16); }
__device__ __forceinline__ float bf_hi(unsigned w) { return __uint_as_float(w & 0xffff0000u); }
__device__ __forceinline__ u32x4 pack8(const f32x4 v0, const f32x4 v1) { u32x4 w; w.x = cvt_pk_bf16(v0[0], v0[1]); w.y = cvt_pk_bf16(v0[2], v0[3]); w.z = cvt_pk_bf16(v1[0], v1[1]); w.w = cvt_pk_bf16(v1[2], v1[3]); return w; }

struct EpiIn {
    static constexpr bool PERM = true, AFTER_DRAIN = false;
    bf16_t *Hg, *CG, *Q, *K, *V, *DG; unsigned* nmax;
    __device__ __forceinline__ void operator()(const f32x4 (&acc)[2][2][4][2], const Unit& u, int wr, int wc, int fr, int fq) const {
        const int row0 = u.pm * BM + wr * 64 + fr; const int pn = u.pn;
        if (pn < 4) {
            const int col = 128 * pn + wc * 32 + 8 * fq;
#pragma unroll
            for (int ai = 0; ai < 2; ++ai)
#pragma unroll
                for (int m = 0; m < 4; ++m) {
                    f32x4 h0, h1;
#pragma unroll
                    for (int j = 0; j < 4; ++j) { h0[j] = acc[ai][0][m][0][j] * sigmoid_f(acc[ai][1][m][0][j]); h1[j] = acc[ai][0][m][1][j] * sigmoid_f(acc[ai][1][m][1][j]); }
                    *(u32x4*)(Hg + (size_t)(row0 + ai * HALF + m * 16) * 512 + col) = pack8(h0, h1);
                }
        } else {
            const int role = (pn - 4) >> 1, colt = 256 * ((pn - 4) & 1) + wc * 32 + 8 * fq;
            bf16_t* base = role == 0 ? CG : role == 1 ? Q : role == 2 ? K : role == 3 ? V : DG;
            float mx[2] = {0.f, 0.f};
#pragma unroll
            for (int ai = 0; ai < 2; ++ai)
#pragma unroll
                for (int m = 0; m < 4; ++m)
#pragma unroll
                    for (int bj = 0; bj < 2; ++bj) {
                        f32x4 v0 = acc[ai][bj][m][0], v1 = acc[ai][bj][m][1];
                        if (role == 0 || role == 4) {
#pragma unroll
                            for (int j = 0; j < 4; ++j) { v0[j] = silu_f(v0[j]); v1[j] = silu_f(v1[j]); }
                        } else if (role == 1) { v0 = v0 * 0.18033688011112042f; v1 = v1 * 0.18033688011112042f; }
                        else if (role == 3) {
                            if (m >= 2) {
                                const int h = 2 * ((pn - 4) & 1) + bj;
                                const float c = alibi_c32(h);
                                v0 = v0 * c; v1 = v1 * c;
                            }
                        }
                        *(u32x4*)(base + (size_t)(row0 + ai * HALF + m * 16) * 512 + colt + bj * HALF) = pack8(v0, v1);
                        if (role == 1 || role == 2) { float ss = (v0[0] * v0[0] + v0[1] * v0[1]) + (v0[2] * v0[2] + v0[3] * v0[3]) + (v1[0] * v1[0] + v1[1] * v1[1]) + (v1[2] * v1[2] + v1[3] * v1[3]);
                            ss += __shfl_xor(ss, 16); ss += __shfl_xor(ss, 32); mx[bj] = fmaxf(mx[bj], ss); }
                    }
            if (role == 1 || role == 2) {
#pragma unroll
                for (int bj = 0; bj < 2; ++bj) { float v = mx[bj]; v = fmaxf(v, __shfl_xor(v, 1)); v = fmaxf(v, __shfl_xor(v, 2)); v = fmaxf(v, __shfl_xor(v, 4)); v = fmaxf(v, __shfl_xor(v, 8));
                    if (fr == 0 && fq == 0) atomicMax(nmax + (role - 1) * 8 + 4 * ((pn - 4) & 1) + 2 * bj + (wc >> 1), __float_as_uint(v)); }
            }
        }
    }
};
struct EpiPw {
    static constexpr bool PERM = true, AFTER_DRAIN = false;
    const bf16_t* CG; const float* bias; bf16_t* Y;
    __device__ __forceinline__ void operator()(const f32x4 (&acc)[2][2][4][2], const Unit& u, int wr, int wc, int fr, int fq) const {
        const int row0 = u.pm * BM + wr * 64 + fr; const int col0 = u.pn * BM + wc * 32 + 8 * fq;
        f32x4 bv[2][2];
#pragma unroll
        for (int bj = 0; bj < 2; ++bj)
#pragma unroll
            for (int n = 0; n < 2; ++n) bv[bj][n] = *(const f32x4*)(bias + col0 + bj * HALF + 4 * n);
#pragma unroll
        for (int ai = 0; ai < 2; ++ai)
#pragma unroll
            for (int m = 0; m < 4; ++m) { const size_t row = (size_t)(row0 + ai * HALF + m * 16);
#pragma unroll
                for (int bj = 0; bj < 2; ++bj) {
                    const u32x4 g = *(const u32x4*)(CG + row * 512 + col0 + bj * HALF);
                    f32x4 v0 = acc[ai][bj][m][0] + bv[bj][0], v1 = acc[ai][bj][m][1] + bv[bj][1];
                    v0[0] *= bf_lo(g.x); v0[1] *= bf_hi(g.x); v0[2] *= bf_lo(g.y); v0[3] *= bf_hi(g.y);
                    v1[0] *= bf_lo(g.z); v1[1] *= bf_hi(g.z); v1[2] *= bf_lo(g.w); v1[3] *= bf_hi(g.w);
                    *(u32x4*)(Y + row * 1024 + col0 + bj * HALF) = pack8(v0, v1);
                } }
    }
};
struct EpiOut {
    static constexpr bool PERM = true, AFTER_DRAIN = false;
    bf16_t* Y2; float* rowss;
    __device__ __forceinline__ void operator()(const f32x4 (&acc)[2][2][4][2], const Unit& u, int wr, int wc, int fr, int fq) const {
        const int row0 = u.pm * BM + wr * 64 + fr; const int col0 = u.pn * BM + wc * 32 + 8 * fq;
#pragma unroll
        for (int ai = 0; ai < 2; ++ai)
#pragma unroll
            for (int m = 0; m < 4; ++m) { const size_t row = (size_t)(row0 + ai * HALF + m * 16); float ss = 0.f;
#pragma unroll
                for (int bj = 0; bj < 2; ++bj) {
                    const f32x4 v0 = acc[ai][bj][m][0], v1 = acc[ai][bj][m][1];
                    ss += (v0[0] * v0[0] + v0[1] * v0[1]) + (v0[2] * v0[2] + v0[3] * v0[3]) + (v1[0] * v1[0] + v1[1] * v1[1]) + (v1[2] * v1[2] + v1[3] * v1[3]);
                    *(u32x4*)(Y2 + row * 1024 + col0 + bj * HALF) = pack8(v0, v1);
                }
                ss += __shfl_xor(ss, 16); ss += __shfl_xor(ss, 32);
                if (fq == 0) atomicAdd(rowss + row, ss);
            }
    }
};


template <class Epi, class Sched, bool ALIGN_EPI = false, bool SP2 = false>
__device__ __forceinline__ void gemm_phase(PG8_LAS unsigned char* lds, const Gemm g, const Sched& S, const Epi& E, int wid_in) {
    const int lane = lane_id_asm();
    int wid_o = wid_in; asm volatile("" : "+s"(wid_o)); const int wid = wid_o, tid = wid * 64 + lane, wr = wid >> 2, wc = wid & 3, fr = lane & 15, fq = lane >> 4;
    const int K = g.K, nt = K / BK;
    unsigned voffA[2], voffB[2];
#pragma unroll
    for (int i = 0; i < 2; ++i) { int R, C; stage_rc(tid * 16 + i * 8192, R, C); const int Rb = Epi::PERM ? ((R & ~31) + perm32(R & 31)) : R;
        voffA[i] = (unsigned)(R * K + C) * 2u; voffB[i] = (unsigned)(Rb * K + C) * 2u; }
    const size_t kstep = (size_t)(BK * 2);
    const size_t hstep = (size_t)HALF * K * 2;
    const size_t tstep = 2 * hstep;
    const unsigned ldsw = (unsigned)wid * 1024u;
    const int aoff = lds_byte(wr * 64 + fr, fq * 8), boff = lds_byte(wc * 32 + fr, fq * 8);
#define PG8_SA(b, h) (((b) * 2 + (h)) * HTB)
#define PG8_SB(b, h) ((4 + (b) * 2 + (h)) * HTB)
#define PG8_STAGE(bufoff, gbase, voff) do { _Pragma("unroll") for (int _i = 0; _i < 2; ++_i) \
        __builtin_amdgcn_global_load_lds((const unsigned*)((const char*)(gbase) + (voff)[_i]), (PG8_LAS unsigned*)(lds + (bufoff) + ldsw + _i * 8192), 16, 0, 0); } while (0)
#define PG8_LDA(dst, b, h) do { _Pragma("unroll") for (int m = 0; m < 4; ++m) _Pragma("unroll") for (int k = 0; k < 2; ++k) dst[m][k] = *(const PG8_LAS bf16x8*)(lds + PG8_SA(b, h) + aoff + m * 2048 + k * 1024); } while (0)
#define PG8_LDB(dst, b, h) do { _Pragma("unroll") for (int n = 0; n < 2; ++n) _Pragma("unroll") for (int k = 0; k < 2; ++k) dst[n][k] = *(const PG8_LAS bf16x8*)(lds + PG8_SB(b, h) + boff + n * 2048 + k * 1024); } while (0)
#define PG8_MMA(ai, bj, At, Bt) do { __builtin_amdgcn_s_setprio(1); _Pragma("unroll") for (int m = 0; m < 4; ++m) _Pragma("unroll") for (int n = 0; n < 2; ++n) _Pragma("unroll") for (int k = 0; k < 2; ++k) \
        acc[ai][bj][m][n] = __builtin_amdgcn_mfma_f32_16x16x32_bf16(Bt[n][k], At[m][k], acc[ai][bj][m][n], 0, 0, 0); __builtin_amdgcn_s_setprio(0); } while (0)
#define PG8_WAIT_V(n) asm volatile("s_waitcnt vmcnt(" #n ")" ::: "memory")
#define PG8_WAIT_L(n) asm volatile("s_waitcnt lgkmcnt(" #n ")" ::: "memory")
#define PG8_BAR __builtin_amdgcn_s_barrier()
#define PG8_SCHED __builtin_amdgcn_sched_barrier(0)
    Unit cur, nxt; int ui = 0;
    if (!S.next(0, cur)) return;
    f32x4 acc[2][2][4][2];
#pragma unroll
    for (int a = 0; a < 2; ++a)
#pragma unroll
        for (int b = 0; b < 2; ++b)
#pragma unroll
            for (int m = 0; m < 4; ++m)
#pragma unroll
                for (int n = 0; n < 2; ++n) acc[a][b][m][n] = (f32x4){0.f, 0.f, 0.f, 0.f};
    bf16x8 At[4][2], B0[2][2], B1[2][2];
    const char* cA = (const char*)g.A + (size_t)cur.pm * tstep; const char* cB = (const char*)g.Bt + (size_t)cur.pn * tstep;
    S.a_ready(cur);
    if constexpr (SP2) {
        PG8_STAGE(PG8_SB(0, 0), cB, voffB); PG8_STAGE(PG8_SB(0, 1), cB + hstep, voffB); PG8_STAGE(PG8_SA(0, 0), cA, voffA); PG8_STAGE(PG8_SA(0, 1), cA + hstep, voffA);
        if (wr == 1) PG8_BAR;
        PG8_WAIT_V(2); PG8_BAR;
        PG8_STAGE(PG8_SB(1, 0), cB + kstep, voffB); PG8_STAGE(PG8_SA(1, 0), cA + kstep, voffA); PG8_STAGE(PG8_SB(1, 1), cB + hstep + kstep, voffB);
        PG8_WAIT_V(6); PG8_BAR;
    } else {
        PG8_STAGE(PG8_SB(0, 0), cB, voffB); PG8_STAGE(PG8_SA(0, 0), cA, voffA); PG8_STAGE(PG8_SB(0, 1), cB + hstep, voffB); PG8_STAGE(PG8_SA(0, 1), cA + hstep, voffA);
        if (wr == 1) PG8_BAR;
        PG8_WAIT_V(4); PG8_BAR;
        PG8_STAGE(PG8_SB(1, 0), cB + kstep, voffB); PG8_STAGE(PG8_SA(1, 0), cA + kstep, voffA); PG8_STAGE(PG8_SB(1, 1), cB + hstep + kstep, voffB);
        PG8_WAIT_V(6); PG8_BAR;
    }
    for (;;) {
        const bool has_next = S.next(ui + 1, nxt);
        const char* nA = has_next ? (const char*)g.A + (size_t)nxt.pm * tstep : cA; const char* nB = has_next ? (const char*)g.Bt + (size_t)nxt.pn * tstep : cB;
        for (int t = 0; t < nt; t += 2) {
            const bool last = (t == nt - 2);
            const char* a1 = cA + (size_t)(t + 1) * kstep;
            const char* a2 = last ? nA : cA + (size_t)(t + 2) * kstep; const char* b2 = last ? nB : cB + (size_t)(t + 2) * kstep;
            const char* a3 = a2 + kstep; const char* b3 = b2 + kstep;
            if (last && has_next) S.a_ready(nxt);
            if constexpr (SP2) {
            PG8_LDB(B0, 0, 0); PG8_LDB(B1, 0, 1); PG8_SCHED; PG8_LDA(At, 0, 0); PG8_STAGE(PG8_SA(1, 1), a1 + hstep, voffA);
            PG8_WAIT_V(8); PG8_WAIT_L(0); PG8_BAR; PG8_MMA(0, 0, At, B0); PG8_MMA(0, 1, At, B1); PG8_BAR; PG8_SCHED;
            PG8_LDA(At, 0, 1); PG8_STAGE(PG8_SB(0, 0), b2, voffB); PG8_STAGE(PG8_SB(0, 1), b2 + hstep, voffB); PG8_STAGE(PG8_SA(0, 0), a2, voffA);
            PG8_WAIT_V(8); PG8_WAIT_L(0); PG8_BAR; PG8_MMA(1, 0, At, B0); PG8_MMA(1, 1, At, B1); PG8_BAR; PG8_SCHED;
            PG8_LDB(B0, 1, 0); PG8_LDB(B1, 1, 1); PG8_SCHED; PG8_LDA(At, 1, 0); PG8_STAGE(PG8_SA(0, 1), a2 + hstep, voffA);
            PG8_WAIT_V(8); PG8_WAIT_L(0); PG8_BAR; PG8_MMA(0, 0, At, B0); PG8_MMA(0, 1, At, B1); PG8_BAR; PG8_SCHED;
            PG8_LDA(At, 1, 1); PG8_STAGE(PG8_SB(1, 0), b3, voffB); PG8_STAGE(PG8_SB(1, 1), b3 + hstep, voffB); PG8_STAGE(PG8_SA(1, 0), a3, voffA);
            PG8_WAIT_V(8); PG8_WAIT_L(0); PG8_BAR; PG8_MMA(1, 0, At, B0); PG8_MMA(1, 1, At, B1); PG8_BAR; PG8_SCHED;
            } else {
            PG8_LDB(B0, 0, 0); PG8_SCHED; PG8_LDA(At, 0, 0); PG8_STAGE(PG8_SA(1, 1), a1 + hstep, voffA);
            PG8_WAIT_L(8); PG8_BAR; PG8_WAIT_L(0); PG8_MMA(0, 0, At, B0); PG8_BAR; PG8_SCHED;
            PG8_LDB(B1, 0, 1); PG8_STAGE(PG8_SB(0, 0), b2, voffB);
            PG8_BAR; PG8_WAIT_L(0); PG8_MMA(0, 1, At, B1); PG8_BAR;
            PG8_LDA(At, 0, 1); PG8_STAGE(PG8_SA(0, 0), a2, voffA);
            PG8_BAR; PG8_WAIT_L(0); PG8_MMA(1, 0, At, B0); PG8_BAR; PG8_SCHED;
            PG8_STAGE(PG8_SB(0, 1), b2 + hstep, voffB);
            PG8_WAIT_V(6); PG8_BAR; PG8_MMA(1, 1, At, B1); PG8_BAR;
            PG8_LDB(B0, 1, 0); PG8_SCHED; PG8_LDA(At, 1, 0); PG8_STAGE(PG8_SA(0, 1), a2 + hstep, voffA);
            PG8_WAIT_L(8); PG8_BAR; PG8_WAIT_L(0); PG8_MMA(0, 0, At, B0); PG8_BAR; PG8_SCHED;
            PG8_LDB(B1, 1, 1); PG8_STAGE(PG8_SB(1, 0), b3, voffB);
            PG8_BAR; PG8_WAIT_L(0); PG8_MMA(0, 1, At, B1); PG8_BAR;
            PG8_LDA(At, 1, 1); PG8_STAGE(PG8_SA(1, 0), a3, voffA);
            PG8_BAR; PG8_WAIT_L(0); PG8_MMA(1, 0, At, B0); PG8_BAR; PG8_SCHED;
            PG8_STAGE(PG8_SB(1, 1), b3 + hstep, voffB);
            PG8_WAIT_V(6); PG8_BAR; PG8_MMA(1, 1, At, B1); PG8_BAR;
            }
        }
        if constexpr (ALIGN_EPI) { if (wr == 0) PG8_BAR; }
        if constexpr (!Epi::AFTER_DRAIN) { E(acc, cur, wr, wc, fr, fq); S.done(cur); }
        if (!has_next) break;
#pragma unroll
        for (int a = 0; a < 2; ++a)
#pragma unroll
            for (int b = 0; b < 2; ++b)
#pragma unroll
                for (int m = 0; m < 4; ++m)
#pragma unroll
                    for (int n = 0; n < 2; ++n) acc[a][b][m][n] = (f32x4){0.f, 0.f, 0.f, 0.f};
        cur = nxt; cA = nA; cB = nB; ++ui;
        if constexpr (ALIGN_EPI) { if (wr == 1) PG8_BAR; }
    }
    PG8_WAIT_V(0);
    if constexpr (!ALIGN_EPI) { if (wr == 0) PG8_BAR; }
    PG8_BAR;
    if constexpr (Epi::AFTER_DRAIN) { E.fused(acc, cur, wr, wc, fr, fq, lds, wid, lane); S.done(cur); }
#undef PG8_SA
#undef PG8_SB
#undef PG8_STAGE
#undef PG8_LDA
#undef PG8_LDB
#undef PG8_MMA
#undef PG8_WAIT_V
#undef PG8_WAIT_L
#undef PG8_BAR
#undef PG8_SCHED
}
}

#ifndef PG8_SP2
#define PG8_SP2 true
#endif
#ifndef PG8_ALIGN
#define PG8_ALIGN true
#endif
#include <hip/hip_bf16.h>
#include <cmath>
namespace attn_body {
using bf16=__hip_bfloat16;
using bf16x8=__attribute__((ext_vector_type(8)))short;
using s16x4=__attribute__((ext_vector_type(4)))short;
using f32x16=__attribute__((ext_vector_type(16)))float;
using u32x4=__attribute__((ext_vector_type(4)))unsigned;
constexpr int BATCH=8,SEQ=4096,D=64;
constexpr int QP=512,KP=512,VP=512,OP=1024;
constexpr int NW=8,QBLK=32,QB=QBLK*NW,KVBLK=64,NQB=SEQ/QB;
constexpr int ATTN_UNIT_ROWS=QB;
__device__ __forceinline__ int crow(int r,int hi){return (r&3)+8*(r>>2)+4*hi;}
#define SBAR() __builtin_amdgcn_sched_barrier(0)
__device__ __forceinline__ void cmask(f32x16&p0,f32x16&p1,int jb,int qrel,int hi){
  const float NEG=-INFINITY; int kb=64*jb+4*hi;
  #pragma unroll
  for(int r=0;r<16;++r){int kv=kb+(r&3)+8*(r>>2); if(kv>qrel)p0[r]=NEG; if(kv+32>qrel)p1[r]=NEG;}
}

constexpr int NSLOT=3, SLOTB=8192;
constexpr int LDS_K=0, LDS_V=NSLOT*SLOTB, LDS_WS=2*NSLOT*SLOTB, LDS_OST=LDS_WS+NW*64*4, LDS_BYTES=LDS_OST+NW*4096;
constexpr float C2=0.125f*1.4426950408889634f;
__device__ __forceinline__ void glds16(const void*sbase,unsigned voff,unsigned lds_dst){unsigned keep;
  asm volatile("s_mov_b32 %0, m0\n\ts_mov_b32 m0, %2\n\ts_nop 0\n\tglobal_load_lds_dwordx4 %1, %3\n\ts_mov_b32 m0, %0":"=&s"(keep):"v"(voff),"s"(lds_dst),"s"(sbase):"memory");}
__device__ __forceinline__ float max3f(float a,float b,float c){float r;asm("v_max3_f32 %0, %1, %2, %3":"=v"(r):"v"(a),"v"(b),"v"(c));return r;}
__device__ __forceinline__ float max2f(float a,float b){float r;asm("v_max_f32_e32 %0, %1, %2":"=v"(r):"v"(a),"v"(b));return r;}
__device__ __forceinline__ float fadd_s(float a,float b){float r;asm("v_add_f32_e32 %0, %1, %2":"=v"(r):"v"(a),"v"(b));return r;}
__device__ __forceinline__ float fsub_s(float a,float b){float r;asm("v_sub_f32_e32 %0, %1, %2":"=v"(r):"v"(a),"v"(b));return r;}
typedef float f32x2_t __attribute__((ext_vector_type(2))); typedef __bf16 bf16x2_t __attribute__((ext_vector_type(2)));
__device__ __forceinline__ unsigned cvtpk_s(float lo,float hi){f32x2_t v={lo,hi};bf16x2_t b=__builtin_convertvector(v,bf16x2_t);return __builtin_bit_cast(unsigned,b);}
#define WAIT_BAR(N) asm volatile("s_waitcnt vmcnt(" #N ") lgkmcnt(0)\n\ts_barrier":::"memory")

__device__ __forceinline__ void qkt(f32x16&p0,f32x16&p1,const char*Kslot,const bf16x8*qr,const f32x16&negm,int r32,int hi){
  const char*kb=Kslot+hi*1024+r32*16;
  #pragma unroll
  for(int d0=0;d0<4;++d0){
    const bf16x8 b0=*reinterpret_cast<const bf16x8*>(kb+d0*2048);
    const bf16x8 b1=*reinterpret_cast<const bf16x8*>(kb+d0*2048+512);
    if(d0==0){p0=__builtin_amdgcn_mfma_f32_32x32x16_bf16(b0,qr[0],negm,0,0,0);p1=__builtin_amdgcn_mfma_f32_32x32x16_bf16(b1,qr[0],negm,0,0,0);}
    else{p0=__builtin_amdgcn_mfma_f32_32x32x16_bf16(b0,qr[d0],p0,0,0,0);p1=__builtin_amdgcn_mfma_f32_32x32x16_bf16(b1,qr[d0],p1,0,0,0);}}
}
typedef __attribute__((address_space(3))) const char* lds_cptr;
typedef short v4i16_t __attribute__((ext_vector_type(4)));
__device__ __forceinline__ void kload8(bf16x8*kf,lds_cptr kp){
  kf[0]=*(const __attribute__((address_space(3))) bf16x8*)(kp);      kf[1]=*(const __attribute__((address_space(3))) bf16x8*)(kp+512);
  kf[2]=*(const __attribute__((address_space(3))) bf16x8*)(kp+2048); kf[3]=*(const __attribute__((address_space(3))) bf16x8*)(kp+2560);
  kf[4]=*(const __attribute__((address_space(3))) bf16x8*)(kp+4096); kf[5]=*(const __attribute__((address_space(3))) bf16x8*)(kp+4608);
  kf[6]=*(const __attribute__((address_space(3))) bf16x8*)(kp+6144); kf[7]=*(const __attribute__((address_space(3))) bf16x8*)(kp+6656);
}
__device__ __forceinline__ void kload2(bf16x8*kf,lds_cptr kp,int j){ kf[2*j]=*(const __attribute__((address_space(3))) bf16x8*)(kp+j*2048); kf[2*j+1]=*(const __attribute__((address_space(3))) bf16x8*)(kp+j*2048+512); }
__device__ __forceinline__ s16x4 vtr(lds_cptr p){ return __builtin_bit_cast(s16x4,__builtin_amdgcn_ds_read_tr16_b64_v4i16((__attribute__((address_space(3))) v4i16_t*)p)); }
__device__ __forceinline__ float rowmax(const f32x16&p0,const f32x16&p1){
  float a=max3f(p0[0],p0[1],p1[0]),b=max3f(p0[2],p0[3],p1[1]);a=max3f(a,p1[2],p1[3]);
  #pragma unroll
  for(int r=4;r<16;r+=4){a=max3f(a,p0[r],p0[r+1]);b=max3f(b,p0[r+2],p0[r+3]);a=max3f(a,p1[r],p1[r+1]);b=max3f(b,p1[r+2],p1[r+3]);}
  const float m=max2f(a,b);
  auto rr=__builtin_amdgcn_permlane32_swap(__float_as_uint(m),__float_as_uint(m),false,false);
  return max2f(__uint_as_float(rr[0]),__uint_as_float(rr[1]));
}
__device__ __forceinline__ void pv(f32x16*o,int vb,bf16x8 pa0,bf16x8 pa1,bf16x8 pa2,bf16x8 pa3){
  #pragma unroll
  for(int d0=0;d0<2;++d0){s16x4 lo[4],hi[4];
    #pragma unroll
    for(int ks=0;ks<4;++ks){
      asm volatile("ds_read_b64_tr_b16 %0,%1 offset:%c2":"=&v"(lo[ks]):"v"(vb),"i"(d0*4096+ks*1024):"memory");
      asm volatile("ds_read_b64_tr_b16 %0,%1 offset:%c2":"=&v"(hi[ks]):"v"(vb),"i"(d0*4096+ks*1024+512):"memory");}
    asm volatile("s_waitcnt lgkmcnt(0)":::"memory");SBAR();
    #define PK(k) (bf16x8){lo[k][0],lo[k][1],lo[k][2],lo[k][3],hi[k][0],hi[k][1],hi[k][2],hi[k][3]}
    o[d0]=__builtin_amdgcn_mfma_f32_32x32x16_bf16(pa0,PK(0),o[d0],0,0,0);
    o[d0]=__builtin_amdgcn_mfma_f32_32x32x16_bf16(pa1,PK(1),o[d0],0,0,0);
    o[d0]=__builtin_amdgcn_mfma_f32_32x32x16_bf16(pa2,PK(2),o[d0],0,0,0);
    o[d0]=__builtin_amdgcn_mfma_f32_32x32x16_bf16(pa3,PK(3),o[d0],0,0,0);
    #undef PK
  }
}

#ifndef ATTN_STORE16
#define ATTN_STORE16(p,v) (*(u32x4*)(p)=(v))
#endif
template<int THRL> __device__ __forceinline__ void attn_unit(int b,int qb,const bf16*Qh,const bf16*__restrict__ Kh0,const bf16*__restrict__ Vh0,bf16*Oh,float sl,float c32,char*shm,int wid_in,int T0,unsigned*qctr,unsigned qslot){
  const int lane=lane_id_asm(),r32=lane&31,hi=lane>>5; int wid=wid_in; asm volatile("":"+s"(wid));
  const long rowbase=(long)b*SEQ; const int q0=qb*QB;
  const bf16*Qw=Qh+(rowbase+q0+wid*QBLK)*QP;
  const bf16*Kh=Kh0+(rowbase+(long)T0*KVBLK)*KP,*Vh=Vh0+(rowbase+(long)T0*KVBLK)*VP;
  const unsigned lds0=(unsigned)(uintptr_t)shm;
  float*wsf=(float*)(shm+LDS_WS)+wid*64;
  const unsigned koff=(unsigned)(lane*KP+wid*8)*2u;
  const unsigned voff=(unsigned)((16*(wid&3)+(lane>>2))*VP+(wid>>2)*32+(lane&3)*8)*2u;
  const unsigned kdst=lds0+LDS_K+wid*1024, vdst=lds0+LDS_V+wid*1024;
  #define DMA_K(t,slot) glds16(Kh+(long)(t)*KVBLK*KP,koff,(unsigned)__builtin_amdgcn_readfirstlane(kdst+(slot)))
  #define DMA_V(t,slot) glds16(Vh+(long)(t)*KVBLK*VP,voff,(unsigned)__builtin_amdgcn_readfirstlane(vdst+(slot)))
  const char*Kbase=shm+LDS_K; bf16x8 kf[8];
  const lds_cptr shm3=(lds_cptr)shm; const lds_cptr kp0=shm3+LDS_K+hi*1024+r32*16; const lds_cptr vp0=shm3+LDS_V+((lane>>4)&1)*32+(lane&3)*8+(4*hi+((lane&15)>>2))*64;
  const int NT=(q0+QB)/KVBLK-T0;
  DMA_K(0,0);DMA_V(0,0);DMA_K(1,SLOTB);
  bf16x8 qr[4];
  #pragma unroll
  for(int d0=0;d0<4;++d0)qr[d0]=*reinterpret_cast<const bf16x8*>(&Qw[(long)r32*QP+d0*16+hi*8]);
  float l_reg=0.f;f32x16 o[2];o[0]=f32x16{};o[1]=f32x16{};f32x16 negm;
  { float hb_=sl*(float)(4*hi); asm volatile("":"+v"(hb_));
    _Pragma("unroll") for(int r=0;r<16;++r)negm[r]=hb_+sl*(float)((r&3)+8*(r>>2)); }
  asm volatile("":"+v"(negm)); const float sl64=64.f*sl;
  const int qrel=wid*QBLK+r32;
  #define CMASK(P0,P1,t) do{int jb_=(t)-(NT-4); if(jb_>=0)cmask(P0,P1,jb_,qrel,hi);}while(0)
  bool resc=false;
  #define START(P0,P1) do{ const float rm=rowmax(P0,P1); resc=false; \
    { const float dl=rm; \
      _Pragma("unroll") for(int r=0;r<16;++r){P0[r]=fsub_s(P0[r],dl);P1[r]=fsub_s(P1[r],dl);} \
      _Pragma("unroll") for(int r=0;r<16;++r)negm[r]-=dl; asm volatile("":"+v"(negm)); } \
    _Pragma("unroll") for(int r=0;r<16;++r)P0[r]=__builtin_amdgcn_exp2f(P0[r]); }while(0)
  #define RESC() do{ if(resc){ asm volatile("s_waitcnt lgkmcnt(0)":::"memory"); \
      _Pragma("unroll") for(int d_=0;d_<2;++d_) _Pragma("unroll") for(int r=0;r<16;++r)o[d_][r]*=wsf[crow(r,hi)]; } }while(0)
  f32x16 pA0,pA1,pB0,pB1;
  int sl_prev=0,sl_cur=0,sl_next=SLOTB;
  #define ROT() do{sl_prev=sl_cur;sl_cur=sl_next;sl_next=(sl_next==(NSLOT-1)*SLOTB)?0:sl_next+SLOTB;}while(0)
  DMA_K(2,2*SLOTB);
  unsigned nxt_=0u; if(wid==0&&lane==0)nxt_=__hip_atomic_fetch_add(qctr,1u,__ATOMIC_RELAXED,__HIP_MEMORY_SCOPE_AGENT);
  WAIT_BAR(3);
  qkt(pA0,pA1,Kbase,qr,negm,r32,hi);asm volatile("s_nop 15\n\ts_nop 7":"+v"(pA0),"+v"(pA1));CMASK(pA0,pA1,0);
  START(pA0,pA1);
  _Pragma("unroll") for(int r=0;r<16;++r)pA1[r]=__builtin_amdgcn_exp2f(pA1[r]);
  WAIT_BAR(0);
  if(wid==0&&lane==0)*(volatile __attribute__((address_space(3))) unsigned*)(shm3+qslot)=nxt_;
  DMA_K(3,0);DMA_V(1,SLOTB);
  ROT();
  kload8(kf,kp0+sl_cur);
  WAIT_BAR(2);
  s16x4 vlo[8],vhi[8]; u32x4 pw0,pw1,pw2,pw3;
  #define PKW(P,B) cvtpk_s(P[B],P[B+1])
  #define PAF(k) __builtin_bit_cast(bf16x8,pw##k)
  #define VFR(i) (bf16x8){vlo[i][0],vlo[i][1],vlo[i][2],vlo[i][3],vhi[i][0],vhi[i][1],vhi[i][2],vhi[i][3]}
  #define PIN(x) asm volatile("":"+v"(x))
  #define MX3(a,b,c) __builtin_fmaxf(__builtin_fmaxf((a),(b)),(c))
  #define GAPA(MF,SA,A0,A1,A2,A3,W0,W1,PW) do{ MF; SA+=A0; SA+=A1; SA+=A2; SA+=A3; PIN(SA); W0; W1; PIN(PW); SBAR(); }while(0)
  #define GAPA2(MF,A0,A1,B0_,B1_,W0,W1,PW) do{ MF; sacc+=A0; sacc+=A1; saccb=B0_+B1_; PIN(sacc); PIN(saccb); W0; W1; PIN(PW); SBAR(); }while(0)
  #define EX(v) __builtin_amdgcn_exp2f(v)
  #define GAPB(MF,X,B) do{ MF; X[B]=EX(X[B]); X[B+1]=EX(X[B+1]); X[B+2]=EX(X[B+2]); X[B+3]=EX(X[B+3]); PIN(X); SBAR(); }while(0)
  #define VRD(i) do{ vlo[i]=vtr(vp_+(((i)>>2)*4096+((i)&3)*1024)); vhi[i]=vtr(vp_+(((i)>>2)*4096+((i)&3)*1024+512)); }while(0)
  #define KRD(G,j) do{ if(G){ kload2(kf,kp0+sl_next,j); SBAR(); } }while(0)
  #define STEP(C0,C1,P0,P1,t,GK,GV,GL) do{ SBAR(); \
    _Pragma("unroll") for(int r=0;r<16;++r)negm[r]+=sl64; asm volatile("":"+v"(negm)); SBAR(); \
    const lds_cptr vp_=vp0+sl_prev; \
    VRD(0); SBAR(); float sacc=(P0[0]+P0[1]); float saccb; \
    GAPA(C0=__builtin_amdgcn_mfma_f32_32x32x16_bf16(kf[0],qr[0],negm,0,0,0), sacc, P0[2],P0[3],P0[4],P0[5],     pw0[0]=PKW(P0,0), pw0[1]=PKW(P0,2), pw0); \
    VRD(4); SBAR(); GAPA(C1=__builtin_amdgcn_mfma_f32_32x32x16_bf16(kf[1],qr[0],negm,0,0,0), sacc, P0[6],P0[7],P0[8],P0[9],     pw0[2]=PKW(P0,4), pw0[3]=PKW(P0,6), pw0); \
    VRD(1); SBAR(); GAPA(C0=__builtin_amdgcn_mfma_f32_32x32x16_bf16(kf[2],qr[1],C0,0,0,0),   sacc, P0[10],P0[11],P0[12],P0[13], pw1[0]=PKW(P0,8), pw1[1]=PKW(P0,10), pw1); \
    VRD(5); SBAR(); GAPA2(C1=__builtin_amdgcn_mfma_f32_32x32x16_bf16(kf[3],qr[1],C1,0,0,0),   P0[14],P0[15],P1[0],P1[1],   pw1[2]=PKW(P0,12),pw1[3]=PKW(P0,14), pw1); \
    VRD(2); SBAR(); GAPA(C0=__builtin_amdgcn_mfma_f32_32x32x16_bf16(kf[4],qr[2],C0,0,0,0),   saccb, P1[2],P1[3],P1[4],P1[5],     pw2[0]=PKW(P1,0), pw2[1]=PKW(P1,2), pw2); \
    VRD(6); SBAR(); GAPA(C1=__builtin_amdgcn_mfma_f32_32x32x16_bf16(kf[5],qr[2],C1,0,0,0),   saccb, P1[6],P1[7],P1[8],P1[9],     pw2[2]=PKW(P1,4), pw2[3]=PKW(P1,6), pw2); \
    VRD(3); SBAR(); GAPA(C0=__builtin_amdgcn_mfma_f32_32x32x16_bf16(kf[6],qr[3],C0,0,0,0),   saccb, P1[10],P1[11],P1[12],P1[13], pw3[0]=PKW(P1,8), pw3[1]=PKW(P1,10), pw3); \
    VRD(7); SBAR(); GAPA(C1=__builtin_amdgcn_mfma_f32_32x32x16_bf16(kf[7],qr[3],C1,0,0,0),   saccb, P1[14],P1[15],0.f,0.f,       pw3[2]=PKW(P1,12),pw3[3]=PKW(P1,14), pw3); \
    l_reg+=sacc+c32*saccb; \
    if(GK){DMA_K((t)+3,sl_cur);} if(GV){DMA_V((t)+1,sl_next);} \
    CMASK(C0,C1,t); \
    { float a=MX3(C0[0],C0[1],C1[0]),b=MX3(C0[2],C0[3],C1[1]); a=MX3(a,C1[2],C1[3]); \
      _Pragma("unroll") for(int r=4;r<16;r+=4){a=MX3(a,C0[r],C0[r+1]);b=MX3(b,C0[r+2],C0[r+3]);a=MX3(a,C1[r],C1[r+1]);b=MX3(b,C1[r+2],C1[r+3]);} \
      float rm=__builtin_fmaxf(a,b); { auto rr=__builtin_amdgcn_permlane32_swap(__float_as_uint(rm),__float_as_uint(rm),false,false); rm=__builtin_fmaxf(__uint_as_float(rr[0]),__uint_as_float(rr[1])); } \
      resc=false; \
      if(__builtin_expect(__any(rm>(float)THRL),0)){ const float dl=__builtin_fmaxf(rm,0.f); \
        _Pragma("unroll") for(int r=0;r<16;++r){C0[r]-=dl;C1[r]-=dl;} \
        _Pragma("unroll") for(int r=0;r<16;++r)negm[r]-=dl; asm volatile("":"+v"(negm)); \
        const float f=__builtin_amdgcn_exp2f(-dl); l_reg*=f; if(hi==0)wsf[r32]=f; resc=true; } } \
    SBAR(); \
    GAPB(o[0]=__builtin_amdgcn_mfma_f32_32x32x16_bf16(PAF(0),VFR(0),o[0],0,0,0), C0,0); \
    GAPB(o[1]=__builtin_amdgcn_mfma_f32_32x32x16_bf16(PAF(0),VFR(4),o[1],0,0,0), C0,4); \
    KRD(GL,0); GAPB(o[0]=__builtin_amdgcn_mfma_f32_32x32x16_bf16(PAF(1),VFR(1),o[0],0,0,0), C0,8); \
    KRD(GL,1); GAPB(o[1]=__builtin_amdgcn_mfma_f32_32x32x16_bf16(PAF(1),VFR(5),o[1],0,0,0), C0,12); \
    KRD(GL,2); GAPB(o[0]=__builtin_amdgcn_mfma_f32_32x32x16_bf16(PAF(2),VFR(2),o[0],0,0,0), C1,0); \
    KRD(GL,3); GAPB(o[1]=__builtin_amdgcn_mfma_f32_32x32x16_bf16(PAF(2),VFR(6),o[1],0,0,0), C1,4); \
    GAPB(o[0]=__builtin_amdgcn_mfma_f32_32x32x16_bf16(PAF(3),VFR(3),o[0],0,0,0), C1,8); \
    GAPB(o[1]=__builtin_amdgcn_mfma_f32_32x32x16_bf16(PAF(3),VFR(7),o[1],0,0,0), C1,12); \
    }while(0)
  int t=1;
  #undef CMASK
  #define CMASK(P0,P1,t) do{}while(0)
  for(;t+5<NT;t+=2){
    STEP(pB0,pB1,pA0,pA1,t,true,true,true);     WAIT_BAR(2); RESC(); ROT();
    STEP(pA0,pA1,pB0,pB1,t+1,true,true,true);   WAIT_BAR(2); RESC(); ROT();
  }
  #undef CMASK
  #define CMASK(P0,P1,t) do{int jb_=(t)-(NT-4); if(jb_>=0)cmask(P0,P1,jb_,qrel,hi);}while(0)
  #define ENDW(tt) do{ if((tt)+3<NT){WAIT_BAR(2);} else if((tt)+2<NT){WAIT_BAR(1);} else {WAIT_BAR(0);} }while(0)
  for(;t+1<NT;t+=2){
    STEP(pB0,pB1,pA0,pA1,t,(t+3<NT),(t+1<NT),(t+1<NT));       ENDW(t);   RESC(); ROT();
    STEP(pA0,pA1,pB0,pB1,t+1,(t+4<NT),(t+2<NT),(t+2<NT));     ENDW(t+1); RESC(); ROT();
  }
  STEP(pB0,pB1,pA0,pA1,NT-1,false,false,false); RESC();
  { float sacc=pB0[0]+pB0[1]; _Pragma("unroll") for(int r=2;r<16;++r)sacc+=pB0[r]; float saccb=pB1[0]+pB1[1]; _Pragma("unroll") for(int r=2;r<16;++r)saccb+=pB1[r]; l_reg+=sacc+c32*saccb;
    pw0=(u32x4){PKW(pB0,0),PKW(pB0,2),PKW(pB0,4),PKW(pB0,6)};pw1=(u32x4){PKW(pB0,8),PKW(pB0,10),PKW(pB0,12),PKW(pB0,14)};pw2=(u32x4){PKW(pB1,0),PKW(pB1,2),PKW(pB1,4),PKW(pB1,6)};pw3=(u32x4){PKW(pB1,8),PKW(pB1,10),PKW(pB1,12),PKW(pB1,14)};
    SBAR(); pv(o,(int)(unsigned)(unsigned long)(vp0+sl_cur),PAF(0),PAF(1),PAF(2),PAF(3)); }
  #undef PKW
  #undef PAF
  #undef VFR
  #undef PIN
  #undef MX3
  #undef GAPA
  #undef GAPA2
  #undef GAPB
  #undef EX
  #undef VRD
  #undef KRD
  #undef STEP
  #undef ENDW
  {auto rr=__builtin_amdgcn_permlane32_swap(__float_as_uint(l_reg),__float_as_uint(l_reg),false,false);l_reg=__uint_as_float(rr[0])+__uint_as_float(rr[1]);}
  if(hi==0)wsf[32+r32]=l_reg;asm volatile("s_waitcnt lgkmcnt(0)":::"memory");
  float rli[16];
  #pragma unroll
  for(int r=0;r<16;++r)rli[r]=__builtin_amdgcn_rcpf(wsf[32+crow(r,hi)]);
  bf16*Ow=Oh+(rowbase+q0+wid*QBLK)*OP;
  { bf16*stg=(bf16*)(shm+LDS_OST)+wid*2048;
    #pragma unroll
    for(int r=0;r<16;++r){const int orow=crow(r,hi);
      #pragma unroll
      for(int d0=0;d0<2;++d0)stg[orow*64+d0*32+r32]=__float2bfloat16(o[d0][r]*rli[r]);}
    asm volatile("s_waitcnt lgkmcnt(0)":::"memory");
    #pragma unroll
    for(int i=0;i<4;++i){const int row=i*8+(lane>>3),ch=lane&7; const u32x4 v=*(const u32x4*)(stg+row*64+ch*8); ATTN_STORE16(Ow+(long)row*OP+ch*8,v);} }
  asm volatile("s_waitcnt lgkmcnt(0)\n\ts_barrier":::"memory");
  #undef DMA_K
  #undef DMA_V
  #undef CMASK
  #undef START
  #undef RESC
  #undef ROT
}
constexpr int ATTN_LDS_BYTES=LDS_BYTES;
constexpr int A2_K=0, A2_V=4*8192, A2_WS=A2_V+3*16384, A2_BYTES=A2_WS+NW*256;
__device__ __forceinline__ void attn_unit2(int b,int qb,const bf16*Qh,const bf16*__restrict__ Kh0,const bf16*__restrict__ Vh0,bf16*Oh,float sl,float c32,char*shm,int wid_in,int T0,unsigned*qctr,unsigned qslot){
  const int lane=lane_id_asm(),r32=lane&31,hi=lane>>5; int wid=wid_in; asm volatile("":"+s"(wid));
  const long rowbase=(long)b*SEQ; const int q0=qb*QB;
  const bf16*Qw=Qh+(rowbase+q0+wid*QBLK)*QP;
  const bf16*Kh=Kh0+(rowbase+(long)T0*KVBLK)*KP,*Vh=Vh0+(rowbase+(long)T0*KVBLK)*VP;
  const unsigned lds0=(unsigned)(uintptr_t)shm;
  float*wsf=(float*)(shm+A2_WS)+wid*64;
  const unsigned koff=(unsigned)(lane*KP+wid*8)*2u;
  const unsigned voff=(unsigned)((16*(wid&3)+(lane>>2))*VP+(wid>>2)*32+(lane&3)*8)*2u;
  const unsigned kdst=lds0+A2_K+wid*1024, vdst=lds0+A2_V+wid*1024;
  #define DMA_K(t,slot) glds16(Kh+(long)(t)*KVBLK*KP,koff,(unsigned)__builtin_amdgcn_readfirstlane(kdst+(slot)))
  #define DMA_V0(t,slot) glds16(Vh+(long)(t)*KVBLK*VP,voff,(unsigned)__builtin_amdgcn_readfirstlane(vdst+2*(slot)))
  #define DMA_V1(t,slot) glds16(Vh+(long)(t)*KVBLK*VP+64,voff,(unsigned)__builtin_amdgcn_readfirstlane(vdst+2*(slot)+8192))
  #define DMA_V(t,slot) do{ DMA_V0(t,slot); DMA_V1(t,slot); }while(0)
  const char*Kbase=shm+A2_K; bf16x8 kf[8];
  const lds_cptr shm3=(lds_cptr)shm; const lds_cptr kp0=shm3+A2_K+hi*1024+r32*16; const lds_cptr vp0=shm3+A2_V+((lane>>4)&1)*32+(lane&3)*8+(4*hi+((lane&15)>>2))*64;
  const int NT=(q0+QB)/KVBLK-T0;
  DMA_K(0,0);DMA_V(0,0);DMA_K(1,8192);
  bf16x8 qr[4];
  #pragma unroll
  for(int d0=0;d0<4;++d0)qr[d0]=*reinterpret_cast<const bf16x8*>(&Qw[(long)r32*QP+d0*16+hi*8]);
  float l_reg=0.f;f32x16 o[4];o[0]=f32x16{};o[1]=f32x16{};o[2]=f32x16{};o[3]=f32x16{};f32x16 negm;
  { float hb_=sl*(float)(64*T0-q0-QBLK*wid-r32+4*hi); asm volatile("":"+v"(hb_));
    _Pragma("unroll") for(int r=0;r<16;++r)negm[r]=hb_+sl*(float)((r&3)+8*(r>>2)); }
  asm volatile("":"+v"(negm)); const float sl64=64.f*sl;
  const int qrel=wid*QBLK+r32;
  #define CMASK(P0,P1,t) do{int jb_=(t)-(NT-4); if(jb_>=0)cmask(P0,P1,jb_,qrel,hi);}while(0)
  int sl_prev=0,sl_cur=0,sl_next=8192;
  #define ROT() do{sl_prev=sl_cur;sl_cur=sl_next;sl_next=(sl_next==2*8192)?0:sl_next+8192;}while(0)
  DMA_K(2,2*8192);
  #define KSL(t) (((t)&3)*8192)
  unsigned nxt_=0u; if(wid==0&&lane==0)nxt_=__hip_atomic_fetch_add(qctr,1u,__ATOMIC_RELAXED,__HIP_MEMORY_SCOPE_AGENT);
  WAIT_BAR(3);
  u32x4 pwA0,pwA1,pwA2,pwA3,pwB0,pwB1,pwB2,pwB3;
  #define PKW(P,B) cvtpk_s(P[B],P[B+1])
  #define EX(v) __builtin_amdgcn_exp2f(v)
  #define PIN(x) asm volatile("":"+v"(x))
  { f32x16 c0,c1; qkt(c0,c1,Kbase,qr,negm,r32,hi); CMASK(c0,c1,0);
    float sa=0.f,sb=0.f;
    _Pragma("unroll") for(int r=0;r<16;++r){c0[r]=EX(c0[r]);c1[r]=EX(c1[r]);sa+=c0[r];sb+=c1[r];}
    l_reg+=sa+c32*sb;
    pwA0=(u32x4){PKW(c0,0),PKW(c0,2),PKW(c0,4),PKW(c0,6)};pwA1=(u32x4){PKW(c0,8),PKW(c0,10),PKW(c0,12),PKW(c0,14)};pwA2=(u32x4){PKW(c1,0),PKW(c1,2),PKW(c1,4),PKW(c1,6)};pwA3=(u32x4){PKW(c1,8),PKW(c1,10),PKW(c1,12),PKW(c1,14)}; }
  WAIT_BAR(0);
  if(wid==0&&lane==0)*(volatile __attribute__((address_space(3))) unsigned*)(shm3+qslot)=nxt_;
  DMA_K(3,3*8192);DMA_V(1,8192);
  ROT();
  kload2(kf,kp0+KSL(1),0); kload2(kf,kp0+KSL(1),1);
  _Pragma("unroll") for(int r=0;r<16;++r)negm[r]+=sl64;
  s16x4 vlo[8],vhi[8];
  #define PAFI(PI,k) __builtin_bit_cast(bf16x8,PI##k)
  #define VFR(i) (bf16x8){vlo[i][0],vlo[i][1],vlo[i][2],vlo[i][3],vhi[i][0],vhi[i][1],vhi[i][2],vhi[i][3]}
  #define VRD(ks,d) do{ vlo[((ks)&1)*4+(d)]=vtr(vp_+((d)*4096+(ks)*1024)); vhi[((ks)&1)*4+(d)]=vtr(vp_+((d)*4096+(ks)*1024+512)); }while(0)
  #define GAPQ(MF) do{ MF; SBAR(); }while(0)
  #define GAPN(MF,B) do{ MF; negm[B]+=sl64; negm[B+1]+=sl64; negm[B+2]+=sl64; negm[B+3]+=sl64; PIN(negm); SBAR(); }while(0)
  #define GAPB(MF,RD,X,SA,B,PO,W) do{ MF; RD; X[B]=EX(X[B]); X[B+1]=EX(X[B+1]); SA+=X[B]; SA+=X[B+1]; PO[W]=PKW(X,B); PIN(X); PIN(SA); PIN(PO); SBAR(); }while(0)
  #define STEP2(PI,PO,t,GK,GV,GL) do{ SBAR(); \
    const lds_cptr vp_=vp0+2*sl_prev; const lds_cptr kq_=kp0+KSL(t); f32x16 C0,C1; float sa=0.f,sb=0.f; \
    kload2(kf,kq_,2); VRD(0,0); SBAR(); kload2(kf,kq_,3); VRD(0,1); SBAR(); \
    GAPQ(C0=__builtin_amdgcn_mfma_f32_32x32x16_bf16(kf[0],qr[0],negm,0,0,0)); \
    VRD(0,2); SBAR(); GAPQ(C1=__builtin_amdgcn_mfma_f32_32x32x16_bf16(kf[1],qr[0],negm,0,0,0)); \
    VRD(0,3); SBAR(); GAPN(C0=__builtin_amdgcn_mfma_f32_32x32x16_bf16(kf[2],qr[1],C0,0,0,0),0); \
    VRD(1,0); SBAR(); GAPN(C1=__builtin_amdgcn_mfma_f32_32x32x16_bf16(kf[3],qr[1],C1,0,0,0),4); \
    VRD(1,1); SBAR(); GAPN(C0=__builtin_amdgcn_mfma_f32_32x32x16_bf16(kf[4],qr[2],C0,0,0,0),8); \
    VRD(1,2); SBAR(); GAPN(C1=__builtin_amdgcn_mfma_f32_32x32x16_bf16(kf[5],qr[2],C1,0,0,0),12); \
    VRD(1,3); SBAR(); GAPQ(C0=__builtin_amdgcn_mfma_f32_32x32x16_bf16(kf[6],qr[3],C0,0,0,0)); \
    GAPQ(C1=__builtin_amdgcn_mfma_f32_32x32x16_bf16(kf[7],qr[3],C1,0,0,0)); \
    CMASK(C0,C1,t); SBAR(); \
    GAPB(o[0]=__builtin_amdgcn_mfma_f32_32x32x16_bf16(PAFI(PI,0),VFR(0),o[0],0,0,0), VRD(2,0), C0,sa,0, PO##0,0); \
    GAPB(o[1]=__builtin_amdgcn_mfma_f32_32x32x16_bf16(PAFI(PI,0),VFR(1),o[1],0,0,0), VRD(2,1), C0,sa,2, PO##0,1); \
    GAPB(o[2]=__builtin_amdgcn_mfma_f32_32x32x16_bf16(PAFI(PI,0),VFR(2),o[2],0,0,0), VRD(2,2), C0,sa,4, PO##0,2); \
    GAPB(o[3]=__builtin_amdgcn_mfma_f32_32x32x16_bf16(PAFI(PI,0),VFR(3),o[3],0,0,0), VRD(2,3), C0,sa,6, PO##0,3); \
    GAPB(o[0]=__builtin_amdgcn_mfma_f32_32x32x16_bf16(PAFI(PI,1),VFR(4),o[0],0,0,0), VRD(3,0), C0,sa,8, PO##1,0); \
    GAPB(o[1]=__builtin_amdgcn_mfma_f32_32x32x16_bf16(PAFI(PI,1),VFR(5),o[1],0,0,0), VRD(3,1), C0,sa,10, PO##1,1); \
    GAPB(o[2]=__builtin_amdgcn_mfma_f32_32x32x16_bf16(PAFI(PI,1),VFR(6),o[2],0,0,0), VRD(3,2), C0,sa,12, PO##1,2); \
    GAPB(o[3]=__builtin_amdgcn_mfma_f32_32x32x16_bf16(PAFI(PI,1),VFR(7),o[3],0,0,0), VRD(3,3), C0,sa,14, PO##1,3); \
    GAPB(o[0]=__builtin_amdgcn_mfma_f32_32x32x16_bf16(PAFI(PI,2),VFR(0),o[0],0,0,0), if(GK){DMA_K((t)+3,KSL((t)+3));}, C1,sb,0, PO##2,0); \
    GAPB(o[1]=__builtin_amdgcn_mfma_f32_32x32x16_bf16(PAFI(PI,2),VFR(1),o[1],0,0,0), if(GL){kload2(kf,kp0+KSL((t)+1),0);}, C1,sb,2, PO##2,1); \
    GAPB(o[2]=__builtin_amdgcn_mfma_f32_32x32x16_bf16(PAFI(PI,2),VFR(2),o[2],0,0,0), if(GV){DMA_V0((t)+1,sl_next);}, C1,sb,4, PO##2,2); \
    GAPB(o[3]=__builtin_amdgcn_mfma_f32_32x32x16_bf16(PAFI(PI,2),VFR(3),o[3],0,0,0), if(GL){kload2(kf,kp0+KSL((t)+1),1);}, C1,sb,6, PO##2,3); \
    GAPB(o[0]=__builtin_amdgcn_mfma_f32_32x32x16_bf16(PAFI(PI,3),VFR(4),o[0],0,0,0), if(GV){DMA_V1((t)+1,sl_next);}, C1,sb,8, PO##3,0); \
    GAPB(o[1]=__builtin_amdgcn_mfma_f32_32x32x16_bf16(PAFI(PI,3),VFR(5),o[1],0,0,0), (void)0, C1,sb,10, PO##3,1); \
    GAPB(o[2]=__builtin_amdgcn_mfma_f32_32x32x16_bf16(PAFI(PI,3),VFR(6),o[2],0,0,0), (void)0, C1,sb,12, PO##3,2); \
    GAPB(o[3]=__builtin_amdgcn_mfma_f32_32x32x16_bf16(PAFI(PI,3),VFR(7),o[3],0,0,0), (void)0, C1,sb,14, PO##3,3); \
    l_reg+=sa+c32*sb; \
    }while(0)
  int t=1;
  #undef CMASK
  #define CMASK(P0,P1,t) do{}while(0)
  for(;t+5<NT;t+=2){
    STEP2(pwA,pwB,t,true,true,true);     WAIT_BAR(3); ROT();
    STEP2(pwB,pwA,t+1,true,true,true);   WAIT_BAR(3); ROT();
  }
  #undef CMASK
  #define CMASK(P0,P1,t) do{int jb_=(t)-(NT-4); if(jb_>=0)cmask(P0,P1,jb_,qrel,hi);}while(0)
  #define ENDW(tt) do{ if((tt)+3<NT){WAIT_BAR(3);} else if((tt)+2<NT){WAIT_BAR(2);} else {WAIT_BAR(0);} }while(0)
  for(;t+1<NT;t+=2){
    STEP2(pwA,pwB,t,(t+3<NT),(t+1<NT),(t+1<NT));       ENDW(t);   ROT();
    STEP2(pwB,pwA,t+1,(t+4<NT),(t+2<NT),(t+2<NT));     ENDW(t+1); ROT();
  }
  STEP2(pwA,pwB,NT-1,false,false,false);
  { const int vb=(int)(unsigned)(unsigned long)(vp0+2*sl_cur);
    #pragma unroll
    for(int d0=0;d0<4;++d0){s16x4 lo[4],hh[4];
      #pragma unroll
      for(int ks=0;ks<4;++ks){
        asm volatile("ds_read_b64_tr_b16 %0,%1 offset:%c2":"=&v"(lo[ks]):"v"(vb),"i"(d0*4096+ks*1024):"memory");
        asm volatile("ds_read_b64_tr_b16 %0,%1 offset:%c2":"=&v"(hh[ks]):"v"(vb),"i"(d0*4096+ks*1024+512):"memory");}
      asm volatile("s_waitcnt lgkmcnt(0)":::"memory");SBAR();
      #define PK(k) (bf16x8){lo[k][0],lo[k][1],lo[k][2],lo[k][3],hh[k][0],hh[k][1],hh[k][2],hh[k][3]}
      o[d0]=__builtin_amdgcn_mfma_f32_32x32x16_bf16(PAFI(pwB,0),PK(0),o[d0],0,0,0);
      o[d0]=__builtin_amdgcn_mfma_f32_32x32x16_bf16(PAFI(pwB,1),PK(1),o[d0],0,0,0);
      o[d0]=__builtin_amdgcn_mfma_f32_32x32x16_bf16(PAFI(pwB,2),PK(2),o[d0],0,0,0);
      o[d0]=__builtin_amdgcn_mfma_f32_32x32x16_bf16(PAFI(pwB,3),PK(3),o[d0],0,0,0);
      #undef PK
    } }
  {auto rr=__builtin_amdgcn_permlane32_swap(__float_as_uint(l_reg),__float_as_uint(l_reg),false,false);l_reg=__uint_as_float(rr[0])+__uint_as_float(rr[1]);}
  if(hi==0)wsf[32+r32]=l_reg;
  asm volatile("s_waitcnt lgkmcnt(0)\n\ts_barrier":::"memory");
  float rli[16];
  #pragma unroll
  for(int r=0;r<16;++r)rli[r]=__builtin_amdgcn_rcpf(wsf[32+crow(r,hi)]);
  bf16*Ow=Oh+(rowbase+q0+wid*QBLK)*OP;
  { bf16*stg=(bf16*)(shm)+wid*4096;
    #pragma unroll
    for(int r=0;r<16;++r){const int orow=crow(r,hi);
      #pragma unroll
      for(int d0=0;d0<4;++d0)stg[orow*128+d0*32+r32]=__float2bfloat16(o[d0][r]*rli[r]);}
    asm volatile("s_waitcnt lgkmcnt(0)":::"memory");
    #pragma unroll
    for(int i=0;i<8;++i){const int row=i*4+(lane>>4),ch=lane&15; const u32x4 v=*(const u32x4*)(stg+row*128+ch*8); ATTN_STORE16(Ow+(long)row*OP+ch*8,v);} }
  asm volatile("s_waitcnt lgkmcnt(0)\n\ts_barrier":::"memory");
  #undef DMA_K
  #undef DMA_V
  #undef DMA_V0
  #undef DMA_V1
  #undef CMASK
  #undef ROT
  #undef PKW
  #undef EX
  #undef PIN
  #undef PAFI
  #undef VFR
  #undef VRD
  #undef KSL
  #undef GAPQ
  #undef GAPN
  #undef GAPB
  #undef STEP2
  #undef ENDW
}
#undef SBAR
#undef WAIT_BAR
}

constexpr int NWAVES = 8;
constexpr int M = 32768, DMODEL = 1024, NIN = 3584, SEQL = 4096;
constexpr size_t MiB = 1u << 20;
constexpr size_t WS_ROWSS = 0;
constexpr size_t WS_WIN = 2 * MiB, WS_WO = 10 * MiB, WS_PW = 12 * MiB;
constexpr size_t WS_XN = 256 * MiB, WS_O = WS_XN;
constexpr size_t WS_HG = 320 * MiB, WS_CG = 352 * MiB, WS_Q = 384 * MiB, WS_K = 416 * MiB, WS_V = 448 * MiB, WS_DG = 480 * MiB, WS_U = 16 * MiB;
constexpr size_t WS_Y = 48 * MiB, WS_Y2 = 112 * MiB, WS_END = 512 * MiB;
constexpr int RING_BYTES = 131072, LDS_BYTES = 147456, LDSCTL_OFF = RING_BYTES;
constexpr size_t WS_BAR = 512 * 1024, WS_BAR_BYTES = 24576;
constexpr int NMAX_WORD = 3600, QCTR_WORD = 3712, GB_WORD = 4096, QG_WORD = 4608, NMG_WORD = 5120, GG_WORD = 5376, SIG_WORD = 5888;
#define GAS __attribute__((address_space(1)))
#define LAS __attribute__((address_space(3)))
typedef unsigned short bf16;
typedef unsigned v4u __attribute__((ext_vector_type(4)));
typedef unsigned v2u __attribute__((ext_vector_type(2)));
typedef float f32x4 __attribute__((ext_vector_type(4)));
typedef float f32x2 __attribute__((ext_vector_type(2)));
#define LDS_WAIT() asm volatile("s_waitcnt lgkmcnt(0)" ::: "memory")
__device__ __forceinline__ unsigned pk2(float lo, float hi) { return pg8::cvt_pk_bf16(lo, hi); }
__device__ __forceinline__ float wave_sum(float v) {
#pragma unroll
    for (int o = 1; o < 64; o <<= 1) v += __shfl_xor(v, o);
    return v;
}
__device__ __forceinline__ void p0_transpose_item(const float* W, int K, int N, bf16* WT, int k0, int n0, int dst_row0, LAS float* scr, int lane) {
#pragma unroll
    for (int i = 0; i < 32; ++i) { const int kk = 2 * i + (lane >> 5); scr[kk * 33 + (lane & 31)] = W[(size_t)(k0 + kk) * N + n0 + (lane & 31)]; }
    LDS_WAIT(); asm volatile("" ::: "memory");
    const int c = lane & 7;
#pragma unroll
    for (int j = 0; j < 4; ++j) { const int n = (lane >> 3) + 8 * j; const LAS float* p = scr + (8 * c) * 33 + n;
        v4u o; o.x = pk2(p[0 * 33], p[1 * 33]); o.y = pk2(p[2 * 33], p[3 * 33]); o.z = pk2(p[4 * 33], p[5 * 33]); o.w = pk2(p[6 * 33], p[7 * 33]);
        *(v4u*)(WT + (size_t)(dst_row0 + n) * K + k0 + 8 * c) = o; }
    LDS_WAIT(); asm volatile("" ::: "memory");
}
__device__ __forceinline__ int win_dst_row(int n0) {
    if (n0 >= 1024) return n0;
    if (n0 < 512) return 256 * (n0 >> 7) + (n0 & 127);
    const int n1 = n0 - 512; return 256 * (n1 >> 7) + 128 + (n1 & 127);
}

#define RLX_AGENT __ATOMIC_RELAXED, __HIP_MEMORY_SCOPE_AGENT
#define XB_TMO      128
#define XB_XCNT(j)  (256  + 64 * (j))
#define XB_XSUB(j)  (1280 + 64 * (j))
#define XB_XGEN(j)  (2304 + 64 * (j))
#define XB_TOP      3328
#define XB_TOPGEN   3392
#define XCD_BAR_WORDS 3456
#define XB_SPIN_CAP (1u << 18)

__device__ __forceinline__ unsigned xb_ld(unsigned* p)              { return __hip_atomic_load(p, __ATOMIC_RELAXED, __HIP_MEMORY_SCOPE_AGENT); }
__device__ __forceinline__ unsigned xb_add(unsigned* p, unsigned v) { return __hip_atomic_fetch_add(p, v, __ATOMIC_RELAXED, __HIP_MEMORY_SCOPE_AGENT); }
__device__ __forceinline__ unsigned xb_xcc_id() { return (unsigned)__builtin_amdgcn_s_getreg((3 << 11) | 20) & 0xFu; }
#define XB_SPIN(cond, bar) do { unsigned _sp = 0; while (cond) { __builtin_amdgcn_s_sleep(1); \
    if ((++_sp & 255u) == 0u) { if (xb_ld(&(bar)[XB_TMO])) break; if (_sp > XB_SPIN_CAP) { atomicAdd(&(bar)[XB_TMO], 1u); break; } } } } while (0)

struct XcdBarrier {
    unsigned* bar; unsigned x;
    volatile LAS unsigned* st;
};

__device__ __forceinline__ XcdBarrier xcd_barrier_post(unsigned* bar, volatile LAS unsigned* st) {
    XcdBarrier b; b.bar = bar; b.x = xb_xcc_id(); b.st = st;
    if (threadIdx.x == 0) (void)xb_add(&bar[XB_XCNT(b.x)], 1u);
    return b;
}
__device__ __forceinline__ void xcd_barrier_complete(unsigned* bar, unsigned x, unsigned& nloc, unsigned& nx) {
    const unsigned G = gridDim.x * gridDim.y * gridDim.z;
    unsigned sum, cnt, mine, sp = 0u;
    for (;;) {
        sum = 0u; cnt = 0u; mine = 0u;
#pragma unroll
        for (unsigned j = 0; j < 16; ++j) { const unsigned c = xb_ld(&bar[XB_XCNT(j)]); sum += c; cnt += (c > 0u) ? 1u : 0u; mine = (j == x) ? c : mine; }
        if (sum == G) break;
        __builtin_amdgcn_s_sleep(1);
        if ((++sp & 255u) == 0u) { if (xb_ld(&bar[XB_TMO])) break; if (sp > XB_SPIN_CAP) { atomicAdd(&bar[XB_TMO], 1u); break; } }
    }
    nloc = mine > 0u ? mine : 1u; nx = cnt > 0u ? cnt : 1u;
}

__device__ __forceinline__ void xcd_barrier(const XcdBarrier& b) {
    asm volatile("s_waitcnt vmcnt(0)" ::: "memory");
    __syncthreads();
    if (threadIdx.x == 0) {
        unsigned* bar = b.bar;
        __builtin_amdgcn_s_waitcnt(0);
        unsigned nloc = b.st[0], nx = b.st[1];
        if (nloc == 0u) { xcd_barrier_complete(bar, b.x, nloc, nx); b.st[0] = nloc; b.st[1] = nx; }
        const unsigned old = xb_add(&bar[XB_XSUB(b.x)], 1u);
        const unsigned gen = old / nloc;
        if (old + 1u == (gen + 1u) * nloc) {
            __builtin_amdgcn_fence(__ATOMIC_RELEASE, "agent");
            asm volatile("s_waitcnt vmcnt(0)" ::: "memory");
            const unsigned og = xb_add(&bar[XB_TOP], 1u);
            const unsigned tg = og / nx;
            if (og + 1u == (tg + 1u) * nx) xb_add(&bar[XB_TOPGEN], 1u);
            else XB_SPIN(xb_ld(&bar[XB_TOPGEN]) == tg, bar);
            __builtin_amdgcn_fence(__ATOMIC_ACQUIRE, "agent");
            xb_add(&bar[XB_XGEN(b.x)], 1u);
            asm volatile("s_waitcnt vmcnt(0)" ::: "memory");
        } else {
            XB_SPIN(xb_ld(&bar[XB_XGEN(b.x)]) == gen, bar);
            __builtin_amdgcn_fence(__ATOMIC_ACQUIRE, "agent");
            asm volatile("s_waitcnt vmcnt(0)" ::: "memory");
        }
    }
    __syncthreads();
}

__device__ __forceinline__ void group_barrier(unsigned* ctr, unsigned target) {
    asm volatile("s_waitcnt vmcnt(0)" ::: "memory");
    __syncthreads();
    if (threadIdx.x == 0) {
        __builtin_amdgcn_fence(__ATOMIC_RELEASE, "agent");
        asm volatile("s_waitcnt vmcnt(0)" ::: "memory");
        __hip_atomic_fetch_add(ctr, 1u, __ATOMIC_RELAXED, __HIP_MEMORY_SCOPE_AGENT);
        unsigned sp = 0u;
        while (__hip_atomic_load(ctr, __ATOMIC_RELAXED, __HIP_MEMORY_SCOPE_AGENT) < target && ++sp < (1u << 22)) __builtin_amdgcn_s_sleep(1);
        __builtin_amdgcn_fence(__ATOMIC_ACQUIRE, "agent");
        asm volatile("s_waitcnt vmcnt(0)" ::: "memory");
    }
    __syncthreads();
}

__device__ __forceinline__ void group_barrier_1xcc(unsigned* ctr, unsigned* gen, unsigned target, unsigned k) {
    asm volatile("s_waitcnt vmcnt(0)" ::: "memory");
    __syncthreads();
    if (threadIdx.x == 0) {
        const unsigned old = __hip_atomic_fetch_add(ctr, 1u, __ATOMIC_RELAXED, __HIP_MEMORY_SCOPE_AGENT);
        if (old + 1u == target) {
            __builtin_amdgcn_fence(__ATOMIC_RELEASE, "agent");
            asm volatile("s_waitcnt vmcnt(0)" ::: "memory");
            __hip_atomic_fetch_add(gen, 1u, __ATOMIC_RELAXED, __HIP_MEMORY_SCOPE_AGENT);
        } else { unsigned sp = 0u; while (__hip_atomic_load(gen, __ATOMIC_RELAXED, __HIP_MEMORY_SCOPE_AGENT) < k && ++sp < (1u << 22)) __builtin_amdgcn_s_sleep(1); }
        __builtin_amdgcn_fence(__ATOMIC_ACQUIRE, "agent");
        asm volatile("s_waitcnt vmcnt(0)" ::: "memory");
    }
    __syncthreads();
}

constexpr int CONV_IN_BYTES = 62 * 1024;
__device__ __forceinline__ void conv_phase(LAS unsigned char* lds, int u0, int ustride, int nunits, const bf16* Hg, const float* dw_w, const float* dw_b, const float* ln_g, const float* ln_b, bf16* U, int tid, int lane, int wave) {
    const int cp = tid & 255, tg = tid >> 8;
    f32x2 w[31];
#pragma unroll
    for (int j = 0; j < 31; ++j) w[j] = *(const f32x2*)(dw_w + j * 512 + 2 * cp);
    const f32x2 bias = *(const f32x2*)(dw_b + 2 * cp);
    f32x4 gg[2], bb[2];
#pragma unroll
    for (int j = 0; j < 2; ++j) { gg[j] = *((const f32x4*)ln_g + lane + 64 * j); bb[j] = *((const f32x4*)ln_b + lane + 64 * j); }
    v4u pre[8];
#define CONV_PREFETCH(unit) do { const int row0_ = (unit) * 32, t0_ = row0_ & (SEQL - 1); _Pragma("unroll") for (int k = 0; k < 8; ++k) { const int i = tid + 512 * k, r = i >> 6, ch = i & 63; pre[k] = (v4u){0u, 0u, 0u, 0u}; \
        if (i < 62 * 64 && t0_ - 30 + r >= 0) pre[k] = *(const v4u*)(Hg + (size_t)(row0_ - 30 + r) * 512 + ch * 8); } } while (0)
    if (u0 < nunits) CONV_PREFETCH(u0);
    for (int unit = u0; unit < nunits; unit += ustride) {
        const int row0 = unit * 32;
#pragma unroll
        for (int k = 0; k < 8; ++k) { const int i = tid + 512 * k, r = i >> 6, ch = i & 63; if (i < 62 * 64) *(LAS v4u*)(lds + r * 1024 + ch * 16) = pre[k]; }
        __syncthreads();
        if (unit + ustride < nunits) CONV_PREFETCH(unit + ustride);
#pragma unroll 1
        for (int g = 0; g < 2; ++g) {
            const int tl0 = tg * 16 + g * 8;
            f32x2 acc[8];
#pragma unroll
            for (int o = 0; o < 8; ++o) acc[o] = bias;
#pragma unroll
            for (int i = 0; i < 38; ++i) { const unsigned wv = *(const LAS unsigned*)(lds + (tl0 + i) * 1024 + cp * 4); const f32x2 x = {pg8::bf_lo(wv), pg8::bf_hi(wv)};
#pragma unroll
                for (int o = 0; o < 8; ++o) { const int j = i - o; if (j >= 0 && j <= 30) acc[o] += w[j] * x; } }
#pragma unroll
            for (int o = 0; o < 8; ++o) *(LAS f32x2*)(lds + CONV_IN_BYTES + (tl0 + o) * 2048 + cp * 8) = acc[o];
        }
        __syncthreads();
        f32x4 v[4][2]; float s1[4], s2[4];
#pragma unroll
        for (int k = 0; k < 4; ++k) { const int tl = wave * 4 + k; s1[k] = 0.f;
#pragma unroll
            for (int j = 0; j < 2; ++j) { v[k][j] = *(const LAS f32x4*)(lds + CONV_IN_BYTES + tl * 2048 + (lane + 64 * j) * 16); s1[k] += (v[k][j].x + v[k][j].y) + (v[k][j].z + v[k][j].w); } }
#pragma unroll
        for (int o = 1; o < 64; o <<= 1) {
#pragma unroll
            for (int k = 0; k < 4; ++k) s1[k] += __shfl_xor(s1[k], o); }
#pragma unroll
        for (int k = 0; k < 4; ++k) { const float mean = s1[k] * (1.f / 512.f); s2[k] = 0.f;
#pragma unroll
            for (int j = 0; j < 2; ++j) { v[k][j] = v[k][j] - mean; s2[k] += (v[k][j].x * v[k][j].x + v[k][j].y * v[k][j].y) + (v[k][j].z * v[k][j].z + v[k][j].w * v[k][j].w); } }
#pragma unroll
        for (int o = 1; o < 64; o <<= 1) {
#pragma unroll
            for (int k = 0; k < 4; ++k) s2[k] += __shfl_xor(s2[k], o); }
#pragma unroll
        for (int k = 0; k < 4; ++k) { const int tl = wave * 4 + k; const float rstd = 1.f / sqrtf(s2[k] * (1.f / 512.f) + 1e-5f);
#pragma unroll
            for (int j = 0; j < 2; ++j) { f32x4 y = v[k][j] * rstd * gg[j] + bb[j];
                y.x = pg8::silu_f(y.x); y.y = pg8::silu_f(y.y); y.z = pg8::silu_f(y.z); y.w = pg8::silu_f(y.w);
                v2u o; o.x = pk2(y.x, y.y); o.y = pk2(y.z, y.w); *(v2u*)(U + (size_t)(row0 + tl) * 512 + (lane + 64 * j) * 4) = o; } }
        __syncthreads();
    }
#undef CONV_PREFETCH
}

__device__ __forceinline__ void conv_phase_dyn(LAS unsigned char* lds, int cur, unsigned* qctr, int qbase  , int nunits, const bf16* Hg, const float* dw_w, const float* dw_b, const float* ln_g, const float* ln_b, bf16* U, int tid, int lane, int wave) {
    const int cp = tid & 255, tg = tid >> 8;
    f32x2 w[31];
#pragma unroll
    for (int j = 0; j < 31; ++j) w[j] = *(const f32x2*)(dw_w + j * 512 + 2 * cp);
    const f32x2 bias = *(const f32x2*)(dw_b + 2 * cp);
    f32x4 gg[2], bb[2];
#pragma unroll
    for (int j = 0; j < 2; ++j) { gg[j] = *((const f32x4*)ln_g + lane + 64 * j); bb[j] = *((const f32x4*)ln_b + lane + 64 * j); }
    v4u pre[8];
#define CONV_PREFETCH(unit) do { const int row0_ = (unit) * 32, t0_ = row0_ & (SEQL - 1); _Pragma("unroll") for (int k = 0; k < 8; ++k) { const int i = tid + 512 * k, r = i >> 6, ch = i & 63; pre[k] = (v4u){0u, 0u, 0u, 0u}; \
        if (i < 62 * 64 && t0_ - 30 + r >= 0) pre[k] = *(const v4u*)(Hg + (size_t)(row0_ - 30 + r) * 512 + ch * 8); } } while (0)
    const bool popper = (wave == 0 && lane == 0); volatile LAS unsigned* slot = (volatile LAS unsigned*)(lds + LDSCTL_OFF + 224);
    if (popper) slot[0] = __hip_atomic_fetch_add(qctr, 1u, __ATOMIC_RELAXED, __HIP_MEMORY_SCOPE_AGENT);
    __syncthreads();
    int nxt = qbase + (int)__builtin_amdgcn_readfirstlane(slot[0]);
    if (cur < nunits) CONV_PREFETCH(cur);
    while (cur < nunits) {
        const int unit = cur; const int row0 = unit * 32;
#pragma unroll
        for (int k = 0; k < 8; ++k) { const int i = tid + 512 * k, r = i >> 6, ch = i & 63; if (i < 62 * 64) *(LAS v4u*)(lds + r * 1024 + ch * 16) = pre[k]; }
        __syncthreads();
        unsigned pv = 0u; if (popper) pv = __hip_atomic_fetch_add(qctr, 1u, __ATOMIC_RELAXED, __HIP_MEMORY_SCOPE_AGENT);
        if (nxt < nunits) CONV_PREFETCH(nxt);
#pragma unroll 1
        for (int g = 0; g < 2; ++g) {
            const int tl0 = tg * 16 + g * 8;
            f32x2 acc[8];
#pragma unroll
            for (int o = 0; o < 8; ++o) acc[o] = bias;
#pragma unroll
            for (int i = 0; i < 38; ++i) { const unsigned wv = *(const LAS unsigned*)(lds + (tl0 + i) * 1024 + cp * 4); const f32x2 x = {pg8::bf_lo(wv), pg8::bf_hi(wv)};
#pragma unroll
                for (int o = 0; o < 8; ++o) { const int j = i - o; if (j >= 0 && j <= 30) acc[o] += w[j] * x; } }
#pragma unroll
            for (int o = 0; o < 8; ++o) *(LAS f32x2*)(lds + CONV_IN_BYTES + (tl0 + o) * 2048 + cp * 8) = acc[o];
        }
        __syncthreads();
        f32x4 v[4][2]; float s1[4], s2[4];
#pragma unroll
        for (int k = 0; k < 4; ++k) { const int tl = wave * 4 + k; s1[k] = 0.f;
#pragma unroll
            for (int j = 0; j < 2; ++j) { v[k][j] = *(const LAS f32x4*)(lds + CONV_IN_BYTES + tl * 2048 + (lane + 64 * j) * 16); s1[k] += (v[k][j].x + v[k][j].y) + (v[k][j].z + v[k][j].w); } }
#pragma unroll
        for (int o = 1; o < 64; o <<= 1) {
#pragma unroll
            for (int k = 0; k < 4; ++k) s1[k] += __shfl_xor(s1[k], o); }
#pragma unroll
        for (int k = 0; k < 4; ++k) { const float mean = s1[k] * (1.f / 512.f); s2[k] = 0.f;
#pragma unroll
            for (int j = 0; j < 2; ++j) { v[k][j] = v[k][j] - mean; s2[k] += (v[k][j].x * v[k][j].x + v[k][j].y * v[k][j].y) + (v[k][j].z * v[k][j].z + v[k][j].w * v[k][j].w); } }
#pragma unroll
        for (int o = 1; o < 64; o <<= 1) {
#pragma unroll
            for (int k = 0; k < 4; ++k) s2[k] += __shfl_xor(s2[k], o); }
#pragma unroll
        for (int k = 0; k < 4; ++k) { const int tl = wave * 4 + k; const float rstd = 1.f / sqrtf(s2[k] * (1.f / 512.f) + 1e-5f);
#pragma unroll
            for (int j = 0; j < 2; ++j) { f32x4 y = v[k][j] * rstd * gg[j] + bb[j];
                y.x = pg8::silu_f(y.x); y.y = pg8::silu_f(y.y); y.z = pg8::silu_f(y.z); y.w = pg8::silu_f(y.w);
                v2u o; o.x = pk2(y.x, y.y); o.y = pk2(y.z, y.w); *(v2u*)(U + (size_t)(row0 + tl) * 512 + (lane + 64 * j) * 4) = o; } }
        if (popper) slot[0] = pv;
        __syncthreads();
        cur = nxt; nxt = qbase + (int)__builtin_amdgcn_readfirstlane(slot[0]);
        __syncthreads();
    }
#undef CONV_PREFETCH
}

struct Args { const float* in[16]; float* out; unsigned char* ws; };
__global__ void __launch_bounds__(NWAVES * 64, 2) fwd_megakernel(Args args) {
    extern __shared__ __attribute__((aligned(16))) unsigned char lds[];
    cg::grid_group grid = cg::this_grid();
    LAS unsigned char* L = (LAS unsigned char*)lds;
    const int wave = __builtin_amdgcn_readfirstlane(threadIdx.x >> 6);
#define FRESH_TID() const int lane = lane_id_asm(); const int tid = wave * 64 + lane; (void)tid
    const int G = gridDim.x; const int bx = blockIdx.x; const int vcu = (G % 8 == 0) ? (bx % 8) * (G / 8) + bx / 8 : bx;
    const int gw = vcu * NWAVES + wave, NGW = G * NWAVES;
    const bool grp = (G == 256); const int NGRP = grp ? 8 : 1, GS = G / NGRP, gi = grp ? (bx & 7) : 0, gj = grp ? (bx >> 3) : bx, NB = 8 / NGRP, RPG = M / NGRP;
    const int gwl = gj * NWAVES + wave, NGWL = GS * NWAVES; unsigned gbt = 0u;
    bool one_xcc = false; unsigned gbk = 0u;
#define GROUP_BAR() do { gbt += (unsigned)GS; ++gbk; if (one_xcc) group_barrier_1xcc((unsigned*)(args.ws + WS_BAR) + GB_WORD + 64 * gi, (unsigned*)(args.ws + WS_BAR) + GG_WORD + 64 * gi, gbt, gbk); \
        else group_barrier((unsigned*)(args.ws + WS_BAR) + GB_WORD + 64 * gi, gbt); } while (0)
#define CA4 __attribute__((address_space(4)))
#define PHASE_PTRS() \
    const CA4 Args* A_; { auto kp_ = __builtin_amdgcn_kernarg_segment_ptr(); asm volatile("" : "+s"(kp_)); A_ = (const CA4 Args*)kp_; } \
    unsigned char* ws = A_->ws; (void)ws; \
    const float* x = A_->in[0]; const float* pre_g = A_->in[1]; const float* w_in = A_->in[2]; const float* dw_w = A_->in[3]; const float* dw_b = A_->in[4]; \
    const float* cln_g = A_->in[5]; const float* cln_b = A_->in[6]; const float* pw_w = A_->in[7]; const float* pw_b = A_->in[8]; \
    const float* lq1 = A_->in[9]; const float* lk1 = A_->in[10]; const float* lq2 = A_->in[11]; const float* lk2 = A_->in[12]; \
    const float* sub_g = A_->in[13]; const float* w_out = A_->in[14]; const float* post_g = A_->in[15]; float* out = A_->out; \
    float* rowss = (float*)(ws + WS_ROWSS); \
    bf16 *WinT = (bf16*)(ws + WS_WIN), *WoT = (bf16*)(ws + WS_WO), *PwT = (bf16*)(ws + WS_PW), *XN = (bf16*)(ws + WS_XN), *OB = (bf16*)(ws + WS_O); \
    bf16 *HG = (bf16*)(ws + WS_HG), *CGB = (bf16*)(ws + WS_CG), *QB_ = (bf16*)(ws + WS_Q), *KB = (bf16*)(ws + WS_K), *VB = (bf16*)(ws + WS_V), *DGB = (bf16*)(ws + WS_DG), *UB = (bf16*)(ws + WS_U); \
    bf16 *YB = (bf16*)(ws + WS_Y), *Y2 = (bf16*)(ws + WS_Y2); \
    (void)x; (void)pre_g; (void)w_in; (void)dw_w; (void)dw_b; (void)cln_g; (void)cln_b; (void)pw_w; (void)pw_b; (void)lq1; (void)lk1; (void)lq2; (void)lk2; (void)sub_g; (void)w_out; (void)post_g; (void)out; \
    (void)rowss; (void)WinT; (void)WoT; (void)PwT; (void)XN; (void)OB; (void)HG; (void)CGB; (void)QB_; (void)KB; (void)VB; (void)DGB; (void)UB; (void)YB; (void)Y2
    if (threadIdx.x < 128) ((LAS unsigned*)(L + LDSCTL_OFF))[threadIdx.x] = 0u;
    __syncthreads();
    XcdBarrier bar = xcd_barrier_post((unsigned*)(args.ws + WS_BAR), (volatile LAS unsigned*)(L + LDSCTL_OFF));
    if (threadIdx.x == 0) atomicOr((unsigned*)(args.ws + WS_BAR) + SIG_WORD + gi, 1u << (xb_xcc_id() & 15u));
    if (args.ws == nullptr) grid.sync();

    {
        PHASE_PTRS(); FRESH_TID();
        LAS float* scr = (LAS float*)(L + wave * 16384);
        constexpr int I_IN = (DMODEL / 64) * (NIN / 32), I_O = (1024 / 64) * (1024 / 32), I_PW = (512 / 64) * (512 / 32);
        for (int it = gw; it < I_IN + I_O + I_PW; it += NGW) {
            int r = it;
            if (r < I_IN) { const int nblk = NIN / 32, kb = r / nblk, nb = r % nblk; p0_transpose_item(w_in, DMODEL, NIN, WinT, 64 * kb, 32 * nb, win_dst_row(32 * nb), scr, lane); continue; } r -= I_IN;
            if (r < I_O) { const int nblk = 1024 / 32, kb = r / nblk, nb = r % nblk; p0_transpose_item(w_out, 1024, 1024, WoT, 64 * kb, 32 * nb, 32 * nb, scr, lane); continue; } r -= I_O;
            { const int nblk = 512 / 32, kb = r / nblk, nb = r % nblk; p0_transpose_item(pw_w, 512, 512, PwT, 64 * kb, 32 * nb, 32 * nb, scr, lane); }
        }
        for (int i = bx * 512 + tid; i < M; i += G * 512) rowss[i] = 0.f;
        f32x4 gv[4];
#pragma unroll
        for (int j = 0; j < 4; ++j) gv[j] = *((const f32x4*)pre_g + lane + 64 * j);
        for (int m0 = gw; m0 < M; m0 += 4 * NGW) {
            f32x4 v[4][4]; float ss[4];
#pragma unroll
            for (int k = 0; k < 4; ++k) { const int m = m0 + k * NGW; const f32x4* xr = (const f32x4*)(x + (size_t)(m < M ? m : m0) * DMODEL) + lane;
#pragma unroll
                for (int j = 0; j < 4; ++j) v[k][j] = __builtin_nontemporal_load(xr + 64 * j); }
#pragma unroll
            for (int k = 0; k < 4; ++k) { ss[k] = 0.f;
#pragma unroll
                for (int j = 0; j < 4; ++j) ss[k] += (v[k][j].x * v[k][j].x + v[k][j].y * v[k][j].y) + (v[k][j].z * v[k][j].z + v[k][j].w * v[k][j].w); }
#pragma unroll
            for (int o = 1; o < 64; o <<= 1) {
#pragma unroll
                for (int k = 0; k < 4; ++k) ss[k] += __shfl_xor(ss[k], o); }
#pragma unroll
            for (int k = 0; k < 4; ++k) { const int m = m0 + k * NGW; if (m < M) { const float rstd = 1.f / sqrtf(ss[k] * (1.f / DMODEL) + 1e-6f);
                v2u* o8 = (v2u*)(XN + (size_t)m * DMODEL) + lane;
#pragma unroll
                for (int j = 0; j < 4; ++j) { const f32x4 y = v[k][j] * rstd * gv[j]; v2u o; o.x = pk2(y.x, y.y); o.y = pk2(y.z, y.w); o8[64 * j] = o; } } }
        }
    }
    xcd_barrier(bar);
    { const unsigned sig_ = __hip_atomic_load((unsigned*)(args.ws + WS_BAR) + SIG_WORD + gi, RLX_AGENT); one_xcc = (__builtin_popcount(sig_) == 1); }

    {
        PHASE_PTRS();
        pg8::Gemm g{XN, WinT, M, NIN, DMODEL}; pg8::StaticOrder S; S.init(M, NIN, G, bx);
        pg8::EpiIn E{HG, CGB, QB_, KB, VB, DGB, (unsigned*)(ws + WS_BAR) + NMG_WORD + 16 * gi};
        pg8::gemm_phase<pg8::EpiIn, pg8::StaticOrder, PG8_ALIGN, PG8_SP2>(L, g, S, E, wave);
    }
    GROUP_BAR();

    {
        PHASE_PTRS(); FRESH_TID();
        unsigned* ctlw = (unsigned*)(ws + WS_BAR); unsigned* nmx = ctlw + NMG_WORD + 16 * gi; unsigned* qg = ctlw + QG_WORD + 64 * gi;
        int Wt[8]; float sbmax = 0.f;
#pragma unroll
        for (int i = 0; i < 8; ++i) { const float qm = __uint_as_float(__hip_atomic_load(nmx + i, RLX_AGENT)), km = __uint_as_float(__hip_atomic_load(nmx + 8 + i, RLX_AGENT));
            const float Sb = 2.02f * sqrtf(qm * km);
            sbmax = fmaxf(sbmax, Sb);
            const float w = (2.f * Sb + 42.f) / (64.f * pg8::alibi_sl(i >> 1)); Wt[i] = w < 64.f ? (int)w + 1 : 64; }
        const unsigned qslot = LDSCTL_OFF + 64;
        const int NA = 128 * NB, convbase = (RPG / 32) * gi;
        if (sbmax <= 60.f) {
            int u = gj;
            while (u < NA) {
                const int b = gi * NB + (u >> 7), ul = u & 127; int qb, h, c;
                if (ul < 44) { qb = 15 - (ul >> 2); h = 2 + ((ul >> 1) & 1); c = ul & 1; }
                else if (ul < 76) { const int v = ul - 44; h = 1; qb = 15 - (v >> 1); c = v & 1; }
                else if (ul < 96) { const int v = ul - 76; qb = 4 - (v >> 2); h = 2 + ((v >> 1) & 1); c = v & 1; }
                else { const int v = ul - 96; h = 0; qb = 15 - (v >> 1); c = v & 1; }
                const int hc = 2 * h + c; int W = Wt[0];
#pragma unroll
                for (int i = 1; i < 8; ++i) W = (hc == i) ? Wt[i] : W;
                int T0 = 4 * qb - W; T0 = T0 > 0 ? (T0 & ~1) : 0;
                attn_body::attn_unit2(b, qb, (const attn_body::bf16*)(QB_ + h * 128 + c * 64), (const attn_body::bf16*)(KB + h * 128 + c * 64), (const attn_body::bf16*)(VB + h * 128),
                                      (attn_body::bf16*)(OB + h * 256 + c * 128), pg8::alibi_sl(h), pg8::alibi_c32(h), (char*)lds, wave, T0, qg, qslot);
                u = GS + (int)__builtin_amdgcn_readfirstlane(*(volatile LAS unsigned*)(L + qslot));
            }
            { const int ucur_ = convbase + (u - NA), qbase_ = convbase + GS - NA, uend_ = convbase + NA; PHASE_PTRS(); FRESH_TID();
              conv_phase_dyn(L, ucur_, (unsigned*)(ws + WS_BAR) + QG_WORD + 64 * gi, qbase_, uend_, HG, dw_w, dw_b, cln_g, cln_b, UB, tid, lane, wave); }
        } else {
        conv_phase(L, convbase + gj, GS, convbase + NA, HG, dw_w, dw_b, cln_g, cln_b, UB, tid, lane, wave);
        int u = gj;
        while (u < 2 * NA) {
            const int b = gi * NB + (u >> 8), r = u & 255, qb = 15 - (r >> 4), h = (r >> 2) & 3, c = (r >> 1) & 1, vh = r & 1;
            const int hc = 2 * h + c; int W = Wt[0];
#pragma unroll
            for (int i = 1; i < 8; ++i) W = (hc == i) ? Wt[i] : W;
            int T0 = 4 * qb - W; T0 = T0 > 0 ? (T0 & ~1) : 0;
            attn_body::attn_unit<8>(b, qb, (const attn_body::bf16*)(QB_ + h * 128 + c * 64), (const attn_body::bf16*)(KB + h * 128 + c * 64), (const attn_body::bf16*)(VB + h * 128 + vh * 64),
                                    (attn_body::bf16*)(OB + h * 256 + c * 128 + vh * 64), pg8::alibi_sl(h), pg8::alibi_c32(h), (char*)lds, wave, T0, qg, qslot);
            u = GS + (int)__builtin_amdgcn_readfirstlane(*(volatile LAS unsigned*)(L + qslot));
        }
        }
    }
    GROUP_BAR();

    {
        PHASE_PTRS();
        {
            pg8::Gemm g{UB, PwT, M, 512, 512}; pg8::StaticOrder S; S.init(M, 512, G, bx);
            pg8::EpiPw E{CGB, pw_b, YB};
            pg8::gemm_phase<pg8::EpiPw, pg8::StaticOrder, PG8_ALIGN, PG8_SP2>(L, g, S, E, wave);
        }
        FRESH_TID();
        const float lam = expf(wave_sum(lq1[lane] * lk1[lane])) - expf(wave_sum(lq2[lane] * lk2[lane])) + 0.2f;
        const int h = lane >> 4, ec = (lane & 15) * 8;
        float gs[8];
#pragma unroll
        for (int j = 0; j < 8; ++j) gs[j] = sub_g[ec + j] * 0.8f;
        for (int m0 = gwl; m0 < RPG; m0 += 4 * NGWL) {
            v4u a[4], bq[4], gt[4];
#pragma unroll
            for (int k = 0; k < 4; ++k) { const int ml = m0 + k * NGWL; const size_t m = (size_t)(RPG * gi + (ml < RPG ? ml : m0));
                a[k] = *(const v4u*)(OB + m * 1024 + h * 256 + ec); bq[k] = *(const v4u*)(OB + m * 1024 + h * 256 + 128 + ec); gt[k] = *(const v4u*)(DGB + m * 512 + h * 128 + ec); }
#pragma unroll
            for (int k = 0; k < 4; ++k) { const int ml = m0 + k * NGWL; if (ml >= RPG) continue; const int mm = RPG * gi + ml;
                const unsigned aw[4] = {a[k].x, a[k].y, a[k].z, a[k].w}, bw[4] = {bq[k].x, bq[k].y, bq[k].z, bq[k].w}, gw4[4] = {gt[k].x, gt[k].y, gt[k].z, gt[k].w};
                float o[8]; float ss = 0.f;
#pragma unroll
                for (int j = 0; j < 4; ++j) { o[2 * j] = pg8::bf_lo(aw[j]) - lam * pg8::bf_lo(bw[j]); o[2 * j + 1] = pg8::bf_hi(aw[j]) - lam * pg8::bf_hi(bw[j]); ss += o[2 * j] * o[2 * j] + o[2 * j + 1] * o[2 * j + 1]; }
                ss += __shfl_xor(ss, 1); ss += __shfl_xor(ss, 2); ss += __shfl_xor(ss, 4); ss += __shfl_xor(ss, 8);
                const float rstd = 1.f / sqrtf(ss * (1.f / 128.f) + 1e-6f);
                unsigned wv[4];
#pragma unroll
                for (int j = 0; j < 4; ++j) wv[j] = pk2(o[2 * j] * rstd * gs[2 * j] * pg8::bf_lo(gw4[j]), o[2 * j + 1] * rstd * gs[2 * j + 1] * pg8::bf_hi(gw4[j]));
                v4u w; w.x = wv[0]; w.y = wv[1]; w.z = wv[2]; w.w = wv[3];
                *(v4u*)(YB + (size_t)mm * 1024 + 512 + h * 128 + ec) = w; }
        }
    }
    GROUP_BAR();

    {
        PHASE_PTRS();
        pg8::Gemm g{YB, WoT, M, 1024, 1024}; pg8::StaticOrder S; S.init(M, 1024, G, bx);
        pg8::EpiOut E{Y2, rowss};
        pg8::gemm_phase<pg8::EpiOut, pg8::StaticOrder, PG8_ALIGN, PG8_SP2>(L, g, S, E, wave);
    }
    GROUP_BAR();

    {
        PHASE_PTRS(); FRESH_TID();
        f32x4 gv[4];
#pragma unroll
        for (int j = 0; j < 4; ++j) gv[j] = *((const f32x4*)post_g + lane + 64 * j);
        for (int m0 = gwl; m0 < RPG; m0 += 4 * NGWL) {
            f32x4 xv[4][4]; v2u yv[4][4]; float rs[4];
#pragma unroll
            for (int k = 0; k < 4; ++k) { const int ml = m0 + k * NGWL; const size_t m = (size_t)(RPG * gi + (ml < RPG ? ml : m0)); rs[k] = rowss[m];
                const f32x4* xr = (const f32x4*)(x + m * DMODEL) + lane; const v2u* yr = (const v2u*)(Y2 + m * 1024) + lane;
#pragma unroll
                for (int j = 0; j < 4; ++j) { xv[k][j] = __builtin_nontemporal_load(xr + 64 * j); yv[k][j] = yr[64 * j]; } }
#pragma unroll
            for (int k = 0; k < 4; ++k) { const int ml = m0 + k * NGWL; if (ml >= RPG) continue; const int mm = RPG * gi + ml;
                const float rstd = 1.f / sqrtf(rs[k] * (1.f / 1024.f) + 1e-6f); f32x4* orow = (f32x4*)(out + (size_t)mm * DMODEL) + lane;
#pragma unroll
                for (int j = 0; j < 4; ++j) { f32x4 o;
                    o.x = xv[k][j].x + pg8::bf_lo(yv[k][j].x) * rstd * gv[j].x; o.y = xv[k][j].y + pg8::bf_hi(yv[k][j].x) * rstd * gv[j].y; o.z = xv[k][j].z + pg8::bf_lo(yv[k][j].y) * rstd * gv[j].z; o.w = xv[k][j].w + pg8::bf_hi(yv[k][j].y) * rstd * gv[j].w;
                    __builtin_nontemporal_store(o, orow + 64 * j); } }
        }
    }
}

extern "C" void kernel_launch(void* const* d_in, const int* in_sizes, int n_in, void* d_out, int out_size, void* d_ws, size_t ws_size, hipStream_t stream) {
    static int grid = 0;
    if (grid == 0) {
        if (n_in != 16 || out_size != M * DMODEL || ws_size < WS_END) { fprintf(stderr, "kernel_launch: unexpected problem shape (n_in %d, out %d, ws %zu)\n", n_in, out_size, ws_size); grid = -1; return; }
        int dev = 0, cus = 0, per_cu = 0;
        hipGetDevice(&dev); hipDeviceGetAttribute(&cus, hipDeviceAttributeMultiprocessorCount, dev);
        hipFuncSetAttribute((const void*)fwd_megakernel, hipFuncAttributeMaxDynamicSharedMemorySize, LDS_BYTES);
        hipOccupancyMaxActiveBlocksPerMultiprocessor(&per_cu, (const void*)fwd_megakernel, NWAVES * 64, LDS_BYTES);
        if (per_cu < 1) { fprintf(stderr, "kernel_launch: occupancy query reports %d blocks per CU\n", per_cu); per_cu = 1; }
        (void)hipGetLastError();
        grid = cus;
    }
    if (grid < 0) return;
    (void)hipMemsetAsync((char*)d_ws + WS_BAR, 0, WS_BAR_BYTES, stream);
    Args a{};
    for (int i = 0; i < 16; ++i) a.in[i] = (const float*)d_in[i];
    a.out = (float*)d_out; a.ws = (unsigned char*)d_ws;
    void* kargs[] = {&a};
    hipError_t e = hipLaunchCooperativeKernel((const void*)fwd_megakernel, dim3(grid), dim3(NWAVES * 64), kargs, LDS_BYTES, stream);
    if (e != hipSuccess) fprintf(stderr, "cooperative launch failed: %s (grid %d)\n", hipGetErrorString(e), grid);
}
```
